# Optimizing an MI355X kernel written in HIP

```python
import math
import jax
import jax.numpy as jnp
from jax import lax
import numpy as np

D_MODEL = 1024
BATCH = 4
SEQ = 4096
DEPTH = 2

GRID_W = 64
CTX_LEN = 256

S5_WIDTH = 256
S5_GROUP = 16
S5_GROUPS = S5_WIDTH // S5_GROUP
S5_STATE = 64
S5_DT_MIN = 1e-3
S5_DT_MAX = 1e-1

GM_WIDTH = 256
GM_HEADS = 4
GM_CHUNK = 128

DA_HEADS = 4
DA_HEAD_DIM = 64
DA_QK = DA_HEADS * 2 * DA_HEAD_DIM
DA_V = DA_HEADS * 2 * DA_HEAD_DIM
Q_BLOCK = 128
ROPE_BASE = 10000.0

N_BRANCH = 3
IN_SPLITS = (S5_WIDTH,
             S5_WIDTH + 2 * GM_WIDTH,
             S5_WIDTH + 2 * GM_WIDTH + DA_QK,
             S5_WIDTH + 2 * GM_WIDTH + 2 * DA_QK,
             S5_WIDTH + 2 * GM_WIDTH + 2 * DA_QK + DA_V)
IN_WIDTH = IN_SPLITS[-1] + N_BRANCH * D_MODEL

N_EXPERTS = 64
TOP_K = 8
N_GROUPS = 8
TOPK_GROUPS = 4
EXPERT_HIDDEN = 256
SHARED_HIDDEN = 256
ROUTED_SCALE = 2.5
MOE_BLOCK = 128

DN_ALPHA = (2 * DEPTH) ** 0.25
DN_BETA = (8 * DEPTH) ** -0.25
LN_EPS = 1e-5

kernel_name = 'hybrid_s5_gmlp_diffattn_moe_dit'


def layer_norm(x, g=None, b=None):
    xf = x.astype(jnp.float32)
    mu = jnp.mean(xf, -1, keepdims=True)
    var = jnp.mean(jnp.square(xf - mu), -1, keepdims=True)
    y = ((xf - mu) * lax.rsqrt(var + LN_EPS)).astype(x.dtype)
    return y if g is None else y * g + b


def rms_norm(x, g):
    xf = x.astype(jnp.float32)
    y = xf * lax.rsqrt(jnp.mean(jnp.square(xf), -1, keepdims=True) + LN_EPS)
    return y.astype(x.dtype) * g


def modulate(x, shift, scale):
    return x * (1 + scale) + shift


def axial_rope_tables(n_tokens):
    rows = n_tokens // GRID_W
    r, col = jnp.meshgrid(jnp.arange(rows), jnp.arange(GRID_W), indexing='ij')
    axis_dim = DA_HEAD_DIM // 2
    inv_freq = ROPE_BASE ** (-jnp.arange(0, axis_dim, 2, dtype=jnp.float32) / axis_dim)
    ang = jnp.concatenate([r.reshape(-1, 1).astype(jnp.float32) * inv_freq,
                           col.reshape(-1, 1).astype(jnp.float32) * inv_freq], -1)
    return jnp.cos(ang), jnp.sin(ang)


def _rotate(x, cos, sin):
    h = x.shape[-1] // 2
    x1, x2 = x[..., :h], x[..., h:]
    return jnp.concatenate([x1 * cos - x2 * sin, x2 * cos + x1 * sin], -1)


def apply_axial_rope(x, cos, sin):
    bshape = (1, x.shape[1]) + (1,) * (x.ndim - 3) + (cos.shape[-1],)
    cos = cos.reshape(bshape).astype(x.dtype)
    sin = sin.reshape(bshape).astype(x.dtype)
    half = DA_HEAD_DIM // 2
    nf = half // 2
    return jnp.concatenate([_rotate(x[..., :half], cos[..., :nf], sin[..., :nf]),
                            _rotate(x[..., half:], cos[..., nf:], sin[..., nf:])], -1)


def s5_discretize(lam_re, lam_im, log_step, b_re, b_im):
    dt = jnp.exp(log_step.astype(jnp.float32))[:, None]
    lr = lam_re.astype(jnp.float32)
    li = lam_im.astype(jnp.float32)
    mag = jnp.exp(lr * dt)
    a_re = mag * jnp.cos(li * dt)
    a_im = mag * jnp.sin(li * dt)
    den = lr * lr + li * li
    n_re = a_re - 1.0
    z_re = (n_re * lr + a_im * li) / den
    z_im = (a_im * lr - n_re * li) / den
    br = b_re.astype(jnp.float32)
    bi = b_im.astype(jnp.float32)
    bb_re = z_re[..., None] * br - z_im[..., None] * bi
    bb_im = z_re[..., None] * bi + z_im[..., None] * br
    return a_re, a_im, bb_re, bb_im


def _complex_affine_combine(e1, e2):
    a1r, a1i, b1r, b1i = e1
    a2r, a2i, b2r, b2i = e2
    return (a1r * a2r - a1i * a2i,
            a1r * a2i + a1i * a2r,
            a2r * b1r - a2i * b1i + b2r,
            a2r * b1i + a2i * b1r + b2i)


def s5_scan(u, a_re, a_im, bb_re, bb_im, h0, reverse):
    bu_re = jnp.einsum('blgc,gpc->blgp', u, bb_re)
    bu_im = jnp.einsum('blgc,gpc->blgp', u, bb_im)
    if h0 is not None:
        h_re, h_im = h0
        edge = -1 if reverse else 0
        bu_re = bu_re.at[:, edge].add(a_re * h_re - a_im * h_im)
        bu_im = bu_im.at[:, edge].add(a_re * h_im + a_im * h_re)
    a_re_t = jnp.broadcast_to(a_re, bu_re.shape)
    a_im_t = jnp.broadcast_to(a_im, bu_re.shape)
    _, _, s_re, s_im = lax.associative_scan(_complex_affine_combine, (a_re_t, a_im_t, bu_re, bu_im),
                                            reverse=reverse, axis=1)
    return s_re, s_im


def s5_readout(s_re, s_im, c_re, c_im):
    return jnp.einsum('blgp,gcp->blgc', s_re, c_re) - jnp.einsum('blgp,gcp->blgc', s_im, c_im)


def s5_branch(a_lat, a_ctx, lam_re, lam_im, log_step, b_re, b_im, c_re, c_im, d_skip, ctx_out):
    def grouped(a):
        return a.astype(jnp.float32).reshape(a.shape[:2] + (S5_GROUPS, S5_GROUP))
    u_lat, u_ctx = grouped(a_lat), grouped(a_ctx)
    d = d_skip.astype(jnp.float32).reshape(S5_GROUPS, S5_GROUP)
    y_lat = d * u_lat
    y_ctx = d * u_ctx
    for direction in range(2):
        reverse = direction == 1
        a_re, a_im, bb_re, bb_im = s5_discretize(lam_re[direction], lam_im[direction],
                                                 log_step[direction], b_re[direction], b_im[direction])
        cr = c_re[direction].astype(jnp.float32)
        ci = c_im[direction].astype(jnp.float32)
        sc_re, sc_im = s5_scan(u_ctx, a_re, a_im, bb_re, bb_im, None, reverse)
        edge = 0 if reverse else -1
        sl_re, sl_im = s5_scan(u_lat, a_re, a_im, bb_re, bb_im, (sc_re[:, edge], sc_im[:, edge]), reverse)
        y_lat = y_lat + s5_readout(sl_re, sl_im, cr, ci)
        if ctx_out:
            y_ctx = y_ctx + s5_readout(sc_re, sc_im, cr, ci)

    def finish(y, like):
        return jax.nn.gelu(y).reshape(like.shape).astype(like.dtype)
    return finish(y_lat, a_lat), (finish(y_ctx, a_ctx) if ctx_out else None)


def chunk_gmlp(z, w_s, b_s):
    bsz, n, _ = z.shape
    u, v = jnp.split(jax.nn.gelu(z), 2, axis=-1)
    v = layer_norm(v).reshape(bsz, n // GM_CHUNK, GM_CHUNK, GM_HEADS, GM_WIDTH // GM_HEADS)
    s = jnp.einsum('hts,bnshc->bnthc', w_s, v) + b_s.T[None, None, :, :, None]
    return u * s.reshape(bsz, n, GM_WIDTH)


def diff_attend(q, k, v, lam):
    s = jnp.einsum('bqhmd,bkhmd->bhmqk', q, k).astype(jnp.float32) * (DA_HEAD_DIM ** -0.5)
    p = jax.nn.softmax(s, axis=-1)
    attn = p[:, :, 0] - lam * p[:, :, 1]
    return jnp.einsum('bhqk,bkhe->bqhe', attn.astype(v.dtype), v)


def diff_attention(q_lat, k_lat, v_lat, q_ctx, k_ctx, v_ctx, da_lam, subln_g, cos, sin, lam_init, ctx_out):
    bsz, n, _ = q_lat.shape

    def qk_heads(t):
        return t.reshape(t.shape[:2] + (DA_HEADS, 2, DA_HEAD_DIM))

    def v_heads(t):
        return t.reshape(t.shape[:2] + (DA_HEADS, 2 * DA_HEAD_DIM))
    q_l = apply_axial_rope(qk_heads(q_lat), cos, sin)
    k_l = apply_axial_rope(qk_heads(k_lat), cos, sin)
    q_c, k_c = qk_heads(q_ctx), qk_heads(k_ctx)
    v_l, v_c = v_heads(v_lat), v_heads(v_ctx)
    lf = da_lam.astype(jnp.float32)
    lam = jnp.exp(jnp.sum(lf[0] * lf[1])) - jnp.exp(jnp.sum(lf[2] * lf[3])) + lam_init
    k_all = jnp.concatenate([k_c, k_l], axis=1)
    v_all = jnp.concatenate([v_c, v_l], axis=1)
    nb = n // Q_BLOCK
    qb = jnp.moveaxis(q_l.reshape(bsz, nb, Q_BLOCK, DA_HEADS, 2, DA_HEAD_DIM), 1, 0)
    o = lax.map(lambda qq: diff_attend(qq, k_all, v_all, lam), qb)
    o_lat = jnp.moveaxis(o, 0, 1).reshape(bsz, n, DA_HEADS, 2 * DA_HEAD_DIM)

    def finish(t):
        return (rms_norm(t, subln_g) * (1.0 - lam_init)).reshape(t.shape[:2] + (DA_V,))
    y_ctx = finish(diff_attend(q_c, k_c, v_c, lam)) if ctx_out else None
    return finish(o_lat), y_ctx


def token_mixer(u_lat, u_ctx, w_in, s5_lam_re, s5_lam_im, s5_log_step, s5_b_re, s5_b_im, s5_c_re, s5_c_im,
                s5_d, gm_w_s, gm_b_s, da_lam, da_subln_g, w_glu_val, w_glu_gate, w_proj_gm, w_proj_da,
                w_out, cos, sin, lam_init, ctx_out):
    p_lat = u_lat @ w_in
    p_ctx = u_ctx @ w_in
    a_lat, z_lat, q_lat, k_lat, v_lat, g_lat = jnp.split(p_lat, IN_SPLITS, axis=-1)
    a_ctx, z_ctx, q_ctx, k_ctx, v_ctx, g_ctx = jnp.split(p_ctx, IN_SPLITS, axis=-1)
    ya_lat, ya_ctx = s5_branch(a_lat, a_ctx, s5_lam_re, s5_lam_im, s5_log_step, s5_b_re, s5_b_im,
                               s5_c_re, s5_c_im, s5_d, ctx_out)
    yc_lat, yc_ctx = diff_attention(q_lat, k_lat, v_lat, q_ctx, k_ctx, v_ctx, da_lam, da_subln_g,
                                    cos, sin, lam_init, ctx_out)

    def merge(y_a, y_b, y_c, gates):
        gate_a, gate_b, gate_c = jnp.split(jax.nn.sigmoid(gates), N_BRANCH, axis=-1)
        branch_a = (y_a @ w_glu_val) * jax.nn.sigmoid(y_a @ w_glu_gate)
        m = gate_a * branch_a + gate_b * (y_b @ w_proj_gm) + gate_c * (y_c @ w_proj_da)
        return m @ w_out
    out_lat = merge(ya_lat, chunk_gmlp(z_lat, gm_w_s, gm_b_s), yc_lat, g_lat)
    out_ctx = merge(ya_ctx, chunk_gmlp(z_ctx, gm_w_s, gm_b_s), yc_ctx, g_ctx) if ctx_out else None
    return out_lat, out_ctx


def swiglu(x, wg, wu, wd):
    return (jax.nn.silu(x @ wg) * (x @ wu)) @ wd


def routed_experts(h, eidx, w, w_gate, w_up, w_down):
    t, d = h.shape
    n = t * TOP_K
    flat_e = eidx.reshape(-1)
    flat_t = jnp.arange(n, dtype=jnp.int32) // TOP_K
    order = jnp.argsort(flat_e)
    se, st, sw = flat_e[order], flat_t[order], w.reshape(-1)[order]
    counts = jnp.bincount(flat_e, length=N_EXPERTS)
    padded = (counts + MOE_BLOCK - 1) // MOE_BLOCK * MOE_BLOCK
    start = jnp.cumsum(counts) - counts
    pend = jnp.cumsum(padded)
    pstart = pend - padded
    dest = pstart[se] + jnp.arange(n, dtype=jnp.int32) - start[se]
    n_blk = -(-n // MOE_BLOCK) + N_EXPERTS
    n_rows = n_blk * MOE_BLOCK
    row_tok = jnp.full((n_rows,), t, jnp.int32).at[dest].set(st)
    row_w = jnp.zeros((n_rows,), h.dtype).at[dest].set(sw)
    blk_e = jnp.minimum(jnp.searchsorted(pend, jnp.arange(n_blk) * MOE_BLOCK, side='right'), N_EXPERTS - 1)
    h_pad = jnp.concatenate([h, jnp.zeros((1, d), h.dtype)], axis=0)

    def block_ffn(args):
        tok, wt, e = args
        return swiglu(h_pad[tok], w_gate[e], w_up[e], w_down[e]) * wt[:, None]
    yb = lax.map(block_ffn, (row_tok.reshape(n_blk, MOE_BLOCK), row_w.reshape(n_blk, MOE_BLOCK), blk_e))
    return jax.ops.segment_sum(yb.reshape(n_rows, d), row_tok, num_segments=t + 1)[:t]


def moe_ffn(h, w_router, b_router, w_exp_gate, w_exp_up, w_exp_down, w_sh_gate, w_sh_up, w_sh_down):
    t = h.shape[0]
    scores = jax.nn.sigmoid((h @ w_router).astype(jnp.float32))
    sel = scores + b_router.astype(jnp.float32)
    group_score = jnp.sum(lax.top_k(sel.reshape(t, N_GROUPS, N_EXPERTS // N_GROUPS), 2)[0], axis=-1)
    _, gidx = lax.top_k(group_score, TOPK_GROUPS)
    gmask = jnp.sum(jax.nn.one_hot(gidx, N_GROUPS, dtype=jnp.float32), axis=1) > 0
    emask = jnp.repeat(gmask, N_EXPERTS // N_GROUPS, axis=1)
    _, eidx = lax.top_k(jnp.where(emask, sel, -jnp.inf), TOP_K)
    wts = jnp.take_along_axis(scores, eidx, axis=1)
    wts = wts / jnp.sum(wts, -1, keepdims=True) * ROUTED_SCALE
    routed = routed_experts(h, eidx, wts.astype(h.dtype), w_exp_gate, w_exp_up, w_exp_down)
    return routed + swiglu(h, w_sh_gate, w_sh_up, w_sh_down)


def setup_inputs(seed: int = 0) -> dict:
    key = jax.random.key(seed)
    ks = iter(jax.random.split(key, 48))
    f32 = jnp.float32

    def nrm(shape, scale):
        return jax.random.normal(next(ks), shape, f32) * scale
    D = D_MODEL
    G, P, C = S5_GROUPS, S5_STATE, S5_GROUP
    return {
        'x': nrm((BATCH, SEQ, D), 1.0),
        'c': nrm((BATCH, D), 1.0),
        'ctx': nrm((BATCH, CTX_LEN, D), 1.0),
        'c_ctx': nrm((D,), 1.0),
        'w_mod': nrm((DEPTH, D, 6 * D), 0.5 * D ** -0.5),
        'b_mod': nrm((DEPTH, 6 * D), 0.02),
        'w_in': nrm((DEPTH, D, IN_WIDTH), D ** -0.5),
        's5_lam_re': -0.5 + nrm((DEPTH, 2, G, P), 0.01),
        's5_lam_im': jnp.pi * jnp.arange(P, dtype=f32) + nrm((DEPTH, 2, G, P), 0.01),
        's5_log_step': jax.random.uniform(next(ks), (DEPTH, 2, G), f32,
                                          math.log(S5_DT_MIN), math.log(S5_DT_MAX)),
        's5_b_re': nrm((DEPTH, 2, G, P, C), (2 * C) ** -0.5),
        's5_b_im': nrm((DEPTH, 2, G, P, C), (2 * C) ** -0.5),
        's5_c_re': nrm((DEPTH, 2, G, C, P), P ** -0.5),
        's5_c_im': nrm((DEPTH, 2, G, C, P), P ** -0.5),
        's5_d': nrm((DEPTH, S5_WIDTH), 1.0),
        'gm_w_s': nrm((DEPTH, GM_HEADS, GM_CHUNK, GM_CHUNK), GM_CHUNK ** -0.5),
        'gm_b_s': 1.0 + nrm((DEPTH, GM_HEADS, GM_CHUNK), 0.01),
        'da_lam': nrm((DEPTH, 4, DA_HEAD_DIM), 0.1),
        'da_subln_g': 1.0 + nrm((DEPTH, 2 * DA_HEAD_DIM), 0.01),
        'w_glu_val': nrm((DEPTH, S5_WIDTH, D), S5_WIDTH ** -0.5),
        'w_glu_gate': nrm((DEPTH, S5_WIDTH, D), S5_WIDTH ** -0.5),
        'w_proj_gm': nrm((DEPTH, GM_WIDTH, D), GM_WIDTH ** -0.5),
        'w_proj_da': nrm((DEPTH, DA_V, D), DA_V ** -0.5),
        'w_out': nrm((DEPTH, D, D), DN_BETA * D ** -0.5),
        'ln1_g': 1.0 + nrm((DEPTH, D), 0.01),
        'ln1_b': nrm((DEPTH, D), 0.01),
        'ln2_g': 1.0 + nrm((DEPTH, D), 0.01),
        'ln2_b': nrm((DEPTH, D), 0.01),
        'w_router': nrm((DEPTH, D, N_EXPERTS), D ** -0.5),
        'b_router': nrm((DEPTH, N_EXPERTS), 0.01),
        'w_exp_gate': nrm((DEPTH, N_EXPERTS, D, EXPERT_HIDDEN), D ** -0.5),
        'w_exp_up': nrm((DEPTH, N_EXPERTS, D, EXPERT_HIDDEN), D ** -0.5),
        'w_exp_down': nrm((DEPTH, N_EXPERTS, EXPERT_HIDDEN, D), DN_BETA * EXPERT_HIDDEN ** -0.5),
        'w_sh_gate': nrm((DEPTH, D, SHARED_HIDDEN), D ** -0.5),
        'w_sh_up': nrm((DEPTH, D, SHARED_HIDDEN), D ** -0.5),
        'w_sh_down': nrm((DEPTH, SHARED_HIDDEN, D), DN_BETA * SHARED_HIDDEN ** -0.5),
    }


def reference(x, c, ctx, c_ctx, w_mod, b_mod, w_in, s5_lam_re, s5_lam_im, s5_log_step, s5_b_re, s5_b_im,
              s5_c_re, s5_c_im, s5_d, gm_w_s, gm_b_s, da_lam, da_subln_g, w_glu_val, w_glu_gate,
              w_proj_gm, w_proj_da, w_out, ln1_g, ln1_b, ln2_g, ln2_b, w_router, b_router,
              w_exp_gate, w_exp_up, w_exp_down, w_sh_gate, w_sh_up, w_sh_down):
    bsz, n, d = x.shape
    cos, sin = axial_rope_tables(n)
    silu_c = jax.nn.silu(c)
    silu_cc = jax.nn.silu(c_ctx)
    h_lat, h_ctx = x, ctx
    for l in range(DEPTH):
        last = l == DEPTH - 1
        mod_lat = (silu_c @ w_mod[l] + b_mod[l])[:, None, :]
        mod_ctx = (silu_cc @ w_mod[l] + b_mod[l])[None, None, :]
        sh1, sc1, g1, sh2, sc2, g2 = jnp.split(mod_lat, 6, axis=-1)
        csh1, csc1, cg1, csh2, csc2, cg2 = jnp.split(mod_ctx, 6, axis=-1)
        lam_init = 0.8 - 0.6 * math.exp(-0.3 * l)
        mix_lat, mix_ctx = token_mixer(
            modulate(layer_norm(h_lat), sh1, sc1), modulate(layer_norm(h_ctx), csh1, csc1),
            w_in[l], s5_lam_re[l], s5_lam_im[l], s5_log_step[l], s5_b_re[l], s5_b_im[l],
            s5_c_re[l], s5_c_im[l], s5_d[l], gm_w_s[l], gm_b_s[l], da_lam[l], da_subln_g[l],
            w_glu_val[l], w_glu_gate[l], w_proj_gm[l], w_proj_da[l], w_out[l],
            cos, sin, lam_init, not last)
        h_lat = layer_norm(DN_ALPHA * h_lat + g1 * mix_lat, ln1_g[l], ln1_b[l])
        f_lat = modulate(layer_norm(h_lat), sh2, sc2).reshape(-1, d)
        moe_args = (w_router[l], b_router[l], w_exp_gate[l], w_exp_up[l], w_exp_down[l],
                    w_sh_gate[l], w_sh_up[l], w_sh_down[l])
        if last:
            y_lat = moe_ffn(f_lat, *moe_args).reshape(bsz, n, d)
        else:
            h_ctx = layer_norm(DN_ALPHA * h_ctx + cg1 * mix_ctx, ln1_g[l], ln1_b[l])
            f_ctx = modulate(layer_norm(h_ctx), csh2, csc2).reshape(-1, d)
            y = moe_ffn(jnp.concatenate([f_lat, f_ctx], axis=0), *moe_args)
            y_lat = y[:bsz * n].reshape(bsz, n, d)
            h_ctx = layer_norm(DN_ALPHA * h_ctx + cg2 * y[bsz * n:].reshape(h_ctx.shape), ln2_g[l], ln2_b[l])
        h_lat = layer_norm(DN_ALPHA * h_lat + g2 * y_lat, ln2_g[l], ln2_b[l])
    return h_lat
```

```cpp
#include <hip/hip_runtime.h>
#include <hip/hip_cooperative_groups.h>
#include <stdint.h>
#include <cstdio>
namespace cg = cooperative_groups;

#ifndef N_LAUNCH_MODE
#define N_LAUNCH_MODE 0
#endif

typedef unsigned short u16;
typedef __attribute__((ext_vector_type(8))) short bf16x8;
typedef __attribute__((ext_vector_type(4))) float f32x4;
typedef __attribute__((ext_vector_type(4))) unsigned u32x4;

#define DM     1024
#define NBATCH 4
#define SEQ    4096
#define CTXL   256
#define TLAT   16384
#define TCTX   1024
#define MTOT   17408
#define INW    5376
#define NTHR   512
#define ALPHA  1.41421356237309515f
#define LN_EPS 1e-5f
#define NCHK   68

enum { I_X = 0, I_C, I_CTX, I_CCTX, I_WMOD, I_BMOD, I_WIN, I_LRE, I_LIM, I_LSTEP, I_BRE, I_BIM, I_CRE, I_CIM, I_S5D,
       I_GMW, I_GMB, I_DALAM, I_SUBLN, I_GLUV, I_GLUG, I_PGM, I_PDA, I_WOUT, I_LN1G, I_LN1B, I_LN2G, I_LN2B,
       I_WR, I_BR, I_EG, I_EU, I_ED, I_SG, I_SU, I_SD, N_IN };

constexpr size_t al256(size_t x) { return (x + 255) / 256 * 256; }
constexpr size_t OFF_BAR   = 0;
constexpr size_t OFF_CNT   = 16384;
constexpr size_t ZERO_BYTES = 20480;
constexpr size_t OFF_MOD   = 32768;
constexpr size_t OFF_S5A   = OFF_MOD + al256(2 * 5 * 6144 * 4);
constexpr size_t OFF_S5A64 = OFF_S5A + 32768;
constexpr size_t OFF_S5BB  = OFF_S5A64 + 32768;
constexpr size_t OFF_ROPE  = OFF_S5BB + 524288;
constexpr size_t OFF_E     = OFF_ROPE + 8192;
constexpr size_t OFF_LIST  = OFF_E + al256((size_t)4 * 2 * NCHK * 16 * 64 * 2 * 4);
constexpr size_t OFF_TOPW  = OFF_LIST + al256((size_t)2 * 64 * 8704 * 4);
constexpr size_t OFF_WS    = OFF_TOPW + al256((size_t)MTOT * 8 * 4);
constexpr size_t WS_WIN = 0, WS_GLU = WS_WIN + (size_t)INW * 1024 * 2, WS_GM = WS_GLU + 2048 * 256 * 2,
                 WS_DA = WS_GM + 1024 * 256 * 2, WS_OUT = WS_DA + 1024 * 512 * 2, WS_R = WS_OUT + 1024 * 1024 * 2,
                 WS_LAYER = WS_R + 128 * 1024 * 2;
constexpr size_t OFF_WE    = OFF_WS + 2 * WS_LAYER;
constexpr size_t WE_GU = (size_t)512 * 1024 * 2, WE_D = (size_t)1024 * 256 * 2, WE_ONE = WE_GU + WE_D;
constexpr size_t OFF_H     = OFF_WE + 65 * WE_ONE;
constexpr size_t OFF_ACT   = OFF_H + (size_t)MTOT * 1024 * 4;
constexpr size_t OFF_BIG   = OFF_ACT + (size_t)MTOT * 1024 * 2;
constexpr size_t BIG_P = 0, BIG_YA = BIG_P + (size_t)MTOT * INW * 2, BIG_YB = BIG_YA + (size_t)MTOT * 256 * 2,
                 BIG_YC = BIG_YB + (size_t)MTOT * 256 * 2, BIG_M = BIG_YC + (size_t)MTOT * 512 * 2,
                 BIG_END = BIG_M + (size_t)MTOT * 1024 * 2;
constexpr size_t BIG_YR = 0, BIG_HD = BIG_YR + (size_t)8704 * 8 * 1024 * 2, BIG_HS = BIG_HD + (size_t)8704 * 8 * 256 * 2,
                 BIG_END2 = BIG_HS + (size_t)8704 * 256 * 2;
static_assert(BIG_END2 <= BIG_END, "moe scratch must fit");
constexpr size_t WS_TOTAL = OFF_BIG + BIG_END;

struct Params { const float* in[N_IN]; float* out; char* ws; int s_lo, s_hi; };

__device__ __forceinline__ u16 f2bf(float f) { unsigned u = __float_as_uint(f); u += 0x7fffu + ((u >> 16) & 1u); return (u16)(u >> 16); }
__device__ __forceinline__ float bf2f(u16 h) { return __uint_as_float(((unsigned)h) << 16); }
__device__ __forceinline__ float bflo(unsigned w) { return __uint_as_float(w << 16); }
__device__ __forceinline__ float bfhi(unsigned w) { return __uint_as_float(w & 0xffff0000u); }
__device__ __forceinline__ unsigned pack2(float a, float b) { return (unsigned)f2bf(a) | ((unsigned)f2bf(b) << 16); }
__device__ __forceinline__ float wave_sum(float v) {
#pragma unroll
  for (int m = 32; m >= 1; m >>= 1) v += __shfl_xor(v, m, 64);
  return v;
}
__device__ __forceinline__ float sigmoidf_(float x) { return 1.f / (1.f + __expf(-x)); }
__device__ __forceinline__ float gelu_tanh(float x) {
  float t = 0.7978845608028654f * (x + 0.044715f * x * x * x);
  float e = __expf(2.f * t);
  float th = 1.f - 2.f / (e + 1.f);
  return 0.5f * x * (1.f + th);
}
__device__ __forceinline__ float silu_(float x) { return x / (1.f + __expf(-x)); }

#define A_STAGE 32768
#define B_STAGE 16384
#define STAGE_BYTES 49152
#define GEMM_LDS (2 * STAGE_BYTES)

__device__ __forceinline__ void glds16(const void* g, void* l) {
  __builtin_amdgcn_global_load_lds((const __attribute__((address_space(1))) void*)g, (__attribute__((address_space(3))) void*)l, 16, 0, 0);
}

template <int NF, class AF, class BF>
__device__ __forceinline__ void gemm_acc_t(f32x4 (&acc)[4][NF], AF arow, BF brow, int K, char* lds) {
  const int tid = threadIdx.x, lane = tid & 63, wid = tid >> 6, wm = wid >> 1, wn = wid & 1, fr = lane & 15, fq = lane >> 4;
  constexpr int NB = NF / 2;
  int tidz = tid; asm volatile("" : "+v"(tidz));
  const u16* ap[4]; const u16* bp[NB];
#pragma unroll
  for (int i = 0; i < 4; ++i) { int idx = i * NTHR + tidz, row = idx >> 3, c = (idx & 7) ^ (row & 7); ap[i] = arow(row) + c * 8; }
#pragma unroll
  for (int i = 0; i < NB; ++i) { int idx = i * NTHR + tidz, row = idx >> 3, c = (idx & 7) ^ (row & 7); bp[i] = brow(row) + c * 8; }
  const int nt = K >> 6;
  {
#pragma unroll
    for (int i = 0; i < 4; ++i) glds16(ap[i], lds + (i * NTHR + tid) * 16);
#pragma unroll
    for (int i = 0; i < NB; ++i) glds16(bp[i], lds + A_STAGE + (i * NTHR + tid) * 16);
  }
  asm volatile("s_waitcnt vmcnt(0)" ::: "memory");
  __syncthreads();
  const int sw = fr & 7;
#pragma unroll 1
  for (int t = 0; t < nt; ++t) {
    char* cur = lds + (t & 1) * STAGE_BYTES;
    if (t + 1 < nt) {
      char* nxt = lds + ((t + 1) & 1) * STAGE_BYTES; const int k0 = (t + 1) << 6;
#pragma unroll
      for (int i = 0; i < 4; ++i) glds16(ap[i] + k0, nxt + (i * NTHR + tid) * 16);
#pragma unroll
      for (int i = 0; i < NB; ++i) glds16(bp[i] + k0, nxt + A_STAGE + (i * NTHR + tid) * 16);
    }
#pragma unroll
    for (int ks = 0; ks < 2; ++ks) {
      bf16x8 At[4], Bt[NF];
      const int coff = (((ks * 4 + fq) ^ sw) << 4);
#pragma unroll
      for (int m = 0; m < 4; ++m) At[m] = *reinterpret_cast<const bf16x8*>(cur + (wm * 64 + m * 16 + fr) * 128 + coff);
#pragma unroll
      for (int n = 0; n < NF; ++n) Bt[n] = *reinterpret_cast<const bf16x8*>(cur + A_STAGE + (wn * NF * 16 + n * 16 + fr) * 128 + coff);
#pragma unroll
      for (int m = 0; m < 4; ++m)
#pragma unroll
        for (int n = 0; n < NF; ++n) acc[m][n] = __builtin_amdgcn_mfma_f32_16x16x32_bf16(At[m], Bt[n], acc[m][n], 0, 0, 0);
    }
    asm volatile("s_waitcnt vmcnt(0)" ::: "memory");
    __syncthreads();
  }
}
template <class AF, class BF>
__device__ __forceinline__ void gemm_acc(f32x4 (&acc)[4][4], AF arow, BF brow, int K, char* lds) { gemm_acc_t<4>(acc, arow, brow, K, lds); }
#define ZERO_ACC(a) do { _Pragma("unroll") for (int _m = 0; _m < 4; ++_m) _Pragma("unroll") for (int _n = 0; _n < 4; ++_n) a[_m][_n] = (f32x4){0.f, 0.f, 0.f, 0.f}; } while (0)

#define EPI_ROWS(ROW0) int _rb = (ROW0) + wm * 64 + fq * 4; asm volatile("" : "+v"(_rb)); \
  _Pragma("unroll") for (int m = 0; m < 4; ++m) { __builtin_amdgcn_sched_barrier(0); _Pragma("unroll") for (int j = 0; j < 4; ++j) { const int row = _rb + m * 16 + j;
#define EPI_END } }

#define PTR_TAB_OFF (GEMM_LDS + 1024)
struct CtxP { char* ws; float* out; };
struct Ctx {
  CtxP p; char* lds; int tid, lane, wid;
  __device__ __forceinline__ const float* in(int i) const { return reinterpret_cast<const float* const*>(lds + PTR_TAB_OFF)[i]; }
  template <typename T> __device__ __forceinline__ T* w(size_t off) const { return reinterpret_cast<T*>(p.ws + off); }
  __device__ __forceinline__ const float* mod(int l, int brow, int chunk) const { return w<float>(OFF_MOD) + ((size_t)(l * 5 + brow) * 6144 + chunk * 1024); }
};
__device__ __forceinline__ int brow_of(int row) { return row < TLAT ? (row >> 12) : 4; }

__device__ __forceinline__ void cvt_tile(const float* __restrict__ src, int N, u16* __restrict__ dst, int dld, int k0, int n0, int roff, float* t) {
  const int tid = threadIdx.x;
  { const int n = tid & 63, kb = tid >> 6;
#pragma unroll
    for (int i = 0; i < 8; ++i) { int k = kb + 8 * i; t[k * 65 + n] = src[(size_t)(k0 + k) * N + n0 + n]; } }
  __syncthreads();
  { const int k = tid & 63, nb = tid >> 6;
#pragma unroll
    for (int i = 0; i < 8; ++i) { int nn = nb + 8 * i; dst[(size_t)(roff + n0 + nn) * dld + k0 + k] = f2bf(t[k * 65 + nn]); } }
  __syncthreads();
}
__device__ __forceinline__ void cvt_router_tile(const float* __restrict__ src, u16* __restrict__ dst, int k0, float* t) {
  const int tid = threadIdx.x;
  { const int n = tid & 63, kb = tid >> 6;
#pragma unroll
    for (int i = 0; i < 8; ++i) { int k = kb + 8 * i; t[k * 65 + n] = src[(size_t)(k0 + k) * 64 + n]; } }
  __syncthreads();
  { const int k = tid & 63, nb = tid >> 6;
#pragma unroll
    for (int i = 0; i < 8; ++i) { int nn = nb + 8 * i; float v = t[k * 65 + nn]; u16 hi = f2bf(v); u16 lo = f2bf(v - bf2f(hi));
      dst[(size_t)nn * 1024 + k0 + k] = hi; dst[(size_t)(64 + nn) * 1024 + k0 + k] = lo; } }
  __syncthreads();
}
#define NCVT_SMALL 1936
__device__ __forceinline__ void cvt_small(const Ctx& c, int l, int t) {
  float* tb = reinterpret_cast<float*>(c.lds);
  char* wl = c.p.ws + OFF_WS + (size_t)l * WS_LAYER;
  if (t < 1344) { cvt_tile(c.in(I_WIN) + (size_t)l * 1024 * INW, INW, (u16*)(wl + WS_WIN), 1024, (t / 84) * 64, (t % 84) * 64, 0, tb); return; }
  t -= 1344;
  if (t < 64) { cvt_tile(c.in(I_GLUV) + (size_t)l * 256 * 1024, 1024, (u16*)(wl + WS_GLU), 256, (t / 16) * 64, (t % 16) * 64, 0, tb); return; }
  t -= 64;
  if (t < 64) { cvt_tile(c.in(I_GLUG) + (size_t)l * 256 * 1024, 1024, (u16*)(wl + WS_GLU), 256, (t / 16) * 64, (t % 16) * 64, 1024, tb); return; }
  t -= 64;
  if (t < 64) { cvt_tile(c.in(I_PGM) + (size_t)l * 256 * 1024, 1024, (u16*)(wl + WS_GM), 256, (t / 16) * 64, (t % 16) * 64, 0, tb); return; }
  t -= 64;
  if (t < 128) { cvt_tile(c.in(I_PDA) + (size_t)l * 512 * 1024, 1024, (u16*)(wl + WS_DA), 512, (t / 16) * 64, (t % 16) * 64, 0, tb); return; }
  t -= 128;
  if (t < 256) { cvt_tile(c.in(I_WOUT) + (size_t)l * 1024 * 1024, 1024, (u16*)(wl + WS_OUT), 1024, (t / 16) * 64, (t % 16) * 64, 0, tb); return; }
  t -= 256;
  cvt_router_tile(c.in(I_WR) + (size_t)l * 1024 * 64, (u16*)(wl + WS_R), t * 64, tb);
}
#define NCVT_EXP (65 * 192)
__device__ __forceinline__ void cvt_expert(const Ctx& c, int l, int t) {
  float* tb = reinterpret_cast<float*>(c.lds);
  const int e = t / 192; int r = t % 192;
  char* we = c.p.ws + OFF_WE + (size_t)e * WE_ONE;
  const float* sg = e < 64 ? c.in(I_EG) + (size_t)(l * 64 + e) * 1024 * 256 : c.in(I_SG) + (size_t)l * 1024 * 256;
  const float* su = e < 64 ? c.in(I_EU) + (size_t)(l * 64 + e) * 1024 * 256 : c.in(I_SU) + (size_t)l * 1024 * 256;
  const float* sd = e < 64 ? c.in(I_ED) + (size_t)(l * 64 + e) * 256 * 1024 : c.in(I_SD) + (size_t)l * 256 * 1024;
  if (r < 64) { cvt_tile(sg, 256, (u16*)we, 1024, (r / 4) * 64, (r % 4) * 64, 0, tb); return; }
  r -= 64;
  if (r < 64) { cvt_tile(su, 256, (u16*)we, 1024, (r / 4) * 64, (r % 4) * 64, 256, tb); return; }
  r -= 64;
  cvt_tile(sd, 1024, (u16*)(we + WE_GU), 256, (r / 16) * 64, (r % 16) * 64, 0, tb);
}

__device__ __forceinline__ void step_prep(const Ctx& c) {
  const int G = gridDim.x;
  const int n_cvt = 2 * NCVT_SMALL, n_mod = 192, n_s5 = 8, n_misc = 1;
  const int total = n_cvt + n_mod + n_s5 + n_misc;
  for (int it = blockIdx.x; it < total; it += G) {
    if (it < n_cvt) { cvt_small(c, it / NCVT_SMALL, it % NCVT_SMALL); continue; }
    int i = it - n_cvt;
    if (i < n_mod) {
      const int l = i / 96, cb = i % 96;
      float* sil = reinterpret_cast<float*>(c.lds);
      float* red = sil + 5 * 1024;
      for (int q = c.tid; q < 5 * 1024; q += NTHR) { int r = q >> 10, k = q & 1023; float v = r < 4 ? c.in(I_C)[r * 1024 + k] : c.in(I_CCTX)[k]; sil[q] = silu_(v); }
      __syncthreads();
      const int col = c.tid & 63, kp = c.tid >> 6;
      float a0 = 0, a1 = 0, a2 = 0, a3 = 0, a4 = 0;
      const float* wm_ = c.in(I_WMOD) + (size_t)l * 1024 * 6144 + cb * 64 + col;
      for (int k = kp * 128; k < kp * 128 + 128; ++k) { float wv = wm_[(size_t)k * 6144];
        a0 += sil[k] * wv; a1 += sil[1024 + k] * wv; a2 += sil[2048 + k] * wv; a3 += sil[3072 + k] * wv; a4 += sil[4096 + k] * wv; }
      red[(kp * 5 + 0) * 64 + col] = a0; red[(kp * 5 + 1) * 64 + col] = a1; red[(kp * 5 + 2) * 64 + col] = a2;
      red[(kp * 5 + 3) * 64 + col] = a3; red[(kp * 5 + 4) * 64 + col] = a4;
      __syncthreads();
      if (c.tid < 320) { int r = c.tid >> 6, cc = c.tid & 63; float s = 0;
#pragma unroll
        for (int q = 0; q < 8; ++q) s += red[(q * 5 + r) * 64 + cc];
        s += c.in(I_BMOD)[l * 6144 + cb * 64 + cc];
        c.w<float>(OFF_MOD)[(size_t)(l * 5 + r) * 6144 + cb * 64 + cc] = s; }
      __syncthreads();
      continue;
    }
    i -= n_mod;
    if (i < n_s5) {
      const int q = i * NTHR + c.tid;
      const int ldg = q >> 6;
      const float dt = expf(c.in(I_LSTEP)[ldg]);
      const float lr = c.in(I_LRE)[q], li = c.in(I_LIM)[q];
      const float mag = expf(lr * dt);
      float sn, cs; sincosf(li * dt, &sn, &cs);
      const float are = mag * cs, aim = mag * sn;
      const float den = lr * lr + li * li, nre = are - 1.f;
      const float zre = (nre * lr + aim * li) / den, zim = (aim * lr - nre * li) / den;
      float* A = c.w<float>(OFF_S5A); float* A64 = c.w<float>(OFF_S5A64); float* BB = c.w<float>(OFF_S5BB);
      A[q * 2] = are; A[q * 2 + 1] = aim;
      float pr = are, pi = aim;
#pragma unroll
      for (int s = 0; s < 6; ++s) { float nr = pr * pr - pi * pi, ni = 2.f * pr * pi; pr = nr; pi = ni; }
      A64[q * 2] = pr; A64[q * 2 + 1] = pi;
      const float* bre = c.in(I_BRE) + (size_t)q * 16; const float* bim = c.in(I_BIM) + (size_t)q * 16;
#pragma unroll
      for (int cc = 0; cc < 16; ++cc) { float br = bre[cc], bi = bim[cc];
        BB[((size_t)q * 16 + cc) * 2] = zre * br - zim * bi; BB[((size_t)q * 16 + cc) * 2 + 1] = zre * bi + zim * br; }
      continue;
    }
    for (int q = c.tid; q < 64 * 16; q += NTHR) { int pos = q >> 4, f = q & 15;
      float inv = powf(10000.f, -(float)f / 16.f); float ang = (float)pos * inv; float sn, cs; sincosf(ang, &sn, &cs);
      c.w<float>(OFF_ROPE)[q * 2] = cs; c.w<float>(OFF_ROPE)[q * 2 + 1] = sn; }
  }
}

__device__ __forceinline__ void ln_stats(const float (&v)[16], float& mean, float& rstd) {
  float s = 0;
#pragma unroll
  for (int i = 0; i < 16; ++i) s += v[i];
  mean = wave_sum(s) * (1.f / 1024.f);
  float q = 0;
#pragma unroll
  for (int i = 0; i < 16; ++i) { float d = v[i] - mean; q += d * d; }
  rstd = rsqrtf(wave_sum(q) * (1.f / 1024.f) + LN_EPS);
}
__device__ __forceinline__ void load_row(const float* src, int lane, float (&v)[16]) {
#pragma unroll
  for (int i = 0; i < 4; ++i) { float4 t = *reinterpret_cast<const float4*>(src + (i * 64 + lane) * 4); v[i * 4] = t.x; v[i * 4 + 1] = t.y; v[i * 4 + 2] = t.z; v[i * 4 + 3] = t.w; }
}
__device__ __forceinline__ void store_row(float* dst, int lane, const float (&v)[16]) {
#pragma unroll
  for (int i = 0; i < 4; ++i) *reinterpret_cast<float4*>(dst + (i * 64 + lane) * 4) = make_float4(v[i * 4], v[i * 4 + 1], v[i * 4 + 2], v[i * 4 + 3]);
}
__device__ __forceinline__ void store_row_bf(u16* dst, int lane, const float (&v)[16]) {
#pragma unroll
  for (int i = 0; i < 4; ++i) *reinterpret_cast<uint2*>(dst + (i * 64 + lane) * 4) = make_uint2(pack2(v[i * 4], v[i * 4 + 1]), pack2(v[i * 4 + 2], v[i * 4 + 3]));
}
__device__ __forceinline__ void ln_mod_store(const float (&v)[16], const float* sh, const float* sc, u16* dst, int lane) {
  float mean, rstd; ln_stats(v, mean, rstd);
  float o[16];
#pragma unroll
  for (int i = 0; i < 4; ++i) { float4 a = *reinterpret_cast<const float4*>(sh + (i * 64 + lane) * 4), b = *reinterpret_cast<const float4*>(sc + (i * 64 + lane) * 4);
    o[i * 4] = (v[i * 4] - mean) * rstd * (1.f + b.x) + a.x; o[i * 4 + 1] = (v[i * 4 + 1] - mean) * rstd * (1.f + b.y) + a.y;
    o[i * 4 + 2] = (v[i * 4 + 2] - mean) * rstd * (1.f + b.z) + a.z; o[i * 4 + 3] = (v[i * 4 + 3] - mean) * rstd * (1.f + b.w) + a.w; }
  store_row_bf(dst, lane, o);
}
__device__ __forceinline__ void ln_affine(float (&v)[16], const float* g, const float* b, int lane) {
  float mean, rstd; ln_stats(v, mean, rstd);
#pragma unroll
  for (int i = 0; i < 4; ++i) { float4 a = *reinterpret_cast<const float4*>(g + (i * 64 + lane) * 4), bb = *reinterpret_cast<const float4*>(b + (i * 64 + lane) * 4);
    v[i * 4] = (v[i * 4] - mean) * rstd * a.x + bb.x; v[i * 4 + 1] = (v[i * 4 + 1] - mean) * rstd * a.y + bb.y;
    v[i * 4 + 2] = (v[i * 4 + 2] - mean) * rstd * a.z + bb.z; v[i * 4 + 3] = (v[i * 4 + 3] - mean) * rstd * a.w + bb.w; }
}

__device__ __forceinline__ void step_ln_in(const Ctx& c) {
  u16* U = c.w<u16>(OFF_ACT);
  for (int it = blockIdx.x; it < MTOT / 8; it += gridDim.x) {
    const int row = it * 8 + c.wid;
    const float* src = row < TLAT ? c.in(I_X) + (size_t)row * 1024 : c.in(I_CTX) + (size_t)(row - TLAT) * 1024;
    float v[16]; load_row(src, c.lane, v);
    const int br = brow_of(row);
    ln_mod_store(v, c.mod(0, br, 0), c.mod(0, br, 1), U + (size_t)row * 1024, c.lane);
  }
}

__device__ __forceinline__ void step_gemm_in(const Ctx& c, int l) {
  const u16* U = c.w<u16>(OFF_ACT);
  const u16* W = reinterpret_cast<const u16*>(c.p.ws + OFF_WS + (size_t)l * WS_LAYER + WS_WIN);
  u16* P = c.w<u16>(OFF_BIG + BIG_P);
  const int wm = c.wid >> 1, wn = c.wid & 1, fr = c.lane & 15, fq = c.lane >> 4;
  for (int it = blockIdx.x; it < 68 * 42; it += gridDim.x) {
    const int tm = it / 42, tn = it % 42;
    f32x4 acc[4][4]; ZERO_ACC(acc);
    gemm_acc(acc, [&](int r) { return U + (size_t)(tm * 256 + r) * 1024; }, [&](int b) { return W + (size_t)(tn * 128 + b) * 1024; }, 1024, c.lds);
    const int cls = tn < 2 ? 0 : (tn < 6 ? 1 : (tn < 18 ? 0 : 2));
    { EPI_ROWS(tm * 256)
        u16* dst = P + (size_t)row * INW + tn * 128 + wn * 64 + fr;
#pragma unroll
        for (int n = 0; n < 4; ++n) { float v = acc[m][n][j];
          if (cls == 1) v = gelu_tanh(v); else if (cls == 2) v = sigmoidf_(v);
          dst[n * 16] = f2bf(v); }
      EPI_END }
  }
}

__device__ __forceinline__ void step_mix_a(const Ctx& c, int l, bool last) {
  u16* P = c.w<u16>(OFF_BIG + BIG_P);
  const int n_rope = 1024, n_s5 = 4 * 2 * NCHK, n_gm = (last ? 128 : 136) * 4, n_cv = NCVT_EXP;
  const int total = n_rope + n_s5 + n_gm + n_cv;
  for (int it = blockIdx.x; it < total; it += gridDim.x) {
    int i = it;
    if (i < n_rope) {
      const int gid = i * NTHR + c.tid; const int row = gid >> 5, sub = gid & 31, grp = sub >> 1, half = sub & 1;
      u16* base = P + (size_t)row * INW + 768 + grp * 64 + half * 32;
      const int t = row & 4095; const int pos = half == 0 ? (t >> 6) : (t & 63);
      const float* tab = c.w<float>(OFF_ROPE) + pos * 32;
      u32x4 x1a = *reinterpret_cast<const u32x4*>(base), x1b = *reinterpret_cast<const u32x4*>(base + 8);
      u32x4 x2a = *reinterpret_cast<const u32x4*>(base + 16), x2b = *reinterpret_cast<const u32x4*>(base + 24);
      u32x4 o1a, o1b, o2a, o2b;
#define ROPE2(X1, X2, O1, O2, W, F0) do { float cs0 = tab[(F0) * 2], sn0 = tab[(F0) * 2 + 1], cs1 = tab[(F0) * 2 + 2], sn1 = tab[(F0) * 2 + 3]; \
        float a0 = bflo(X1[W]), a1 = bfhi(X1[W]), b0 = bflo(X2[W]), b1 = bfhi(X2[W]); \
        O1[W] = pack2(a0 * cs0 - b0 * sn0, a1 * cs1 - b1 * sn1); O2[W] = pack2(b0 * cs0 + a0 * sn0, b1 * cs1 + a1 * sn1); } while (0)
      ROPE2(x1a, x2a, o1a, o2a, 0, 0); ROPE2(x1a, x2a, o1a, o2a, 1, 2); ROPE2(x1a, x2a, o1a, o2a, 2, 4); ROPE2(x1a, x2a, o1a, o2a, 3, 6);
      ROPE2(x1b, x2b, o1b, o2b, 0, 8); ROPE2(x1b, x2b, o1b, o2b, 1, 10); ROPE2(x1b, x2b, o1b, o2b, 2, 12); ROPE2(x1b, x2b, o1b, o2b, 3, 14);
#undef ROPE2
      *reinterpret_cast<u32x4*>(base) = o1a; *reinterpret_cast<u32x4*>(base + 8) = o1b;
      *reinterpret_cast<u32x4*>(base + 16) = o2a; *reinterpret_cast<u32x4*>(base + 24) = o2b;
      continue;
    }
    i -= n_rope;
    if (i < n_s5) {
      const int b = i / (2 * NCHK), rem = i % (2 * NCHK), dir = rem / NCHK, ck = rem % NCHK;
      const float* A = c.w<float>(OFF_S5A); const float* BB = c.w<float>(OFF_S5BB); float* E = c.w<float>(OFF_E);
#pragma unroll 1
      for (int gi = 0; gi < 2; ++gi) {
        const int g = c.wid * 2 + gi; const int q = ((l * 2 + dir) * 16 + g) * 64 + c.lane;
        const float are = A[q * 2], aim = A[q * 2 + 1];
        float bbr[16], bbi[16];
#pragma unroll
        for (int cc = 0; cc < 16; ++cc) { float2 t = *reinterpret_cast<const float2*>(BB + ((size_t)q * 16 + cc) * 2); bbr[cc] = t.x; bbi[cc] = t.y; }
        float sr = 0.f, si = 0.f;
        for (int j = 0; j < 64; ++j) {
          const int tau = ck * 64 + j; int row;
          if (tau < 256) row = TLAT + b * 256 + (dir ? 255 - tau : tau); else { int tt = tau - 256; row = b * 4096 + (dir ? 4095 - tt : tt); }
          const u16* up = P + (size_t)row * INW + g * 16;
          u32x4 u0 = *reinterpret_cast<const u32x4*>(up), u1 = *reinterpret_cast<const u32x4*>(up + 8);
          float br = 0.f, bi = 0.f;
#pragma unroll
          for (int w = 0; w < 4; ++w) { float x0 = bflo(u0[w]), x1 = bfhi(u0[w]), y0 = bflo(u1[w]), y1 = bfhi(u1[w]);
            br += bbr[2 * w] * x0 + bbr[2 * w + 1] * x1 + bbr[8 + 2 * w] * y0 + bbr[8 + 2 * w + 1] * y1;
            bi += bbi[2 * w] * x0 + bbi[2 * w + 1] * x1 + bbi[8 + 2 * w] * y0 + bbi[8 + 2 * w + 1] * y1; }
          const float nr = are * sr - aim * si + br, ni = are * si + aim * sr + bi; sr = nr; si = ni;
        }
        *reinterpret_cast<float2*>(E + ((size_t)(((b * 2 + dir) * NCHK + ck) * 16 + g) * 64 + c.lane) * 2) = make_float2(sr, si);
      }
      continue;
    }
    i -= n_s5;
    if (i < n_gm) {
      const int ck = i >> 2, h = i & 3; const int row0 = ck * 128;
      float* vh = reinterpret_cast<float*>(c.lds);
      for (int q = 0; q < 16; ++q) {
        const int s = c.wid * 16 + q; const u16* vp = P + (size_t)(row0 + s) * INW + 512 + c.lane * 4;
        uint2 t = *reinterpret_cast<const uint2*>(vp);
        float v0 = bflo(t.x), v1 = bfhi(t.x), v2 = bflo(t.y), v3 = bfhi(t.y);
        float mean = wave_sum(v0 + v1 + v2 + v3) * (1.f / 256.f);
        float d0 = v0 - mean, d1 = v1 - mean, d2 = v2 - mean, d3 = v3 - mean;
        float rstd = rsqrtf(wave_sum(d0 * d0 + d1 * d1 + d2 * d2 + d3 * d3) * (1.f / 256.f) + LN_EPS);
        if ((c.lane >> 4) == h) *reinterpret_cast<float4*>(vh + s * 64 + (c.lane & 15) * 4) = make_float4(d0 * rstd, d1 * rstd, d2 * rstd, d3 * rstd);
      }
      __syncthreads();
      const int t = c.tid >> 2, cq = c.tid & 3;
      float acc[16];
#pragma unroll
      for (int q = 0; q < 16; ++q) acc[q] = 0.f;
      const float* wrow = c.in(I_GMW) + ((size_t)(l * 4 + h) * 128 + t) * 128;
      for (int s4 = 0; s4 < 32; ++s4) {
        float4 w4 = *reinterpret_cast<const float4*>(wrow + s4 * 4);
        float wv[4] = {w4.x, w4.y, w4.z, w4.w};
#pragma unroll
        for (int ss = 0; ss < 4; ++ss) {
          const float* vr = vh + (s4 * 4 + ss) * 64 + cq * 16;
#pragma unroll
          for (int q4 = 0; q4 < 4; ++q4) { float4 x = *reinterpret_cast<const float4*>(vr + q4 * 4);
            acc[q4 * 4] += wv[ss] * x.x; acc[q4 * 4 + 1] += wv[ss] * x.y; acc[q4 * 4 + 2] += wv[ss] * x.z; acc[q4 * 4 + 3] += wv[ss] * x.w; }
        }
      }
      const float bs = c.in(I_GMB)[(l * 4 + h) * 128 + t];
      const u16* up = P + (size_t)(row0 + t) * INW + 256 + h * 64 + cq * 16;
      u32x4 u0 = *reinterpret_cast<const u32x4*>(up), u1 = *reinterpret_cast<const u32x4*>(up + 8);
      u32x4 o0, o1;
#pragma unroll
      for (int w = 0; w < 4; ++w) { o0[w] = pack2(bflo(u0[w]) * (acc[2 * w] + bs), bfhi(u0[w]) * (acc[2 * w + 1] + bs));
        o1[w] = pack2(bflo(u1[w]) * (acc[8 + 2 * w] + bs), bfhi(u1[w]) * (acc[8 + 2 * w + 1] + bs)); }
      u16* yb = c.w<u16>(OFF_BIG + BIG_YB) + (size_t)(row0 + t) * 256 + h * 64 + cq * 16;
      *reinterpret_cast<u32x4*>(yb) = o0; *reinterpret_cast<u32x4*>(yb + 8) = o1;
      __syncthreads();
      continue;
    }
    i -= n_gm;
    cvt_expert(c, l, i);
  }
}

#define SB_LD 136
__device__ __forceinline__ void s5_out_item(const Ctx& c, int l, int b, int seg, int j) {
  const u16* P = c.w<u16>(OFF_BIG + BIG_P); u16* YA = c.w<u16>(OFF_BIG + BIG_YA);
  const float* A = c.w<float>(OFF_S5A); const float* A64 = c.w<float>(OFF_S5A64); const float* BB = c.w<float>(OFF_S5BB); const float* E = c.w<float>(OFF_E);
  const int r0 = seg ? (TLAT + b * 256 + j * 64) : (b * 4096 + j * 64);
  const int kf = seg ? j : 4 + j, kr = seg ? 3 - j : 4 + (63 - j);
  const int lane = c.lane, fr = lane & 15, fq = lane >> 4;
  float* ubuf = reinterpret_cast<float*>(c.lds + c.wid * 8704);
  u16* sbuf = reinterpret_cast<u16*>(c.lds + c.wid * 8704 + 4096);
#pragma unroll 1
  for (int gi = 0; gi < 2; ++gi) {
    const int g = c.wid * 2 + gi;
    { const u16* up = P + (size_t)(r0 + lane) * INW + g * 16;
      u32x4 u0 = *reinterpret_cast<const u32x4*>(up), u1 = *reinterpret_cast<const u32x4*>(up + 8);
      float* ub = ubuf + lane * 16;
      *reinterpret_cast<float4*>(ub) = make_float4(bflo(u0[0]), bfhi(u0[0]), bflo(u0[1]), bfhi(u0[1]));
      *reinterpret_cast<float4*>(ub + 4) = make_float4(bflo(u0[2]), bfhi(u0[2]), bflo(u0[3]), bfhi(u0[3]));
      *reinterpret_cast<float4*>(ub + 8) = make_float4(bflo(u1[0]), bfhi(u1[0]), bflo(u1[1]), bfhi(u1[1]));
      *reinterpret_cast<float4*>(ub + 12) = make_float4(bflo(u1[2]), bfhi(u1[2]), bflo(u1[3]), bfhi(u1[3])); }
    __builtin_amdgcn_wave_barrier(); asm volatile("s_waitcnt lgkmcnt(0)" ::: "memory");
    f32x4 acc[4];
#pragma unroll
    for (int q = 0; q < 4; ++q) acc[q] = (f32x4){0.f, 0.f, 0.f, 0.f};
#pragma unroll 1
    for (int dir = 0; dir < 2; ++dir) {
      const int q = ((l * 2 + dir) * 16 + g) * 64 + lane;
      const float are = A[q * 2], aim = A[q * 2 + 1], a64r = A64[q * 2], a64i = A64[q * 2 + 1];
      float bbr[16], bbi[16];
#pragma unroll
      for (int cc = 0; cc < 16; ++cc) { float2 t = *reinterpret_cast<const float2*>(BB + ((size_t)q * 16 + cc) * 2); bbr[cc] = t.x; bbi[cc] = t.y; }
      float sr = 0.f, si = 0.f; const int kk = dir ? kr : kf;
      for (int jj = 0; jj < kk; ++jj) { float2 e = *reinterpret_cast<const float2*>(E + ((size_t)(((b * 2 + dir) * NCHK + jj) * 16 + g) * 64 + lane) * 2);
        float nr = a64r * sr - a64i * si + e.x, ni = a64r * si + a64i * sr + e.y; sr = nr; si = ni; }
      bf16x8 Bf[4];
      { const float* cre = c.in(I_CRE) + ((size_t)((l * 2 + dir) * 16 + g) * 16 + fr) * 64; const float* cim = c.in(I_CIM) + ((size_t)((l * 2 + dir) * 16 + g) * 16 + fr) * 64;
#pragma unroll
        for (int ks = 0; ks < 4; ++ks) {
#pragma unroll
          for (int ii = 0; ii < 8; ++ii) { int k = ks * 32 + fq * 8 + ii; float v = ks < 2 ? cre[k] : -cim[k - 64]; Bf[ks][ii] = (short)f2bf(v); } } }
#pragma unroll
      for (int sub = 0; sub < 4; ++sub) {
#pragma unroll 4
        for (int jj = 0; jj < 16; ++jj) {
          const int tau = sub * 16 + jj; const int tl = dir ? 63 - tau : tau;
          const float* ub = ubuf + tl * 16;
          float4 x0 = *reinterpret_cast<const float4*>(ub), x1 = *reinterpret_cast<const float4*>(ub + 4), x2 = *reinterpret_cast<const float4*>(ub + 8), x3 = *reinterpret_cast<const float4*>(ub + 12);
          float br = bbr[0] * x0.x + bbr[1] * x0.y + bbr[2] * x0.z + bbr[3] * x0.w + bbr[4] * x1.x + bbr[5] * x1.y + bbr[6] * x1.z + bbr[7] * x1.w
                   + bbr[8] * x2.x + bbr[9] * x2.y + bbr[10] * x2.z + bbr[11] * x2.w + bbr[12] * x3.x + bbr[13] * x3.y + bbr[14] * x3.z + bbr[15] * x3.w;
          float bi = bbi[0] * x0.x + bbi[1] * x0.y + bbi[2] * x0.z + bbi[3] * x0.w + bbi[4] * x1.x + bbi[5] * x1.y + bbi[6] * x1.z + bbi[7] * x1.w
                   + bbi[8] * x2.x + bbi[9] * x2.y + bbi[10] * x2.z + bbi[11] * x2.w + bbi[12] * x3.x + bbi[13] * x3.y + bbi[14] * x3.z + bbi[15] * x3.w;
          const float nr = are * sr - aim * si + br, ni = are * si + aim * sr + bi; sr = nr; si = ni;
          sbuf[(tl & 15) * SB_LD + lane] = f2bf(sr); sbuf[(tl & 15) * SB_LD + 64 + lane] = f2bf(si);
        }
        __builtin_amdgcn_wave_barrier(); asm volatile("s_waitcnt lgkmcnt(0)" ::: "memory");
        bf16x8 Af[4];
#pragma unroll
        for (int ks = 0; ks < 4; ++ks) Af[ks] = *reinterpret_cast<const bf16x8*>(sbuf + fr * SB_LD + ks * 32 + fq * 8);
        asm volatile("s_waitcnt lgkmcnt(0)" ::: "memory"); __builtin_amdgcn_wave_barrier();
        if (dir == 0) {
#pragma unroll
          for (int ks = 0; ks < 4; ++ks) acc[sub] = __builtin_amdgcn_mfma_f32_16x16x32_bf16(Af[ks], Bf[ks], acc[sub], 0, 0, 0);
        } else {
#pragma unroll
          for (int ks = 0; ks < 4; ++ks) acc[3 - sub] = __builtin_amdgcn_mfma_f32_16x16x32_bf16(Af[ks], Bf[ks], acc[3 - sub], 0, 0, 0);
        }
      }
    }
    const float dsk = c.in(I_S5D)[l * 256 + g * 16 + fr];
#pragma unroll
    for (int tb = 0; tb < 4; ++tb)
#pragma unroll
      for (int jx = 0; jx < 4; ++jx) { const int tl = tb * 16 + fq * 4 + jx; float y = dsk * ubuf[tl * 16 + fr] + acc[tb][jx];
        YA[(size_t)(r0 + tl) * 256 + g * 16 + fr] = f2bf(gelu_tanh(y)); }
    __builtin_amdgcn_wave_barrier(); asm volatile("s_waitcnt lgkmcnt(0)" ::: "memory");
  }
}

__device__ __forceinline__ void attn_naive_item(const Ctx& c, int l, int b, int h, int qb, int seg) {
  const u16* P = c.w<u16>(OFF_BIG + BIG_P); u16* YC = c.w<u16>(OFF_BIG + BIG_YC);
  const int ql = c.tid >> 2, vq = c.tid & 3;
  const int qrow = seg ? (TLAT + b * 256 + qb * 128 + ql) : (b * 4096 + qb * 128 + ql);
  const int nkeys = seg ? 256 : 4352;
  const float lam_init = 0.8f - 0.6f * expf(-0.3f * (float)l);
  float lam;
  { const float* lf = c.in(I_DALAM) + l * 256; float s1 = 0.f, s2 = 0.f;
    for (int d = 0; d < 64; ++d) { s1 += lf[d] * lf[64 + d]; s2 += lf[128 + d] * lf[192 + d]; }
    lam = expf(s1) - expf(s2) + lam_init; }
  float res[32];
#pragma unroll 1
  for (int mp = 0; mp < 2; ++mp) {
    float q[64];
    { const u16* qp = P + (size_t)qrow * INW + 768 + h * 128 + mp * 64;
#pragma unroll
      for (int w = 0; w < 8; ++w) { u32x4 t = *reinterpret_cast<const u32x4*>(qp + w * 8);
#pragma unroll
        for (int e = 0; e < 4; ++e) { q[w * 8 + 2 * e] = bflo(t[e]) * 0.125f; q[w * 8 + 2 * e + 1] = bfhi(t[e]) * 0.125f; } } }
    float o[32];
#pragma unroll
    for (int d = 0; d < 32; ++d) o[d] = 0.f;
    float mx = -1e30f, ls = 0.f;
#pragma unroll 1
    for (int key = 0; key < nkeys; ++key) {
      const int krow = key < 256 ? (TLAT + b * 256 + key) : (b * 4096 + key - 256);
      const u16* kp = P + (size_t)krow * INW + 1280 + h * 128 + mp * 64;
      float s = 0.f;
#pragma unroll
      for (int w = 0; w < 8; ++w) { u32x4 t = *reinterpret_cast<const u32x4*>(kp + w * 8);
#pragma unroll
        for (int e = 0; e < 4; ++e) s += q[w * 8 + 2 * e] * bflo(t[e]) + q[w * 8 + 2 * e + 1] * bfhi(t[e]); }
      const float mn = fmaxf(mx, s); const float al = __expf(mx - mn), pp = __expf(s - mn); mx = mn; ls = ls * al + pp;
      const u16* vp = P + (size_t)krow * INW + 1792 + h * 128 + vq * 32;
#pragma unroll
      for (int w = 0; w < 4; ++w) { u32x4 t = *reinterpret_cast<const u32x4*>(vp + w * 8);
#pragma unroll
        for (int e = 0; e < 4; ++e) { o[w * 8 + 2 * e] = o[w * 8 + 2 * e] * al + pp * bflo(t[e]); o[w * 8 + 2 * e + 1] = o[w * 8 + 2 * e + 1] * al + pp * bfhi(t[e]); } }
    }
    const float inv = 1.f / ls;
    if (mp == 0) {
#pragma unroll
      for (int d = 0; d < 32; ++d) res[d] = o[d] * inv;
    } else {
#pragma unroll
      for (int d = 0; d < 32; ++d) res[d] = res[d] - lam * o[d] * inv;
    }
  }
  float ss = 0.f;
#pragma unroll
  for (int d = 0; d < 32; ++d) ss += res[d] * res[d];
  ss += __shfl_xor(ss, 1, 64); ss += __shfl_xor(ss, 2, 64);
  const float r = rsqrtf(ss * (1.f / 128.f) + LN_EPS) * (1.f - lam_init);
  const float* sg = c.in(I_SUBLN) + l * 128 + vq * 32;
  u16* yp = YC + (size_t)qrow * 512 + h * 128 + vq * 32;
#pragma unroll
  for (int w = 0; w < 4; ++w) { u32x4 t;
#pragma unroll
    for (int e = 0; e < 4; ++e) t[e] = pack2(res[w * 8 + 2 * e] * r * sg[w * 8 + 2 * e], res[w * 8 + 2 * e + 1] * r * sg[w * 8 + 2 * e + 1]);
    *reinterpret_cast<u32x4*>(yp + w * 8) = t; }
}

__device__ __forceinline__ void step_mix_b(const Ctx& c, int l, bool last) {
  const int n_att = 512, n_attc = last ? 0 : 32, n_s5 = 4 * 64, n_s5c = last ? 0 : 16;
  const int total = n_att + n_attc + n_s5 + n_s5c;
  for (int it = blockIdx.x; it < total; it += gridDim.x) {
    int i = it;
    if (i < n_att) { const int bh = i >> 5, qb = i & 31; attn_naive_item(c, l, bh >> 2, bh & 3, qb, 0); continue; }
    i -= n_att;
    if (i < n_attc) { const int bh = i >> 1; attn_naive_item(c, l, bh >> 2, bh & 3, i & 1, 1); continue; }
    i -= n_attc;
    if (i < n_s5) { s5_out_item(c, l, i >> 6, 0, i & 63); continue; }
    i -= n_s5;
    s5_out_item(c, l, i >> 2, 1, i & 3);
  }
}

__device__ __forceinline__ void step_merge(const Ctx& c, int l, bool last) {
  const char* wl = c.p.ws + OFF_WS + (size_t)l * WS_LAYER;
  const u16* WGLU = (const u16*)(wl + WS_GLU); const u16* WGM = (const u16*)(wl + WS_GM); const u16* WDA = (const u16*)(wl + WS_DA);
  const u16* P = c.w<u16>(OFF_BIG + BIG_P); const u16* YA = c.w<u16>(OFF_BIG + BIG_YA); const u16* YB = c.w<u16>(OFF_BIG + BIG_YB); const u16* YC = c.w<u16>(OFF_BIG + BIG_YC);
  u16* Mb = c.w<u16>(OFF_BIG + BIG_M);
  const int wm = c.wid >> 1, wn = c.wid & 1, fr = c.lane & 15, fq = c.lane >> 4;
  const int ntm = last ? 64 : 68;
  for (int it = blockIdx.x; it < ntm * 16; it += gridDim.x) {
    const int tm = it >> 4, tn = it & 15;
    f32x4 am[4][2];
    { f32x4 t[4][4]; ZERO_ACC(t);
      gemm_acc_t<4>(t, [&](int r) { return YA + (size_t)(tm * 256 + r) * 256; },
                    [&](int b) { const int wn_ = b >> 6, nn = (b >> 4) & 3, f_ = b & 15; return WGLU + (size_t)((nn >> 1) * 1024 + tn * 64 + wn_ * 32 + (nn & 1) * 16 + f_) * 256; }, 256, c.lds);
      { EPI_ROWS(tm * 256)
          const u16* gp = P + (size_t)row * INW + 2304 + tn * 64 + wn * 32 + fr;
#pragma unroll
          for (int n = 0; n < 2; ++n) am[m][n][j] = bf2f(gp[n * 16]) * t[m][n][j] * sigmoidf_(t[m][n + 2][j]);
        EPI_END } }
    { f32x4 t[4][2];
#pragma unroll
      for (int m = 0; m < 4; ++m) { t[m][0] = (f32x4){0.f, 0.f, 0.f, 0.f}; t[m][1] = (f32x4){0.f, 0.f, 0.f, 0.f}; }
      gemm_acc_t<2>(t, [&](int r) { return YB + (size_t)(tm * 256 + r) * 256; }, [&](int b) { return WGM + (size_t)(tn * 64 + b) * 256; }, 256, c.lds);
      { EPI_ROWS(tm * 256)
          const u16* gp = P + (size_t)row * INW + 2304 + 1024 + tn * 64 + wn * 32 + fr;
#pragma unroll
          for (int n = 0; n < 2; ++n) am[m][n][j] += bf2f(gp[n * 16]) * t[m][n][j];
        EPI_END } }
    { f32x4 t[4][2];
#pragma unroll
      for (int m = 0; m < 4; ++m) { t[m][0] = (f32x4){0.f, 0.f, 0.f, 0.f}; t[m][1] = (f32x4){0.f, 0.f, 0.f, 0.f}; }
      gemm_acc_t<2>(t, [&](int r) { return YC + (size_t)(tm * 256 + r) * 512; }, [&](int b) { return WDA + (size_t)(tn * 64 + b) * 512; }, 512, c.lds);
      { EPI_ROWS(tm * 256)
          const u16* gp = P + (size_t)row * INW + 2304 + 2048 + tn * 64 + wn * 32 + fr;
          u16* dst = Mb + (size_t)row * 1024 + tn * 64 + wn * 32 + fr;
#pragma unroll
          for (int n = 0; n < 2; ++n) dst[n * 16] = f2bf(am[m][n][j] + bf2f(gp[n * 16]) * t[m][n][j]);
        EPI_END } }
  }
}

__device__ __forceinline__ void step_out(const Ctx& c, int l, bool last) {
  const u16* WOUT = (const u16*)(c.p.ws + OFF_WS + (size_t)l * WS_LAYER + WS_OUT);
  const u16* Mb = c.w<u16>(OFF_BIG + BIG_M); float* H = c.w<float>(OFF_H);
  const int wm = c.wid >> 1, wn = c.wid & 1, fr = c.lane & 15, fq = c.lane >> 4;
  const int ntm = last ? 64 : 68;
  for (int it = blockIdx.x; it < ntm * 8; it += gridDim.x) {
    const int tm = it >> 3, tn = it & 7;
    f32x4 acc[4][4]; ZERO_ACC(acc);
    gemm_acc(acc, [&](int r) { return Mb + (size_t)(tm * 256 + r) * 1024; }, [&](int b) { return WOUT + (size_t)(tn * 128 + b) * 1024; }, 1024, c.lds);
    { EPI_ROWS(tm * 256)
        const int cb = tn * 128 + wn * 64 + fr;
        const float* hs = (l == 0) ? (row < TLAT ? c.in(I_X) + (size_t)row * 1024 : c.in(I_CTX) + (size_t)(row - TLAT) * 1024) : H + (size_t)row * 1024;
        const float* g1 = c.mod(l, brow_of(row), 2);
        float* hd = H + (size_t)row * 1024;
#pragma unroll
        for (int n = 0; n < 4; ++n) hd[cb + n * 16] = ALPHA * hs[cb + n * 16] + g1[cb + n * 16] * acc[m][n][j];
      EPI_END }
  }
}

__device__ __forceinline__ void step_ln_mid(const Ctx& c, int l, int mrows) {
  float* H = c.w<float>(OFF_H); u16* F = c.w<u16>(OFF_ACT);
  for (int it = blockIdx.x; it < mrows / 8; it += gridDim.x) {
    const int row = it * 8 + c.wid; float v[16]; load_row(H + (size_t)row * 1024, c.lane, v);
    ln_affine(v, c.in(I_LN1G) + l * 1024, c.in(I_LN1B) + l * 1024, c.lane);
    store_row(H + (size_t)row * 1024, c.lane, v);
    const int br = brow_of(row);
    ln_mod_store(v, c.mod(l, br, 3), c.mod(l, br, 4), F + (size_t)row * 1024, c.lane);
  }
}

__device__ __forceinline__ void step_router(const Ctx& c, int l, int mrows, int halfrows) {
  const u16* F = c.w<u16>(OFF_ACT); const u16* WR = (const u16*)(c.p.ws + OFF_WS + (size_t)l * WS_LAYER + WS_R);
  int* cnt = c.w<int>(OFF_CNT) + l * 128; int* list = c.w<int>(OFF_LIST); float* topw = c.w<float>(OFF_TOPW);
  const int wm = c.wid >> 1, wn = c.wid & 1, fr = c.lane & 15, fq = c.lane >> 4, lane = c.lane;
  float* lg = reinterpret_cast<float*>(c.lds);
  for (int it = blockIdx.x; it < mrows / 256; it += gridDim.x) {
    f32x4 acc[4][4]; ZERO_ACC(acc);
    gemm_acc(acc, [&](int r) { return F + (size_t)(it * 256 + r) * 1024; },
             [&](int b) { const int wn_ = b >> 6, nn = (b >> 4) & 3, f_ = b & 15; return WR + (size_t)((nn >> 1) * 64 + wn_ * 32 + (nn & 1) * 16 + f_) * 1024; }, 1024, c.lds);
    { EPI_ROWS(0)
#pragma unroll
        for (int n = 0; n < 2; ++n) lg[row * 64 + wn * 32 + n * 16 + fr] = acc[m][n][j] + acc[m][n + 2][j];
      EPI_END }
    __syncthreads();
    const float bias = c.in(I_BR)[l * 64 + lane];
    for (int rr = 0; rr < 32; ++rr) {
      const int row = c.wid * 32 + rr; const int tok = it * 256 + row;
      const float score = sigmoidf_(lg[row * 64 + lane]); const float sel = score + bias;
      float m1 = sel;
      m1 = fmaxf(m1, __shfl_xor(m1, 1, 64)); m1 = fmaxf(m1, __shfl_xor(m1, 2, 64)); m1 = fmaxf(m1, __shfl_xor(m1, 4, 64));
      const unsigned long long bm = __ballot(sel == m1);
      const unsigned grp = (unsigned)((bm >> (lane & ~7)) & 0xffull);
      const int first = __ffs((int)grp) - 1;
      float s2 = ((lane & 7) == first) ? -3.0e38f : sel;
      s2 = fmaxf(s2, __shfl_xor(s2, 1, 64)); s2 = fmaxf(s2, __shfl_xor(s2, 2, 64)); s2 = fmaxf(s2, __shfl_xor(s2, 4, 64));
      const float gs = m1 + s2; const int g8 = lane >> 3;
      int cg = 0;
#pragma unroll
      for (int jg = 0; jg < 8; ++jg) { const float gj = __shfl(gs, jg * 8, 64); cg += (gj > gs || (gj == gs && jg < g8)) ? 1 : 0; }
      const bool allowed = cg < 4;
      const float sm = allowed ? sel : -3.0e38f;
      float* smb = reinterpret_cast<float*>(c.lds + 65536) + c.wid * 64;
      smb[lane] = sm;
      __builtin_amdgcn_wave_barrier(); asm volatile("s_waitcnt lgkmcnt(0)" ::: "memory");
      int rk = 0;
#pragma unroll 8
      for (int je = 0; je < 64; ++je) { const float sj = smb[je]; rk += (sj > sm || (sj == sm && je < lane)) ? 1 : 0; }
      __builtin_amdgcn_wave_barrier();
      const bool selected = allowed && rk < 8;
      const float wsum = wave_sum(selected ? score : 0.f);
      if (selected) {
        const int hh = tok >= halfrows ? 1 : 0;
        topw[(size_t)tok * 8 + rk] = score / wsum * 2.5f;
        const int pos = atomicAdd(&cnt[hh * 64 + lane], 1);
        list[((size_t)hh * 64 + lane) * 8704 + pos] = tok * 8 + rk;
      }
    }
    __syncthreads();
  }
}

__device__ __forceinline__ int moe_schedule(const Ctx& c, int l, int hh, int halfrows, int* pre  , int* cn  ) {
  const int* cnt = c.w<int>(OFF_CNT) + l * 128 + hh * 64;
  if (c.tid == 0) { int s = 0; for (int e = 0; e < 65; ++e) { int n = e < 64 ? cnt[e] : halfrows; cn[e] = n; pre[e] = s; s += (n + 255) >> 8; } pre[65] = s; }
  __syncthreads();
  return pre[65];
}
#define MOE_LDS_OFF GEMM_LDS

__device__ __forceinline__ void step_moe_up(const Ctx& c, int l, int hh, int halfrows) {
  int* pre = reinterpret_cast<int*>(c.lds + MOE_LDS_OFF); int* cn = pre + 72;
  const int RT = moe_schedule(c, l, hh, halfrows, pre, cn);
  const u16* F = c.w<u16>(OFF_ACT); const int* list = c.w<int>(OFF_LIST) + (size_t)hh * 64 * 8704;
  u16* HD = c.w<u16>(OFF_BIG + BIG_HD); u16* HS = c.w<u16>(OFF_BIG + BIG_HS);
  const int wm = c.wid >> 1, wn = c.wid & 1, fr = c.lane & 15, fq = c.lane >> 4;
  const int tok0 = hh * halfrows;
  for (int it = blockIdx.x; it < RT * 4; it += gridDim.x) {
    const int rt = it >> 2, tn = it & 3;
    int e = 0; while (pre[e + 1] <= rt) ++e;
    const int rti = rt - pre[e], ne = cn[e];
    const int* le = list + (size_t)e * 8704;
    const u16* WGU = (const u16*)(c.p.ws + OFF_WE + (size_t)e * WE_ONE);
    f32x4 acc[4][4]; ZERO_ACC(acc);
    gemm_acc(acc, [&](int r) { int idx = rti * 256 + r; if (idx >= ne) idx = 0; const int tok = e < 64 ? (le[idx] >> 3) : tok0 + idx; return F + (size_t)tok * 1024; },
             [&](int b) { const int wn_ = b >> 6, nn = (b >> 4) & 3, f_ = b & 15; return WGU + (size_t)((nn >> 1) * 256 + tn * 64 + wn_ * 32 + (nn & 1) * 16 + f_) * 1024; }, 1024, c.lds);
    { EPI_ROWS(rti * 256)
        const int idx = row;
        if (idx < ne) {
          u16* dst = e < 64 ? HD + (size_t)(le[idx] - tok0 * 8) * 256 : HS + (size_t)idx * 256;
#pragma unroll
          for (int n = 0; n < 2; ++n) dst[tn * 64 + wn * 32 + n * 16 + fr] = f2bf(silu_(acc[m][n][j]) * acc[m][n + 2][j]);
        }
      EPI_END }
  }
}
__device__ __forceinline__ void step_moe_down(const Ctx& c, int l, int hh, int halfrows) {
  int* pre = reinterpret_cast<int*>(c.lds + MOE_LDS_OFF); int* cn = pre + 72;
  const int RT = moe_schedule(c, l, hh, halfrows, pre, cn);
  const int* list = c.w<int>(OFF_LIST) + (size_t)hh * 64 * 8704; const float* topw = c.w<float>(OFF_TOPW);
  const u16* HD = c.w<u16>(OFF_BIG + BIG_HD); const u16* HS = c.w<u16>(OFF_BIG + BIG_HS); u16* YR = c.w<u16>(OFF_BIG + BIG_YR); float* H = c.w<float>(OFF_H);
  const int wm = c.wid >> 1, wn = c.wid & 1, fr = c.lane & 15, fq = c.lane >> 4;
  const int tok0 = hh * halfrows;
  for (int it = blockIdx.x; it < RT * 8; it += gridDim.x) {
    const int rt = it >> 3, tn = it & 7;
    int e = 0; while (pre[e + 1] <= rt) ++e;
    const int rti = rt - pre[e], ne = cn[e];
    const int* le = list + (size_t)e * 8704;
    const u16* WD = (const u16*)(c.p.ws + OFF_WE + (size_t)e * WE_ONE + WE_GU);
    f32x4 acc[4][4]; ZERO_ACC(acc);
    gemm_acc(acc, [&](int r) { int idx = rti * 256 + r; if (idx >= ne) idx = 0; return e < 64 ? HD + (size_t)(le[idx] - tok0 * 8) * 256 : HS + (size_t)idx * 256; },
             [&](int b) { return WD + (size_t)(tn * 128 + b) * 256; }, 256, c.lds);
    { EPI_ROWS(rti * 256)
        const int idx = row;
        if (idx < ne) {
          if (e < 64) { const int ent = le[idx]; const float wv = topw[ent]; u16* dst = YR + (size_t)(ent - tok0 * 8) * 1024 + tn * 128 + wn * 64 + fr;
#pragma unroll
            for (int n = 0; n < 4; ++n) dst[n * 16] = f2bf(wv * acc[m][n][j]);
          } else { const int tok = tok0 + idx; float* dst = H + (size_t)tok * 1024 + tn * 128 + wn * 64 + fr; const float* g2 = c.mod(l, brow_of(tok), 5) + tn * 128 + wn * 64 + fr;
#pragma unroll
            for (int n = 0; n < 4; ++n) dst[n * 16] = ALPHA * dst[n * 16] + g2[n * 16] * acc[m][n][j];
          }
        }
      EPI_END }
  }
}
__device__ __forceinline__ void step_combine(const Ctx& c, int l, bool last, int hh, int halfrows) {
  float* H = c.w<float>(OFF_H); const u16* YR = c.w<u16>(OFF_BIG + BIG_YR); u16* U = c.w<u16>(OFF_ACT);
  const int tok0 = hh * halfrows;
  for (int it = blockIdx.x; it < halfrows / 8; it += gridDim.x) {
    const int tok = tok0 + it * 8 + c.wid; float v[16]; load_row(H + (size_t)tok * 1024, c.lane, v);
    float s[16];
#pragma unroll
    for (int i = 0; i < 16; ++i) s[i] = 0.f;
#pragma unroll
    for (int k = 0; k < 8; ++k) { const u16* yr = YR + ((size_t)(tok - tok0) * 8 + k) * 1024;
#pragma unroll
      for (int i = 0; i < 4; ++i) { uint2 t = *reinterpret_cast<const uint2*>(yr + (i * 64 + c.lane) * 4); s[i * 4] += bflo(t.x); s[i * 4 + 1] += bfhi(t.x); s[i * 4 + 2] += bflo(t.y); s[i * 4 + 3] += bfhi(t.y); } }
    const float* g2 = c.mod(l, brow_of(tok), 5);
#pragma unroll
    for (int i = 0; i < 4; ++i) { float4 g = *reinterpret_cast<const float4*>(g2 + (i * 64 + c.lane) * 4);
      v[i * 4] += g.x * s[i * 4]; v[i * 4 + 1] += g.y * s[i * 4 + 1]; v[i * 4 + 2] += g.z * s[i * 4 + 2]; v[i * 4 + 3] += g.w * s[i * 4 + 3]; }
    ln_affine(v, c.in(I_LN2G) + l * 1024, c.in(I_LN2B) + l * 1024, c.lane);
    if (last) { store_row(c.p.out + (size_t)tok * 1024, c.lane, v); }
    else { store_row(H + (size_t)tok * 1024, c.lane, v); const int br = brow_of(tok);
      ln_mod_store(v, c.mod(l + 1, br, 0), c.mod(l + 1, br, 1), U + (size_t)tok * 1024, c.lane); }
  }
}

#ifdef ONLY
__device__ __forceinline__ void run_step_only(const Ctx& c) {
  const int l_ = 0; const bool last_ = false;
  if (ONLY == 0) step_prep(c); if (ONLY == 1) step_ln_in(c); if (ONLY == 2) step_gemm_in(c, l_); if (ONLY == 3) step_mix_a(c, l_, last_); if (ONLY == 4) step_mix_b(c, l_, last_);
  if (ONLY == 5) step_merge(c, l_, last_); if (ONLY == 6) step_out(c, l_, last_); if (ONLY == 7) step_ln_mid(c, l_, MTOT); if (ONLY == 8) step_router(c, l_, MTOT, 8704);
  if (ONLY == 9) step_moe_up(c, l_, 0, 8704); if (ONLY == 10) step_moe_down(c, l_, 0, 8704); if (ONLY == 11) step_combine(c, l_, last_, 0, 8704);
}
#endif
#define N_STEPS 28
template <int L>
__device__ __forceinline__ void run_layer_step(const Ctx& c, int k) {
  constexpr bool last = (L == 1);
  constexpr int mrows = last ? TLAT : MTOT, halfrows = mrows / 2;
  switch (k) {
    case 0: step_gemm_in(c, L); break;
    case 1: step_mix_a(c, L, last); break;
    case 2: step_mix_b(c, L, last); break;
    case 3: step_merge(c, L, last); break;
    case 4: step_out(c, L, last); break;
    case 5: step_ln_mid(c, L, mrows); break;
    case 6: step_router(c, L, mrows, halfrows); break;
    case 7: step_moe_up(c, L, 0, halfrows); break;
    case 8: step_moe_down(c, L, 0, halfrows); break;
    case 9: step_combine(c, L, last, 0, halfrows); break;
    case 10: step_moe_up(c, L, 1, halfrows); break;
    case 11: step_moe_down(c, L, 1, halfrows); break;
    default: step_combine(c, L, last, 1, halfrows); break;
  }
}

#define LDS_BYTES (GEMM_LDS + 1024 + 512)
__global__ void __launch_bounds__(NTHR, 2) fwd_kernel(Params p) {
  extern __shared__ __attribute__((aligned(16))) char lds[];
  Ctx c; c.p.ws = p.ws; c.p.out = p.out; c.lds = lds; c.tid = threadIdx.x; c.lane = threadIdx.x & 63; c.wid = __builtin_amdgcn_readfirstlane(threadIdx.x >> 6);
  if (threadIdx.x == 0) {
    const float** tab = reinterpret_cast<const float**>(lds + PTR_TAB_OFF);
#pragma unroll
    for (int i = 0; i < N_IN; ++i) tab[i] = p.in[i];
  }
  __syncthreads();
  const int lo = p.s_lo, hi = p.s_hi;
#define STEP(S, CALL) do { if (lo <= (S) && (S) < hi) { CALL; if ((S) + 1 < hi) cg::this_grid().sync(); } } while (0)
#ifdef ONLY
  run_step_only(c);
#else
  STEP(0, step_prep(c));
  STEP(1, step_ln_in(c));
#define LSTEP(L, K) STEP(2 + 13 * (L) + (K), run_layer_step<L>(c, K))
  LSTEP(0, 0); LSTEP(0, 1); LSTEP(0, 2); LSTEP(0, 3); LSTEP(0, 4); LSTEP(0, 5); LSTEP(0, 6); LSTEP(0, 7); LSTEP(0, 8); LSTEP(0, 9); LSTEP(0, 10); LSTEP(0, 11); LSTEP(0, 12);
  LSTEP(1, 0); LSTEP(1, 1); LSTEP(1, 2); LSTEP(1, 3); LSTEP(1, 4); LSTEP(1, 5); LSTEP(1, 6); LSTEP(1, 7); LSTEP(1, 8); LSTEP(1, 9); LSTEP(1, 10); LSTEP(1, 11); LSTEP(1, 12);
#endif
}

extern "C" void kernel_launch(void* const* d_in, const int* in_sizes, int n_in, void* d_out, int out_size, void* d_ws, size_t ws_size, hipStream_t stream) {
  static int grid = 0;
  if (grid == 0) {
    if (n_in != N_IN || ws_size < WS_TOTAL) { fprintf(stderr, "kernel_launch: bad shapes n_in %d ws %zu need %zu\n", n_in, ws_size, (size_t)WS_TOTAL); grid = -1; return; }
    hipFuncSetAttribute((const void*)fwd_kernel, hipFuncAttributeMaxDynamicSharedMemorySize, LDS_BYTES);
    int dev = 0, cus = 0, per_cu = 0; hipGetDevice(&dev); hipDeviceGetAttribute(&cus, hipDeviceAttributeMultiprocessorCount, dev);
    hipOccupancyMaxActiveBlocksPerMultiprocessor(&per_cu, (const void*)fwd_kernel, NTHR, LDS_BYTES);
    if (per_cu < 1) { fprintf(stderr, "kernel_launch: occupancy query says %d\n", per_cu); grid = -1; return; }
    grid = cus;
  }
  if (grid < 0) return;
  hipMemsetAsync(d_ws, 0, ZERO_BYTES, stream);
  Params p{};
  for (int i = 0; i < N_IN; ++i) p.in[i] = (const float*)d_in[i];
  p.out = (float*)d_out; p.ws = (char*)d_ws;
#if N_LAUNCH_MODE == 1
  p.s_lo = 0; p.s_hi = N_STEPS;
  void* args[] = {&p};
  hipError_t e = hipLaunchCooperativeKernel((const void*)fwd_kernel, dim3(grid), dim3(NTHR), args, LDS_BYTES, stream);
  if (e != hipSuccess) fprintf(stderr, "cooperative launch failed: %s (grid %d)\n", hipGetErrorString(e), grid);
#else
  for (int s = 0; s < N_STEPS; ++s) { p.s_lo = s; p.s_hi = s + 1; hipLaunchKernelGGL(fwd_kernel, dim3(grid), dim3(NTHR), LDS_BYTES, stream, p); }
#endif
}
```

```cpp
#include <hip/hip_runtime.h>
#include <hip/hip_cooperative_groups.h>
#include <stdint.h>
#include <cstdio>
namespace cg = cooperative_groups;

#ifndef N_LAUNCH_MODE
#define N_LAUNCH_MODE 1
#endif

typedef unsigned short u16;
typedef __attribute__((ext_vector_type(8))) short bf16x8;
typedef __attribute__((ext_vector_type(4))) float f32x4;
typedef __attribute__((ext_vector_type(4))) unsigned u32x4;

#define DM     1024
#define NBATCH 4
#define SEQ    4096
#define CTXL   256
#define TLAT   16384
#define TCTX   1024
#define MTOT   17408
#define INW    5376
#define NTHR   512
#define ALPHA  1.41421356237309515f
#define LN_EPS 1e-5f
#define NCHK   68

enum { I_X = 0, I_C, I_CTX, I_CCTX, I_WMOD, I_BMOD, I_WIN, I_LRE, I_LIM, I_LSTEP, I_BRE, I_BIM, I_CRE, I_CIM, I_S5D,
       I_GMW, I_GMB, I_DALAM, I_SUBLN, I_GLUV, I_GLUG, I_PGM, I_PDA, I_WOUT, I_LN1G, I_LN1B, I_LN2G, I_LN2B,
       I_WR, I_BR, I_EG, I_EU, I_ED, I_SG, I_SU, I_SD, N_IN };

constexpr size_t al256(size_t x) { return (x + 255) / 256 * 256; }
constexpr size_t OFF_BAR   = 0;
constexpr size_t OFF_CNT   = 16384;
constexpr size_t ZERO_BYTES = 20480;
constexpr size_t OFF_MOD   = 32768;
constexpr size_t OFF_S5A   = OFF_MOD + al256(2 * 5 * 6144 * 4);
constexpr size_t OFF_S5A64 = OFF_S5A + 32768;
constexpr size_t OFF_S5BB  = OFF_S5A64 + 32768;
constexpr size_t OFF_ROPE  = OFF_S5BB + 524288;
constexpr size_t OFF_E     = OFF_ROPE + 8192;
constexpr size_t OFF_LIST  = OFF_E + al256((size_t)4 * 2 * NCHK * 16 * 64 * 2 * 4);
constexpr size_t OFF_TOPW  = OFF_LIST + al256((size_t)2 * 64 * 8704 * 4);
constexpr size_t OFF_WS    = OFF_TOPW + al256((size_t)MTOT * 8 * 4);
constexpr size_t WS_WIN = 0, WS_GLU = WS_WIN + (size_t)INW * 1024 * 2, WS_GM = WS_GLU + 2048 * 256 * 2,
                 WS_DA = WS_GM + 1024 * 256 * 2, WS_OUT = WS_DA + 1024 * 512 * 2, WS_R = WS_OUT + 1024 * 1024 * 2,
                 WS_LAYER = WS_R + 128 * 1024 * 2;
constexpr size_t OFF_WE    = OFF_WS + 2 * WS_LAYER;
constexpr size_t WE_GU = (size_t)512 * 1024 * 2, WE_D = (size_t)1024 * 256 * 2, WE_ONE = WE_GU + WE_D;
constexpr size_t OFF_H     = OFF_WE + 65 * WE_ONE;
constexpr size_t OFF_ACT   = OFF_H + (size_t)MTOT * 1024 * 4;
constexpr size_t OFF_BIG   = OFF_ACT + (size_t)MTOT * 1024 * 2;
constexpr size_t BIG_P = 0, BIG_YA = BIG_P + (size_t)MTOT * INW * 2, BIG_YB = BIG_YA + (size_t)MTOT * 256 * 2,
                 BIG_YC = BIG_YB + (size_t)MTOT * 256 * 2, BIG_M = BIG_YC + (size_t)MTOT * 512 * 2,
                 BIG_END = BIG_M + (size_t)MTOT * 1024 * 2;
constexpr size_t BIG_YR = 0, BIG_HD = BIG_YR + (size_t)8704 * 8 * 1024 * 2, BIG_HS = BIG_HD + (size_t)8704 * 8 * 256 * 2,
                 BIG_END2 = BIG_HS + (size_t)8704 * 256 * 2;
static_assert(BIG_END2 <= BIG_END, "moe scratch must fit");
constexpr size_t WS_TOTAL = OFF_BIG + BIG_END;

struct Params { const float* in[N_IN]; float* out; char* ws; int s_lo, s_hi; };

__device__ __forceinline__ u16 f2bf(float f) { unsigned u = __float_as_uint(f); u += 0x7fffu + ((u >> 16) & 1u); return (u16)(u >> 16); }
__device__ __forceinline__ float bf2f(u16 h) { return __uint_as_float(((unsigned)h) << 16); }
__device__ __forceinline__ float bflo(unsigned w) { return __uint_as_float(w << 16); }
__device__ __forceinline__ float bfhi(unsigned w) { return __uint_as_float(w & 0xffff0000u); }
__device__ __forceinline__ unsigned pack2(float a, float b) { return (unsigned)f2bf(a) | ((unsigned)f2bf(b) << 16); }
__device__ __forceinline__ float wave_sum(float v) {
#pragma unroll
  for (int m = 32; m >= 1; m >>= 1) v += __shfl_xor(v, m, 64);
  return v;
}
__device__ __forceinline__ float sigmoidf_(float x) { return 1.f / (1.f + __expf(-x)); }
__device__ __forceinline__ float gelu_tanh(float x) {
  float t = 0.7978845608028654f * (x + 0.044715f * x * x * x);
  float e = __expf(2.f * t);
  float th = 1.f - 2.f / (e + 1.f);
  return 0.5f * x * (1.f + th);
}
__device__ __forceinline__ float silu_(float x) { return x / (1.f + __expf(-x)); }

#define A_STAGE 32768
#define B_STAGE 16384
#define STAGE_BYTES 49152
#define GEMM_LDS (2 * STAGE_BYTES)

__device__ __forceinline__ void glds16(const void* g, void* l) {
  __builtin_amdgcn_global_load_lds((const __attribute__((address_space(1))) void*)g, (__attribute__((address_space(3))) void*)l, 16, 0, 0);
}

template <int NF, class AF, class BF>
__device__ __forceinline__ void gemm_acc_t(f32x4 (&acc)[4][NF], AF arow, BF brow, int K, char* lds) {
  const int tid = threadIdx.x, lane = tid & 63, wid = tid >> 6, wm = wid >> 1, wn = wid & 1, fr = lane & 15, fq = lane >> 4;
  constexpr int NB = NF / 2;
  int tidz = tid; asm volatile("" : "+v"(tidz));
  const u16* ap[4]; const u16* bp[NB];
#pragma unroll
  for (int i = 0; i < 4; ++i) { int idx = i * NTHR + tidz, row = idx >> 3, c = (idx & 7) ^ (row & 7); ap[i] = arow(row) + c * 8; }
#pragma unroll
  for (int i = 0; i < NB; ++i) { int idx = i * NTHR + tidz, row = idx >> 3, c = (idx & 7) ^ (row & 7); bp[i] = brow(row) + c * 8; }
  const int nt = K >> 6;
  {
#pragma unroll
    for (int i = 0; i < 4; ++i) glds16(ap[i], lds + (i * NTHR + tid) * 16);
#pragma unroll
    for (int i = 0; i < NB; ++i) glds16(bp[i], lds + A_STAGE + (i * NTHR + tid) * 16);
  }
  asm volatile("s_waitcnt vmcnt(0)" ::: "memory");
  __syncthreads();
  const int sw = fr & 7;
#pragma unroll 1
  for (int t = 0; t < nt; ++t) {
    char* cur = lds + (t & 1) * STAGE_BYTES;
    if (t + 1 < nt) {
      char* nxt = lds + ((t + 1) & 1) * STAGE_BYTES; const int k0 = (t + 1) << 6;
#pragma unroll
      for (int i = 0; i < 4; ++i) glds16(ap[i] + k0, nxt + (i * NTHR + tid) * 16);
#pragma unroll
      for (int i = 0; i < NB; ++i) glds16(bp[i] + k0, nxt + A_STAGE + (i * NTHR + tid) * 16);
    }
#pragma unroll
    for (int ks = 0; ks < 2; ++ks) {
      bf16x8 At[4], Bt[NF];
      const int coff = (((ks * 4 + fq) ^ sw) << 4);
#pragma unroll
      for (int m = 0; m < 4; ++m) At[m] = *reinterpret_cast<const bf16x8*>(cur + (wm * 64 + m * 16 + fr) * 128 + coff);
#pragma unroll
      for (int n = 0; n < NF; ++n) Bt[n] = *reinterpret_cast<const bf16x8*>(cur + A_STAGE + (wn * NF * 16 + n * 16 + fr) * 128 + coff);
#pragma unroll
      for (int m = 0; m < 4; ++m)
#pragma unroll
        for (int n = 0; n < NF; ++n) acc[m][n] = __builtin_amdgcn_mfma_f32_16x16x32_bf16(At[m], Bt[n], acc[m][n], 0, 0, 0);
    }
    asm volatile("s_waitcnt vmcnt(0)" ::: "memory");
    __syncthreads();
  }
}
template <class AF, class BF>
__device__ __forceinline__ void gemm_acc(f32x4 (&acc)[4][4], AF arow, BF brow, int K, char* lds) { gemm_acc_t<4>(acc, arow, brow, K, lds); }
#define ZERO_ACC(a) do { _Pragma("unroll") for (int _m = 0; _m < 4; ++_m) _Pragma("unroll") for (int _n = 0; _n < 4; ++_n) a[_m][_n] = (f32x4){0.f, 0.f, 0.f, 0.f}; } while (0)

#define EPI_ROWS(ROW0) int _rb = (ROW0) + wm * 64 + fq * 4; asm volatile("" : "+v"(_rb)); \
  _Pragma("unroll") for (int m = 0; m < 4; ++m) { __builtin_amdgcn_sched_barrier(0); _Pragma("unroll") for (int j = 0; j < 4; ++j) { const int row = _rb + m * 16 + j;
#define EPI_END } }

#define PTR_TAB_OFF (GEMM_LDS + 1024)
struct CtxP { char* ws; float* out; };
struct Ctx {
  CtxP p; char* lds; int tid, lane, wid;
  __device__ __forceinline__ const float* in(int i) const { return reinterpret_cast<const float* const*>(lds + PTR_TAB_OFF)[i]; }
  template <typename T> __device__ __forceinline__ T* w(size_t off) const { return reinterpret_cast<T*>(p.ws + off); }
  __device__ __forceinline__ const float* mod(int l, int brow, int chunk) const { return w<float>(OFF_MOD) + ((size_t)(l * 5 + brow) * 6144 + chunk * 1024); }
};
__device__ __forceinline__ int brow_of(int row) { return row < TLAT ? (row >> 12) : 4; }

__device__ __forceinline__ void cvt_tile(const float* __restrict__ src, int N, u16* __restrict__ dst, int dld, int k0, int n0, int roff, float* t) {
  const int tid = threadIdx.x;
  { const int n = tid & 63, kb = tid >> 6;
#pragma unroll
    for (int i = 0; i < 8; ++i) { int k = kb + 8 * i; t[k * 65 + n] = src[(size_t)(k0 + k) * N + n0 + n]; } }
  __syncthreads();
  { const int k = tid & 63, nb = tid >> 6;
#pragma unroll
    for (int i = 0; i < 8; ++i) { int nn = nb + 8 * i; dst[(size_t)(roff + n0 + nn) * dld + k0 + k] = f2bf(t[k * 65 + nn]); } }
  __syncthreads();
}
__device__ __forceinline__ void cvt_router_tile(const float* __restrict__ src, u16* __restrict__ dst, int k0, float* t) {
  const int tid = threadIdx.x;
  { const int n = tid & 63, kb = tid >> 6;
#pragma unroll
    for (int i = 0; i < 8; ++i) { int k = kb + 8 * i; t[k * 65 + n] = src[(size_t)(k0 + k) * 64 + n]; } }
  __syncthreads();
  { const int k = tid & 63, nb = tid >> 6;
#pragma unroll
    for (int i = 0; i < 8; ++i) { int nn = nb + 8 * i; float v = t[k * 65 + nn]; u16 hi = f2bf(v); u16 lo = f2bf(v - bf2f(hi));
      dst[(size_t)nn * 1024 + k0 + k] = hi; dst[(size_t)(64 + nn) * 1024 + k0 + k] = lo; } }
  __syncthreads();
}
#define NCVT_SMALL 1936
__device__ __forceinline__ void cvt_small(const Ctx& c, int l, int t) {
  float* tb = reinterpret_cast<float*>(c.lds);
  char* wl = c.p.ws + OFF_WS + (size_t)l * WS_LAYER;
  if (t < 1344) { cvt_tile(c.in(I_WIN) + (size_t)l * 1024 * INW, INW, (u16*)(wl + WS_WIN), 1024, (t / 84) * 64, (t % 84) * 64, 0, tb); return; }
  t -= 1344;
  if (t < 64) { cvt_tile(c.in(I_GLUV) + (size_t)l * 256 * 1024, 1024, (u16*)(wl + WS_GLU), 256, (t / 16) * 64, (t % 16) * 64, 0, tb); return; }
  t -= 64;
  if (t < 64) { cvt_tile(c.in(I_GLUG) + (size_t)l * 256 * 1024, 1024, (u16*)(wl + WS_GLU), 256, (t / 16) * 64, (t % 16) * 64, 1024, tb); return; }
  t -= 64;
  if (t < 64) { cvt_tile(c.in(I_PGM) + (size_t)l * 256 * 1024, 1024, (u16*)(wl + WS_GM), 256, (t / 16) * 64, (t % 16) * 64, 0, tb); return; }
  t -= 64;
  if (t < 128) { cvt_tile(c.in(I_PDA) + (size_t)l * 512 * 1024, 1024, (u16*)(wl + WS_DA), 512, (t / 16) * 64, (t % 16) * 64, 0, tb); return; }
  t -= 128;
  if (t < 256) { cvt_tile(c.in(I_WOUT) + (size_t)l * 1024 * 1024, 1024, (u16*)(wl + WS_OUT), 1024, (t / 16) * 64, (t % 16) * 64, 0, tb); return; }
  t -= 256;
  cvt_router_tile(c.in(I_WR) + (size_t)l * 1024 * 64, (u16*)(wl + WS_R), t * 64, tb);
}
#define NCVT_EXP (65 * 192)
__device__ __forceinline__ void cvt_expert(const Ctx& c, int l, int t) {
  float* tb = reinterpret_cast<float*>(c.lds);
  const int e = t / 192; int r = t % 192;
  char* we = c.p.ws + OFF_WE + (size_t)e * WE_ONE;
  const float* sg = e < 64 ? c.in(I_EG) + (size_t)(l * 64 + e) * 1024 * 256 : c.in(I_SG) + (size_t)l * 1024 * 256;
  const float* su = e < 64 ? c.in(I_EU) + (size_t)(l * 64 + e) * 1024 * 256 : c.in(I_SU) + (size_t)l * 1024 * 256;
  const float* sd = e < 64 ? c.in(I_ED) + (size_t)(l * 64 + e) * 256 * 1024 : c.in(I_SD) + (size_t)l * 256 * 1024;
  if (r < 64) { cvt_tile(sg, 256, (u16*)we, 1024, (r / 4) * 64, (r % 4) * 64, 0, tb); return; }
  r -= 64;
  if (r < 64) { cvt_tile(su, 256, (u16*)we, 1024, (r / 4) * 64, (r % 4) * 64, 256, tb); return; }
  r -= 64;
  cvt_tile(sd, 1024, (u16*)(we + WE_GU), 256, (r / 16) * 64, (r % 16) * 64, 0, tb);
}

__device__ __forceinline__ void step_prep(const Ctx& c) {
  const int G = gridDim.x;
  const int n_cvt = 2 * NCVT_SMALL, n_mod = 192, n_s5 = 8, n_misc = 1;
  const int total = n_cvt + n_mod + n_s5 + n_misc;
  for (int it = blockIdx.x; it < total; it += G) {
    if (it < n_cvt) { cvt_small(c, it / NCVT_SMALL, it % NCVT_SMALL); continue; }
    int i = it - n_cvt;
    if (i < n_mod) {
      const int l = i / 96, cb = i % 96;
      float* sil = reinterpret_cast<float*>(c.lds);
      float* red = sil + 5 * 1024;
      for (int q = c.tid; q < 5 * 1024; q += NTHR) { int r = q >> 10, k = q & 1023; float v = r < 4 ? c.in(I_C)[r * 1024 + k] : c.in(I_CCTX)[k]; sil[q] = silu_(v); }
      __syncthreads();
      const int col = c.tid & 63, kp = c.tid >> 6;
      float a0 = 0, a1 = 0, a2 = 0, a3 = 0, a4 = 0;
      const float* wm_ = c.in(I_WMOD) + (size_t)l * 1024 * 6144 + cb * 64 + col;
      for (int k = kp * 128; k < kp * 128 + 128; ++k) { float wv = wm_[(size_t)k * 6144];
        a0 += sil[k] * wv; a1 += sil[1024 + k] * wv; a2 += sil[2048 + k] * wv; a3 += sil[3072 + k] * wv; a4 += sil[4096 + k] * wv; }
      red[(kp * 5 + 0) * 64 + col] = a0; red[(kp * 5 + 1) * 64 + col] = a1; red[(kp * 5 + 2) * 64 + col] = a2;
      red[(kp * 5 + 3) * 64 + col] = a3; red[(kp * 5 + 4) * 64 + col] = a4;
      __syncthreads();
      if (c.tid < 320) { int r = c.tid >> 6, cc = c.tid & 63; float s = 0;
#pragma unroll
        for (int q = 0; q < 8; ++q) s += red[(q * 5 + r) * 64 + cc];
        s += c.in(I_BMOD)[l * 6144 + cb * 64 + cc];
        c.w<float>(OFF_MOD)[(size_t)(l * 5 + r) * 6144 + cb * 64 + cc] = s; }
      __syncthreads();
      continue;
    }
    i -= n_mod;
    if (i < n_s5) {
      const int q = i * NTHR + c.tid;
      const int ldg = q >> 6;
      const float dt = expf(c.in(I_LSTEP)[ldg]);
      const float lr = c.in(I_LRE)[q], li = c.in(I_LIM)[q];
      const float mag = expf(lr * dt);
      float sn, cs; sincosf(li * dt, &sn, &cs);
      const float are = mag * cs, aim = mag * sn;
      const float den = lr * lr + li * li, nre = are - 1.f;
      const float zre = (nre * lr + aim * li) / den, zim = (aim * lr - nre * li) / den;
      float* A = c.w<float>(OFF_S5A); float* A64 = c.w<float>(OFF_S5A64); float* BB = c.w<float>(OFF_S5BB);
      A[q * 2] = are; A[q * 2 + 1] = aim;
      float pr = are, pi = aim;
#pragma unroll
      for (int s = 0; s < 6; ++s) { float nr = pr * pr - pi * pi, ni = 2.f * pr * pi; pr = nr; pi = ni; }
      A64[q * 2] = pr; A64[q * 2 + 1] = pi;
      const float* bre = c.in(I_BRE) + (size_t)q * 16; const float* bim = c.in(I_BIM) + (size_t)q * 16;
#pragma unroll
      for (int cc = 0; cc < 16; ++cc) { float br = bre[cc], bi = bim[cc];
        BB[((size_t)q * 16 + cc) * 2] = zre * br - zim * bi; BB[((size_t)q * 16 + cc) * 2 + 1] = zre * bi + zim * br; }
      continue;
    }
    for (int q = c.tid; q < 64 * 16; q += NTHR) { int pos = q >> 4, f = q & 15;
      float inv = powf(10000.f, -(float)f / 16.f); float ang = (float)pos * inv; float sn, cs; sincosf(ang, &sn, &cs);
      c.w<float>(OFF_ROPE)[q * 2] = cs; c.w<float>(OFF_ROPE)[q * 2 + 1] = sn; }
  }
}

__device__ __forceinline__ void ln_stats(const float (&v)[16], float& mean, float& rstd) {
  float s = 0;
#pragma unroll
  for (int i = 0; i < 16; ++i) s += v[i];
  mean = wave_sum(s) * (1.f / 1024.f);
  float q = 0;
#pragma unroll
  for (int i = 0; i < 16; ++i) { float d = v[i] - mean; q += d * d; }
  rstd = rsqrtf(wave_sum(q) * (1.f / 1024.f) + LN_EPS);
}
__device__ __forceinline__ void load_row(const float* src, int lane, float (&v)[16]) {
#pragma unroll
  for (int i = 0; i < 4; ++i) { float4 t = *reinterpret_cast<const float4*>(src + (i * 64 + lane) * 4); v[i * 4] = t.x; v[i * 4 + 1] = t.y; v[i * 4 + 2] = t.z; v[i * 4 + 3] = t.w; }
}
__device__ __forceinline__ void store_row(float* dst, int lane, const float (&v)[16]) {
#pragma unroll
  for (int i = 0; i < 4; ++i) *reinterpret_cast<float4*>(dst + (i * 64 + lane) * 4) = make_float4(v[i * 4], v[i * 4 + 1], v[i * 4 + 2], v[i * 4 + 3]);
}
__device__ __forceinline__ void store_row_bf(u16* dst, int lane, const float (&v)[16]) {
#pragma unroll
  for (int i = 0; i < 4; ++i) *reinterpret_cast<uint2*>(dst + (i * 64 + lane) * 4) = make_uint2(pack2(v[i * 4], v[i * 4 + 1]), pack2(v[i * 4 + 2], v[i * 4 + 3]));
}
__device__ __forceinline__ void ln_mod_store(const float (&v)[16], const float* sh, const float* sc, u16* dst, int lane) {
  float mean, rstd; ln_stats(v, mean, rstd);
  float o[16];
#pragma unroll
  for (int i = 0; i < 4; ++i) { float4 a = *reinterpret_cast<const float4*>(sh + (i * 64 + lane) * 4), b = *reinterpret_cast<const float4*>(sc + (i * 64 + lane) * 4);
    o[i * 4] = (v[i * 4] - mean) * rstd * (1.f + b.x) + a.x; o[i * 4 + 1] = (v[i * 4 + 1] - mean) * rstd * (1.f + b.y) + a.y;
    o[i * 4 + 2] = (v[i * 4 + 2] - mean) * rstd * (1.f + b.z) + a.z; o[i * 4 + 3] = (v[i * 4 + 3] - mean) * rstd * (1.f + b.w) + a.w; }
  store_row_bf(dst, lane, o);
}
__device__ __forceinline__ void ln_affine(float (&v)[16], const float* g, const float* b, int lane) {
  float mean, rstd; ln_stats(v, mean, rstd);
#pragma unroll
  for (int i = 0; i < 4; ++i) { float4 a = *reinterpret_cast<const float4*>(g + (i * 64 + lane) * 4), bb = *reinterpret_cast<const float4*>(b + (i * 64 + lane) * 4);
    v[i * 4] = (v[i * 4] - mean) * rstd * a.x + bb.x; v[i * 4 + 1] = (v[i * 4 + 1] - mean) * rstd * a.y + bb.y;
    v[i * 4 + 2] = (v[i * 4 + 2] - mean) * rstd * a.z + bb.z; v[i * 4 + 3] = (v[i * 4 + 3] - mean) * rstd * a.w + bb.w; }
}

__device__ __forceinline__ void step_ln_in(const Ctx& c) {
  u16* U = c.w<u16>(OFF_ACT);
  for (int it = blockIdx.x; it < MTOT / 8; it += gridDim.x) {
    const int row = it * 8 + c.wid;
    const float* src = row < TLAT ? c.in(I_X) + (size_t)row * 1024 : c.in(I_CTX) + (size_t)(row - TLAT) * 1024;
    float v[16]; load_row(src, c.lane, v);
    const int br = brow_of(row);
    ln_mod_store(v, c.mod(0, br, 0), c.mod(0, br, 1), U + (size_t)row * 1024, c.lane);
  }
}

__device__ __forceinline__ void step_gemm_in(const Ctx& c, int l) {
  const u16* U = c.w<u16>(OFF_ACT);
  const u16* W = reinterpret_cast<const u16*>(c.p.ws + OFF_WS + (size_t)l * WS_LAYER + WS_WIN);
  u16* P = c.w<u16>(OFF_BIG + BIG_P);
  const int wm = c.wid >> 1, wn = c.wid & 1, fr = c.lane & 15, fq = c.lane >> 4;
  for (int it = blockIdx.x; it < 68 * 42; it += gridDim.x) {
    const int tm = it / 42, tn = it % 42;
    f32x4 acc[4][4]; ZERO_ACC(acc);
    gemm_acc(acc, [&](int r) { return U + (size_t)(tm * 256 + r) * 1024; }, [&](int b) { return W + (size_t)(tn * 128 + b) * 1024; }, 1024, c.lds);
    const int cls = tn < 2 ? 0 : (tn < 6 ? 1 : (tn < 18 ? 0 : 2));
    { EPI_ROWS(tm * 256)
        u16* dst = P + (size_t)row * INW + tn * 128 + wn * 64 + fr;
#pragma unroll
        for (int n = 0; n < 4; ++n) { float v = acc[m][n][j];
          if (cls == 1) v = gelu_tanh(v); else if (cls == 2) v = sigmoidf_(v);
          dst[n * 16] = f2bf(v); }
      EPI_END }
  }
}

__device__ __forceinline__ void step_mix_a(const Ctx& c, int l, bool last) {
  u16* P = c.w<u16>(OFF_BIG + BIG_P);
  const int n_rope = 1024, n_s5 = 4 * 2 * NCHK, n_gm = (last ? 128 : 136) * 4, n_cv = NCVT_EXP;
  const int total = n_rope + n_s5 + n_gm + n_cv;
  for (int it = blockIdx.x; it < total; it += gridDim.x) {
    int i = it;
    if (i < n_rope) {
      const int gid = i * NTHR + c.tid; const int row = gid >> 5, sub = gid & 31, grp = sub >> 1, half = sub & 1;
      u16* base = P + (size_t)row * INW + 768 + grp * 64 + half * 32;
      const int t = row & 4095; const int pos = half == 0 ? (t >> 6) : (t & 63);
      const float* tab = c.w<float>(OFF_ROPE) + pos * 32;
      u32x4 x1a = *reinterpret_cast<const u32x4*>(base), x1b = *reinterpret_cast<const u32x4*>(base + 8);
      u32x4 x2a = *reinterpret_cast<const u32x4*>(base + 16), x2b = *reinterpret_cast<const u32x4*>(base + 24);
      u32x4 o1a, o1b, o2a, o2b;
#define ROPE2(X1, X2, O1, O2, W, F0) do { float cs0 = tab[(F0) * 2], sn0 = tab[(F0) * 2 + 1], cs1 = tab[(F0) * 2 + 2], sn1 = tab[(F0) * 2 + 3]; \
        float a0 = bflo(X1[W]), a1 = bfhi(X1[W]), b0 = bflo(X2[W]), b1 = bfhi(X2[W]); \
        O1[W] = pack2(a0 * cs0 - b0 * sn0, a1 * cs1 - b1 * sn1); O2[W] = pack2(b0 * cs0 + a0 * sn0, b1 * cs1 + a1 * sn1); } while (0)
      ROPE2(x1a, x2a, o1a, o2a, 0, 0); ROPE2(x1a, x2a, o1a, o2a, 1, 2); ROPE2(x1a, x2a, o1a, o2a, 2, 4); ROPE2(x1a, x2a, o1a, o2a, 3, 6);
      ROPE2(x1b, x2b, o1b, o2b, 0, 8); ROPE2(x1b, x2b, o1b, o2b, 1, 10); ROPE2(x1b, x2b, o1b, o2b, 2, 12); ROPE2(x1b, x2b, o1b, o2b, 3, 14);
#undef ROPE2
      *reinterpret_cast<u32x4*>(base) = o1a; *reinterpret_cast<u32x4*>(base + 8) = o1b;
      *reinterpret_cast<u32x4*>(base + 16) = o2a; *reinterpret_cast<u32x4*>(base + 24) = o2b;
      continue;
    }
    i -= n_rope;
    if (i < n_s5) {
      const int b = i / (2 * NCHK), rem = i % (2 * NCHK), dir = rem / NCHK, ck = rem % NCHK;
      const float* A = c.w<float>(OFF_S5A); const float* BB = c.w<float>(OFF_S5BB); float* E = c.w<float>(OFF_E);
#pragma unroll 1
      for (int gi = 0; gi < 2; ++gi) {
        const int g = c.wid * 2 + gi; const int q = ((l * 2 + dir) * 16 + g) * 64 + c.lane;
        const float are = A[q * 2], aim = A[q * 2 + 1];
        float bbr[16], bbi[16];
#pragma unroll
        for (int cc = 0; cc < 16; ++cc) { float2 t = *reinterpret_cast<const float2*>(BB + ((size_t)q * 16 + cc) * 2); bbr[cc] = t.x; bbi[cc] = t.y; }
        float sr = 0.f, si = 0.f;
        for (int j = 0; j < 64; ++j) {
          const int tau = ck * 64 + j; int row;
          if (tau < 256) row = TLAT + b * 256 + (dir ? 255 - tau : tau); else { int tt = tau - 256; row = b * 4096 + (dir ? 4095 - tt : tt); }
          const u16* up = P + (size_t)row * INW + g * 16;
          u32x4 u0 = *reinterpret_cast<const u32x4*>(up), u1 = *reinterpret_cast<const u32x4*>(up + 8);
          float br = 0.f, bi = 0.f;
#pragma unroll
          for (int w = 0; w < 4; ++w) { float x0 = bflo(u0[w]), x1 = bfhi(u0[w]), y0 = bflo(u1[w]), y1 = bfhi(u1[w]);
            br += bbr[2 * w] * x0 + bbr[2 * w + 1] * x1 + bbr[8 + 2 * w] * y0 + bbr[8 + 2 * w + 1] * y1;
            bi += bbi[2 * w] * x0 + bbi[2 * w + 1] * x1 + bbi[8 + 2 * w] * y0 + bbi[8 + 2 * w + 1] * y1; }
          const float nr = are * sr - aim * si + br, ni = are * si + aim * sr + bi; sr = nr; si = ni;
        }
        *reinterpret_cast<float2*>(E + ((size_t)(((b * 2 + dir) * NCHK + ck) * 16 + g) * 64 + c.lane) * 2) = make_float2(sr, si);
      }
      continue;
    }
    i -= n_s5;
    if (i < n_gm) {
      const int ck = i >> 2, h = i & 3; const int row0 = ck * 128;
      float* vh = reinterpret_cast<float*>(c.lds);
      for (int q = 0; q < 16; ++q) {
        const int s = c.wid * 16 + q; const u16* vp = P + (size_t)(row0 + s) * INW + 512 + c.lane * 4;
        uint2 t = *reinterpret_cast<const uint2*>(vp);
        float v0 = bflo(t.x), v1 = bfhi(t.x), v2 = bflo(t.y), v3 = bfhi(t.y);
        float mean = wave_sum(v0 + v1 + v2 + v3) * (1.f / 256.f);
        float d0 = v0 - mean, d1 = v1 - mean, d2 = v2 - mean, d3 = v3 - mean;
        float rstd = rsqrtf(wave_sum(d0 * d0 + d1 * d1 + d2 * d2 + d3 * d3) * (1.f / 256.f) + LN_EPS);
        if ((c.lane >> 4) == h) *reinterpret_cast<float4*>(vh + s * 64 + (c.lane & 15) * 4) = make_float4(d0 * rstd, d1 * rstd, d2 * rstd, d3 * rstd);
      }
      __syncthreads();
      const int t = c.tid >> 2, cq = c.tid & 3;
      float acc[16];
#pragma unroll
      for (int q = 0; q < 16; ++q) acc[q] = 0.f;
      const float* wrow = c.in(I_GMW) + ((size_t)(l * 4 + h) * 128 + t) * 128;
      for (int s4 = 0; s4 < 32; ++s4) {
        float4 w4 = *reinterpret_cast<const float4*>(wrow + s4 * 4);
        float wv[4] = {w4.x, w4.y, w4.z, w4.w};
#pragma unroll
        for (int ss = 0; ss < 4; ++ss) {
          const float* vr = vh + (s4 * 4 + ss) * 64 + cq * 16;
#pragma unroll
          for (int q4 = 0; q4 < 4; ++q4) { float4 x = *reinterpret_cast<const float4*>(vr + q4 * 4);
            acc[q4 * 4] += wv[ss] * x.x; acc[q4 * 4 + 1] += wv[ss] * x.y; acc[q4 * 4 + 2] += wv[ss] * x.z; acc[q4 * 4 + 3] += wv[ss] * x.w; }
        }
      }
      const float bs = c.in(I_GMB)[(l * 4 + h) * 128 + t];
      const u16* up = P + (size_t)(row0 + t) * INW + 256 + h * 64 + cq * 16;
      u32x4 u0 = *reinterpret_cast<const u32x4*>(up), u1 = *reinterpret_cast<const u32x4*>(up + 8);
      u32x4 o0, o1;
#pragma unroll
      for (int w = 0; w < 4; ++w) { o0[w] = pack2(bflo(u0[w]) * (acc[2 * w] + bs), bfhi(u0[w]) * (acc[2 * w + 1] + bs));
        o1[w] = pack2(bflo(u1[w]) * (acc[8 + 2 * w] + bs), bfhi(u1[w]) * (acc[8 + 2 * w + 1] + bs)); }
      u16* yb = c.w<u16>(OFF_BIG + BIG_YB) + (size_t)(row0 + t) * 256 + h * 64 + cq * 16;
      *reinterpret_cast<u32x4*>(yb) = o0; *reinterpret_cast<u32x4*>(yb + 8) = o1;
      __syncthreads();
      continue;
    }
    i -= n_gm;
    cvt_expert(c, l, i);
  }
}

#define SB_LD 136
__device__ __forceinline__ void s5_out_item(const Ctx& c, int l, int b, int seg, int j) {
  const u16* P = c.w<u16>(OFF_BIG + BIG_P); u16* YA = c.w<u16>(OFF_BIG + BIG_YA);
  const float* A = c.w<float>(OFF_S5A); const float* A64 = c.w<float>(OFF_S5A64); const float* BB = c.w<float>(OFF_S5BB); const float* E = c.w<float>(OFF_E);
  const int r0 = seg ? (TLAT + b * 256 + j * 64) : (b * 4096 + j * 64);
  const int kf = seg ? j : 4 + j, kr = seg ? 3 - j : 4 + (63 - j);
  const int lane = c.lane, fr = lane & 15, fq = lane >> 4;
  float* ubuf = reinterpret_cast<float*>(c.lds + c.wid * 8704);
  u16* sbuf = reinterpret_cast<u16*>(c.lds + c.wid * 8704 + 4096);
#pragma unroll 1
  for (int gi = 0; gi < 2; ++gi) {
    const int g = c.wid * 2 + gi;
    { const u16* up = P + (size_t)(r0 + lane) * INW + g * 16;
      u32x4 u0 = *reinterpret_cast<const u32x4*>(up), u1 = *reinterpret_cast<const u32x4*>(up + 8);
      float* ub = ubuf + lane * 16;
      *reinterpret_cast<float4*>(ub) = make_float4(bflo(u0[0]), bfhi(u0[0]), bflo(u0[1]), bfhi(u0[1]));
      *reinterpret_cast<float4*>(ub + 4) = make_float4(bflo(u0[2]), bfhi(u0[2]), bflo(u0[3]), bfhi(u0[3]));
      *reinterpret_cast<float4*>(ub + 8) = make_float4(bflo(u1[0]), bfhi(u1[0]), bflo(u1[1]), bfhi(u1[1]));
      *reinterpret_cast<float4*>(ub + 12) = make_float4(bflo(u1[2]), bfhi(u1[2]), bflo(u1[3]), bfhi(u1[3])); }
    __builtin_amdgcn_wave_barrier(); asm volatile("s_waitcnt lgkmcnt(0)" ::: "memory");
    f32x4 acc[4];
#pragma unroll
    for (int q = 0; q < 4; ++q) acc[q] = (f32x4){0.f, 0.f, 0.f, 0.f};
#pragma unroll 1
    for (int dir = 0; dir < 2; ++dir) {
      const int q = ((l * 2 + dir) * 16 + g) * 64 + lane;
      const float are = A[q * 2], aim = A[q * 2 + 1], a64r = A64[q * 2], a64i = A64[q * 2 + 1];
      float bbr[16], bbi[16];
#pragma unroll
      for (int cc = 0; cc < 16; ++cc) { float2 t = *reinterpret_cast<const float2*>(BB + ((size_t)q * 16 + cc) * 2); bbr[cc] = t.x; bbi[cc] = t.y; }
      float sr = 0.f, si = 0.f; const int kk = dir ? kr : kf;
      for (int jj = 0; jj < kk; ++jj) { float2 e = *reinterpret_cast<const float2*>(E + ((size_t)(((b * 2 + dir) * NCHK + jj) * 16 + g) * 64 + lane) * 2);
        float nr = a64r * sr - a64i * si + e.x, ni = a64r * si + a64i * sr + e.y; sr = nr; si = ni; }
      bf16x8 Bf[4];
      { const float* cre = c.in(I_CRE) + ((size_t)((l * 2 + dir) * 16 + g) * 16 + fr) * 64; const float* cim = c.in(I_CIM) + ((size_t)((l * 2 + dir) * 16 + g) * 16 + fr) * 64;
#pragma unroll
        for (int ks = 0; ks < 4; ++ks) {
#pragma unroll
          for (int ii = 0; ii < 8; ++ii) { int k = ks * 32 + fq * 8 + ii; float v = ks < 2 ? cre[k] : -cim[k - 64]; Bf[ks][ii] = (short)f2bf(v); } } }
#pragma unroll
      for (int sub = 0; sub < 4; ++sub) {
#pragma unroll 4
        for (int jj = 0; jj < 16; ++jj) {
          const int tau = sub * 16 + jj; const int tl = dir ? 63 - tau : tau;
          const float* ub = ubuf + tl * 16;
          float4 x0 = *reinterpret_cast<const float4*>(ub), x1 = *reinterpret_cast<const float4*>(ub + 4), x2 = *reinterpret_cast<const float4*>(ub + 8), x3 = *reinterpret_cast<const float4*>(ub + 12);
          float br = bbr[0] * x0.x + bbr[1] * x0.y + bbr[2] * x0.z + bbr[3] * x0.w + bbr[4] * x1.x + bbr[5] * x1.y + bbr[6] * x1.z + bbr[7] * x1.w
                   + bbr[8] * x2.x + bbr[9] * x2.y + bbr[10] * x2.z + bbr[11] * x2.w + bbr[12] * x3.x + bbr[13] * x3.y + bbr[14] * x3.z + bbr[15] * x3.w;
          float bi = bbi[0] * x0.x + bbi[1] * x0.y + bbi[2] * x0.z + bbi[3] * x0.w + bbi[4] * x1.x + bbi[5] * x1.y + bbi[6] * x1.z + bbi[7] * x1.w
                   + bbi[8] * x2.x + bbi[9] * x2.y + bbi[10] * x2.z + bbi[11] * x2.w + bbi[12] * x3.x + bbi[13] * x3.y + bbi[14] * x3.z + bbi[15] * x3.w;
          const float nr = are * sr - aim * si + br, ni = are * si + aim * sr + bi; sr = nr; si = ni;
          sbuf[(tl & 15) * SB_LD + lane] = f2bf(sr); sbuf[(tl & 15) * SB_LD + 64 + lane] = f2bf(si);
        }
        __builtin_amdgcn_wave_barrier(); asm volatile("s_waitcnt lgkmcnt(0)" ::: "memory");
        bf16x8 Af[4];
#pragma unroll
        for (int ks = 0; ks < 4; ++ks) Af[ks] = *reinterpret_cast<const bf16x8*>(sbuf + fr * SB_LD + ks * 32 + fq * 8);
        asm volatile("s_waitcnt lgkmcnt(0)" ::: "memory"); __builtin_amdgcn_wave_barrier();
        if (dir == 0) {
#pragma unroll
          for (int ks = 0; ks < 4; ++ks) acc[sub] = __builtin_amdgcn_mfma_f32_16x16x32_bf16(Af[ks], Bf[ks], acc[sub], 0, 0, 0);
        } else {
#pragma unroll
          for (int ks = 0; ks < 4; ++ks) acc[3 - sub] = __builtin_amdgcn_mfma_f32_16x16x32_bf16(Af[ks], Bf[ks], acc[3 - sub], 0, 0, 0);
        }
      }
    }
    const float dsk = c.in(I_S5D)[l * 256 + g * 16 + fr];
#pragma unroll
    for (int tb = 0; tb < 4; ++tb)
#pragma unroll
      for (int jx = 0; jx < 4; ++jx) { const int tl = tb * 16 + fq * 4 + jx; float y = dsk * ubuf[tl * 16 + fr] + acc[tb][jx];
        YA[(size_t)(r0 + tl) * 256 + g * 16 + fr] = f2bf(gelu_tanh(y)); }
    __builtin_amdgcn_wave_barrier(); asm volatile("s_waitcnt lgkmcnt(0)" ::: "memory");
  }
}

__device__ __forceinline__ void attn_naive_item(const Ctx& c, int l, int b, int h, int qb, int seg) {
  const u16* P = c.w<u16>(OFF_BIG + BIG_P); u16* YC = c.w<u16>(OFF_BIG + BIG_YC);
  const int ql = c.tid >> 2, vq = c.tid & 3;
  const int qrow = seg ? (TLAT + b * 256 + qb * 128 + ql) : (b * 4096 + qb * 128 + ql);
  const int nkeys = seg ? 256 : 4352;
  const float lam_init = 0.8f - 0.6f * expf(-0.3f * (float)l);
  float lam;
  { const float* lf = c.in(I_DALAM) + l * 256; float s1 = 0.f, s2 = 0.f;
    for (int d = 0; d < 64; ++d) { s1 += lf[d] * lf[64 + d]; s2 += lf[128 + d] * lf[192 + d]; }
    lam = expf(s1) - expf(s2) + lam_init; }
  float res[32];
#pragma unroll 1
  for (int mp = 0; mp < 2; ++mp) {
    float q[64];
    { const u16* qp = P + (size_t)qrow * INW + 768 + h * 128 + mp * 64;
#pragma unroll
      for (int w = 0; w < 8; ++w) { u32x4 t = *reinterpret_cast<const u32x4*>(qp + w * 8);
#pragma unroll
        for (int e = 0; e < 4; ++e) { q[w * 8 + 2 * e] = bflo(t[e]) * 0.125f; q[w * 8 + 2 * e + 1] = bfhi(t[e]) * 0.125f; } } }
    float o[32];
#pragma unroll
    for (int d = 0; d < 32; ++d) o[d] = 0.f;
    float mx = -1e30f, ls = 0.f;
#pragma unroll 1
    for (int key = 0; key < nkeys; ++key) {
      const int krow = key < 256 ? (TLAT + b * 256 + key) : (b * 4096 + key - 256);
      const u16* kp = P + (size_t)krow * INW + 1280 + h * 128 + mp * 64;
      float s = 0.f;
#pragma unroll
      for (int w = 0; w < 8; ++w) { u32x4 t = *reinterpret_cast<const u32x4*>(kp + w * 8);
#pragma unroll
        for (int e = 0; e < 4; ++e) s += q[w * 8 + 2 * e] * bflo(t[e]) + q[w * 8 + 2 * e + 1] * bfhi(t[e]); }
      const float mn = fmaxf(mx, s); const float al = __expf(mx - mn), pp = __expf(s - mn); mx = mn; ls = ls * al + pp;
      const u16* vp = P + (size_t)krow * INW + 1792 + h * 128 + vq * 32;
#pragma unroll
      for (int w = 0; w < 4; ++w) { u32x4 t = *reinterpret_cast<const u32x4*>(vp + w * 8);
#pragma unroll
        for (int e = 0; e < 4; ++e) { o[w * 8 + 2 * e] = o[w * 8 + 2 * e] * al + pp * bflo(t[e]); o[w * 8 + 2 * e + 1] = o[w * 8 + 2 * e + 1] * al + pp * bfhi(t[e]); } }
    }
    const float inv = 1.f / ls;
    if (mp == 0) {
#pragma unroll
      for (int d = 0; d < 32; ++d) res[d] = o[d] * inv;
    } else {
#pragma unroll
      for (int d = 0; d < 32; ++d) res[d] = res[d] - lam * o[d] * inv;
    }
  }
  float ss = 0.f;
#pragma unroll
  for (int d = 0; d < 32; ++d) ss += res[d] * res[d];
  ss += __shfl_xor(ss, 1, 64); ss += __shfl_xor(ss, 2, 64);
  const float r = rsqrtf(ss * (1.f / 128.f) + LN_EPS) * (1.f - lam_init);
  const float* sg = c.in(I_SUBLN) + l * 128 + vq * 32;
  u16* yp = YC + (size_t)qrow * 512 + h * 128 + vq * 32;
#pragma unroll
  for (int w = 0; w < 4; ++w) { u32x4 t;
#pragma unroll
    for (int e = 0; e < 4; ++e) t[e] = pack2(res[w * 8 + 2 * e] * r * sg[w * 8 + 2 * e], res[w * 8 + 2 * e + 1] * r * sg[w * 8 + 2 * e + 1]);
    *reinterpret_cast<u32x4*>(yp + w * 8) = t; }
}

__device__ __forceinline__ void step_mix_b(const Ctx& c, int l, bool last) {
  const int n_att = 512, n_attc = last ? 0 : 32, n_s5 = 4 * 64, n_s5c = last ? 0 : 16;
  const int total = n_att + n_attc + n_s5 + n_s5c;
  for (int it = blockIdx.x; it < total; it += gridDim.x) {
    int i = it;
    if (i < n_att) { const int bh = i >> 5, qb = i & 31; attn_naive_item(c, l, bh >> 2, bh & 3, qb, 0); continue; }
    i -= n_att;
    if (i < n_attc) { const int bh = i >> 1; attn_naive_item(c, l, bh >> 2, bh & 3, i & 1, 1); continue; }
    i -= n_attc;
    if (i < n_s5) { s5_out_item(c, l, i >> 6, 0, i & 63); continue; }
    i -= n_s5;
    s5_out_item(c, l, i >> 2, 1, i & 3);
  }
}

__device__ __forceinline__ void step_merge(const Ctx& c, int l, bool last) {
  const char* wl = c.p.ws + OFF_WS + (size_t)l * WS_LAYER;
  const u16* WGLU = (const u16*)(wl + WS_GLU); const u16* WGM = (const u16*)(wl + WS_GM); const u16* WDA = (const u16*)(wl + WS_DA);
  const u16* P = c.w<u16>(OFF_BIG + BIG_P); const u16* YA = c.w<u16>(OFF_BIG + BIG_YA); const u16* YB = c.w<u16>(OFF_BIG + BIG_YB); const u16* YC = c.w<u16>(OFF_BIG + BIG_YC);
  u16* Mb = c.w<u16>(OFF_BIG + BIG_M);
  const int wm = c.wid >> 1, wn = c.wid & 1, fr = c.lane & 15, fq = c.lane >> 4;
  const int ntm = last ? 64 : 68;
  for (int it = blockIdx.x; it < ntm * 16; it += gridDim.x) {
    const int tm = it >> 4, tn = it & 15;
    f32x4 am[4][2];
    { f32x4 t[4][4]; ZERO_ACC(t);
      gemm_acc_t<4>(t, [&](int r) { return YA + (size_t)(tm * 256 + r) * 256; },
                    [&](int b) { const int wn_ = b >> 6, nn = (b >> 4) & 3, f_ = b & 15; return WGLU + (size_t)((nn >> 1) * 1024 + tn * 64 + wn_ * 32 + (nn & 1) * 16 + f_) * 256; }, 256, c.lds);
      { EPI_ROWS(tm * 256)
          const u16* gp = P + (size_t)row * INW + 2304 + tn * 64 + wn * 32 + fr;
#pragma unroll
          for (int n = 0; n < 2; ++n) am[m][n][j] = bf2f(gp[n * 16]) * t[m][n][j] * sigmoidf_(t[m][n + 2][j]);
        EPI_END } }
    { f32x4 t[4][2];
#pragma unroll
      for (int m = 0; m < 4; ++m) { t[m][0] = (f32x4){0.f, 0.f, 0.f, 0.f}; t[m][1] = (f32x4){0.f, 0.f, 0.f, 0.f}; }
      gemm_acc_t<2>(t, [&](int r) { return YB + (size_t)(tm * 256 + r) * 256; }, [&](int b) { return WGM + (size_t)(tn * 64 + b) * 256; }, 256, c.lds);
      { EPI_ROWS(tm * 256)
          const u16* gp = P + (size_t)row * INW + 2304 + 1024 + tn * 64 + wn * 32 + fr;
#pragma unroll
          for (int n = 0; n < 2; ++n) am[m][n][j] += bf2f(gp[n * 16]) * t[m][n][j];
        EPI_END } }
    { f32x4 t[4][2];
#pragma unroll
      for (int m = 0; m < 4; ++m) { t[m][0] = (f32x4){0.f, 0.f, 0.f, 0.f}; t[m][1] = (f32x4){0.f, 0.f, 0.f, 0.f}; }
      gemm_acc_t<2>(t, [&](int r) { return YC + (size_t)(tm * 256 + r) * 512; }, [&](int b) { return WDA + (size_t)(tn * 64 + b) * 512; }, 512, c.lds);
      { EPI_ROWS(tm * 256)
          const u16* gp = P + (size_t)row * INW + 2304 + 2048 + tn * 64 + wn * 32 + fr;
          u16* dst = Mb + (size_t)row * 1024 + tn * 64 + wn * 32 + fr;
#pragma unroll
          for (int n = 0; n < 2; ++n) dst[n * 16] = f2bf(am[m][n][j] + bf2f(gp[n * 16]) * t[m][n][j]);
        EPI_END } }
  }
}

__device__ __forceinline__ void step_out(const Ctx& c, int l, bool last) {
  const u16* WOUT = (const u16*)(c.p.ws + OFF_WS + (size_t)l * WS_LAYER + WS_OUT);
  const u16* Mb = c.w<u16>(OFF_BIG + BIG_M); float* H = c.w<float>(OFF_H);
  const int wm = c.wid >> 1, wn = c.wid & 1, fr = c.lane & 15, fq = c.lane >> 4;
  const int ntm = last ? 64 : 68;
  for (int it = blockIdx.x; it < ntm * 8; it += gridDim.x) {
    const int tm = it >> 3, tn = it & 7;
    f32x4 acc[4][4]; ZERO_ACC(acc);
    gemm_acc(acc, [&](int r) { return Mb + (size_t)(tm * 256 + r) * 1024; }, [&](int b) { return WOUT + (size_t)(tn * 128 + b) * 1024; }, 1024, c.lds);
    { EPI_ROWS(tm * 256)
        const int cb = tn * 128 + wn * 64 + fr;
        const float* hs = (l == 0) ? (row < TLAT ? c.in(I_X) + (size_t)row * 1024 : c.in(I_CTX) + (size_t)(row - TLAT) * 1024) : H + (size_t)row * 1024;
        const float* g1 = c.mod(l, brow_of(row), 2);
        float* hd = H + (size_t)row * 1024;
#pragma unroll
        for (int n = 0; n < 4; ++n) hd[cb + n * 16] = ALPHA * hs[cb + n * 16] + g1[cb + n * 16] * acc[m][n][j];
      EPI_END }
  }
}

__device__ __forceinline__ void step_ln_mid(const Ctx& c, int l, int mrows) {
  float* H = c.w<float>(OFF_H); u16* F = c.w<u16>(OFF_ACT);
  for (int it = blockIdx.x; it < mrows / 8; it += gridDim.x) {
    const int row = it * 8 + c.wid; float v[16]; load_row(H + (size_t)row * 1024, c.lane, v);
    ln_affine(v, c.in(I_LN1G) + l * 1024, c.in(I_LN1B) + l * 1024, c.lane);
    store_row(H + (size_t)row * 1024, c.lane, v);
    const int br = brow_of(row);
    ln_mod_store(v, c.mod(l, br, 3), c.mod(l, br, 4), F + (size_t)row * 1024, c.lane);
  }
}

__device__ __forceinline__ void step_router(const Ctx& c, int l, int mrows, int halfrows) {
  const u16* F = c.w<u16>(OFF_ACT); const u16* WR = (const u16*)(c.p.ws + OFF_WS + (size_t)l * WS_LAYER + WS_R);
  int* cnt = c.w<int>(OFF_CNT) + l * 128; int* list = c.w<int>(OFF_LIST); float* topw = c.w<float>(OFF_TOPW);
  const int wm = c.wid >> 1, wn = c.wid & 1, fr = c.lane & 15, fq = c.lane >> 4, lane = c.lane;
  float* lg = reinterpret_cast<float*>(c.lds);
  for (int it = blockIdx.x; it < mrows / 256; it += gridDim.x) {
    f32x4 acc[4][4]; ZERO_ACC(acc);
    gemm_acc(acc, [&](int r) { return F + (size_t)(it * 256 + r) * 1024; },
             [&](int b) { const int wn_ = b >> 6, nn = (b >> 4) & 3, f_ = b & 15; return WR + (size_t)((nn >> 1) * 64 + wn_ * 32 + (nn & 1) * 16 + f_) * 1024; }, 1024, c.lds);
    { EPI_ROWS(0)
#pragma unroll
        for (int n = 0; n < 2; ++n) lg[row * 64 + wn * 32 + n * 16 + fr] = acc[m][n][j] + acc[m][n + 2][j];
      EPI_END }
    __syncthreads();
    const float bias = c.in(I_BR)[l * 64 + lane];
    for (int rr = 0; rr < 32; ++rr) {
      const int row = c.wid * 32 + rr; const int tok = it * 256 + row;
      const float score = sigmoidf_(lg[row * 64 + lane]); const float sel = score + bias;
      float m1 = sel;
      m1 = fmaxf(m1, __shfl_xor(m1, 1, 64)); m1 = fmaxf(m1, __shfl_xor(m1, 2, 64)); m1 = fmaxf(m1, __shfl_xor(m1, 4, 64));
      const unsigned long long bm = __ballot(sel == m1);
      const unsigned grp = (unsigned)((bm >> (lane & ~7)) & 0xffull);
      const int first = __ffs((int)grp) - 1;
      float s2 = ((lane & 7) == first) ? -3.0e38f : sel;
      s2 = fmaxf(s2, __shfl_xor(s2, 1, 64)); s2 = fmaxf(s2, __shfl_xor(s2, 2, 64)); s2 = fmaxf(s2, __shfl_xor(s2, 4, 64));
      const float gs = m1 + s2; const int g8 = lane >> 3;
      int cg = 0;
#pragma unroll
      for (int jg = 0; jg < 8; ++jg) { const float gj = __shfl(gs, jg * 8, 64); cg += (gj > gs || (gj == gs && jg < g8)) ? 1 : 0; }
      const bool allowed = cg < 4;
      const float sm = allowed ? sel : -3.0e38f;
      float* smb = reinterpret_cast<float*>(c.lds + 65536) + c.wid * 64;
      smb[lane] = sm;
      __builtin_amdgcn_wave_barrier(); asm volatile("s_waitcnt lgkmcnt(0)" ::: "memory");
      int rk = 0;
#pragma unroll 8
      for (int je = 0; je < 64; ++je) { const float sj = smb[je]; rk += (sj > sm || (sj == sm && je < lane)) ? 1 : 0; }
      __builtin_amdgcn_wave_barrier();
      const bool selected = allowed && rk < 8;
      const float wsum = wave_sum(selected ? score : 0.f);
      if (selected) {
        const int hh = tok >= halfrows ? 1 : 0;
        topw[(size_t)tok * 8 + rk] = score / wsum * 2.5f;
        const int pos = atomicAdd(&cnt[hh * 64 + lane], 1);
        list[((size_t)hh * 64 + lane) * 8704 + pos] = tok * 8 + rk;
      }
    }
    __syncthreads();
  }
}

__device__ __forceinline__ int moe_schedule(const Ctx& c, int l, int hh, int halfrows, int* pre  , int* cn  ) {
  const int* cnt = c.w<int>(OFF_CNT) + l * 128 + hh * 64;
  if (c.tid == 0) { int s = 0; for (int e = 0; e < 65; ++e) { int n = e < 64 ? cnt[e] : halfrows; cn[e] = n; pre[e] = s; s += (n + 255) >> 8; } pre[65] = s; }
  __syncthreads();
  return pre[65];
}
#define MOE_LDS_OFF GEMM_LDS

__device__ __forceinline__ void step_moe_up(const Ctx& c, int l, int hh, int halfrows) {
  int* pre = reinterpret_cast<int*>(c.lds + MOE_LDS_OFF); int* cn = pre + 72;
  const int RT = moe_schedule(c, l, hh, halfrows, pre, cn);
  const u16* F = c.w<u16>(OFF_ACT); const int* list = c.w<int>(OFF_LIST) + (size_t)hh * 64 * 8704;
  u16* HD = c.w<u16>(OFF_BIG + BIG_HD); u16* HS = c.w<u16>(OFF_BIG + BIG_HS);
  const int wm = c.wid >> 1, wn = c.wid & 1, fr = c.lane & 15, fq = c.lane >> 4;
  const int tok0 = hh * halfrows;
  for (int it = blockIdx.x; it < RT * 4; it += gridDim.x) {
    const int rt = it >> 2, tn = it & 3;
    int e = 0; while (pre[e + 1] <= rt) ++e;
    const int rti = rt - pre[e], ne = cn[e];
    const int* le = list + (size_t)e * 8704;
    const u16* WGU = (const u16*)(c.p.ws + OFF_WE + (size_t)e * WE_ONE);
    f32x4 acc[4][4]; ZERO_ACC(acc);
    gemm_acc(acc, [&](int r) { int idx = rti * 256 + r; if (idx >= ne) idx = 0; const int tok = e < 64 ? (le[idx] >> 3) : tok0 + idx; return F + (size_t)tok * 1024; },
             [&](int b) { const int wn_ = b >> 6, nn = (b >> 4) & 3, f_ = b & 15; return WGU + (size_t)((nn >> 1) * 256 + tn * 64 + wn_ * 32 + (nn & 1) * 16 + f_) * 1024; }, 1024, c.lds);
    { EPI_ROWS(rti * 256)
        const int idx = row;
        if (idx < ne) {
          u16* dst = e < 64 ? HD + (size_t)(le[idx] - tok0 * 8) * 256 : HS + (size_t)idx * 256;
#pragma unroll
          for (int n = 0; n < 2; ++n) dst[tn * 64 + wn * 32 + n * 16 + fr] = f2bf(silu_(acc[m][n][j]) * acc[m][n + 2][j]);
        }
      EPI_END }
  }
}
__device__ __forceinline__ void step_moe_down(const Ctx& c, int l, int hh, int halfrows) {
  int* pre = reinterpret_cast<int*>(c.lds + MOE_LDS_OFF); int* cn = pre + 72;
  const int RT = moe_schedule(c, l, hh, halfrows, pre, cn);
  const int* list = c.w<int>(OFF_LIST) + (size_t)hh * 64 * 8704; const float* topw = c.w<float>(OFF_TOPW);
  const u16* HD = c.w<u16>(OFF_BIG + BIG_HD); const u16* HS = c.w<u16>(OFF_BIG + BIG_HS); u16* YR = c.w<u16>(OFF_BIG + BIG_YR); float* H = c.w<float>(OFF_H);
  const int wm = c.wid >> 1, wn = c.wid & 1, fr = c.lane & 15, fq = c.lane >> 4;
  const int tok0 = hh * halfrows;
  for (int it = blockIdx.x; it < RT * 8; it += gridDim.x) {
    const int rt = it >> 3, tn = it & 7;
    int e = 0; while (pre[e + 1] <= rt) ++e;
    const int rti = rt - pre[e], ne = cn[e];
    const int* le = list + (size_t)e * 8704;
    const u16* WD = (const u16*)(c.p.ws + OFF_WE + (size_t)e * WE_ONE + WE_GU);
    f32x4 acc[4][4]; ZERO_ACC(acc);
    gemm_acc(acc, [&](int r) { int idx = rti * 256 + r; if (idx >= ne) idx = 0; return e < 64 ? HD + (size_t)(le[idx] - tok0 * 8) * 256 : HS + (size_t)idx * 256; },
             [&](int b) { return WD + (size_t)(tn * 128 + b) * 256; }, 256, c.lds);
    { EPI_ROWS(rti * 256)
        const int idx = row;
        if (idx < ne) {
          if (e < 64) { const int ent = le[idx]; const float wv = topw[ent]; u16* dst = YR + (size_t)(ent - tok0 * 8) * 1024 + tn * 128 + wn * 64 + fr;
#pragma unroll
            for (int n = 0; n < 4; ++n) dst[n * 16] = f2bf(wv * acc[m][n][j]);
          } else { const int tok = tok0 + idx; float* dst = H + (size_t)tok * 1024 + tn * 128 + wn * 64 + fr; const float* g2 = c.mod(l, brow_of(tok), 5) + tn * 128 + wn * 64 + fr;
#pragma unroll
            for (int n = 0; n < 4; ++n) dst[n * 16] = ALPHA * dst[n * 16] + g2[n * 16] * acc[m][n][j];
          }
        }
      EPI_END }
  }
}
__device__ __forceinline__ void step_combine(const Ctx& c, int l, bool last, int hh, int halfrows) {
  float* H = c.w<float>(OFF_H); const u16* YR = c.w<u16>(OFF_BIG + BIG_YR); u16* U = c.w<u16>(OFF_ACT);
  const int tok0 = hh * halfrows;
  for (int it = blockIdx.x; it < halfrows / 8; it += gridDim.x) {
    const int tok = tok0 + it * 8 + c.wid; float v[16]; load_row(H + (size_t)tok * 1024, c.lane, v);
    float s[16];
#pragma unroll
    for (int i = 0; i < 16; ++i) s[i] = 0.f;
#pragma unroll
    for (int k = 0; k < 8; ++k) { const u16* yr = YR + ((size_t)(tok - tok0) * 8 + k) * 1024;
#pragma unroll
      for (int i = 0; i < 4; ++i) { uint2 t = *reinterpret_cast<const uint2*>(yr + (i * 64 + c.lane) * 4); s[i * 4] += bflo(t.x); s[i * 4 + 1] += bfhi(t.x); s[i * 4 + 2] += bflo(t.y); s[i * 4 + 3] += bfhi(t.y); } }
    const float* g2 = c.mod(l, brow_of(tok), 5);
#pragma unroll
    for (int i = 0; i < 4; ++i) { float4 g = *reinterpret_cast<const float4*>(g2 + (i * 64 + c.lane) * 4);
      v[i * 4] += g.x * s[i * 4]; v[i * 4 + 1] += g.y * s[i * 4 + 1]; v[i * 4 + 2] += g.z * s[i * 4 + 2]; v[i * 4 + 3] += g.w * s[i * 4 + 3]; }
    ln_affine(v, c.in(I_LN2G) + l * 1024, c.in(I_LN2B) + l * 1024, c.lane);
    if (last) { store_row(c.p.out + (size_t)tok * 1024, c.lane, v); }
    else { store_row(H + (size_t)tok * 1024, c.lane, v); const int br = brow_of(tok);
      ln_mod_store(v, c.mod(l + 1, br, 0), c.mod(l + 1, br, 1), U + (size_t)tok * 1024, c.lane); }
  }
}

#ifdef ONLY
__device__ __forceinline__ void run_step_only(const Ctx& c) {
  const int l_ = 0; const bool last_ = false;
  if (ONLY == 0) step_prep(c); if (ONLY == 1) step_ln_in(c); if (ONLY == 2) step_gemm_in(c, l_); if (ONLY == 3) step_mix_a(c, l_, last_); if (ONLY == 4) step_mix_b(c, l_, last_);
  if (ONLY == 5) step_merge(c, l_, last_); if (ONLY == 6) step_out(c, l_, last_); if (ONLY == 7) step_ln_mid(c, l_, MTOT); if (ONLY == 8) step_router(c, l_, MTOT, 8704);
  if (ONLY == 9) step_moe_up(c, l_, 0, 8704); if (ONLY == 10) step_moe_down(c, l_, 0, 8704); if (ONLY == 11) step_combine(c, l_, last_, 0, 8704);
}
#endif
#define N_STEPS 28
template <int L>
__device__ __forceinline__ void run_layer_step(const Ctx& c, int k) {
  constexpr bool last = (L == 1);
  constexpr int mrows = last ? TLAT : MTOT, halfrows = mrows / 2;
  switch (k) {
    case 0: step_gemm_in(c, L); break;
    case 1: step_mix_a(c, L, last); break;
    case 2: step_mix_b(c, L, last); break;
    case 3: step_merge(c, L, last); break;
    case 4: step_out(c, L, last); break;
    case 5: step_ln_mid(c, L, mrows); break;
    case 6: step_router(c, L, mrows, halfrows); break;
    case 7: step_moe_up(c, L, 0, halfrows); break;
    case 8: step_moe_down(c, L, 0, halfrows); break;
    case 9: step_combine(c, L, last, 0, halfrows); break;
    case 10: step_moe_up(c, L, 1, halfrows); break;
    case 11: step_moe_down(c, L, 1, halfrows); break;
    default: step_combine(c, L, last, 1, halfrows); break;
  }
}

#define LDS_BYTES (GEMM_LDS + 1024 + 512)
__global__ void __launch_bounds__(NTHR, 2) fwd_kernel(Params p) {
  extern __shared__ __attribute__((aligned(16))) char lds[];
  Ctx c; c.p.ws = p.ws; c.p.out = p.out; c.lds = lds; c.tid = threadIdx.x; c.lane = threadIdx.x & 63; c.wid = __builtin_amdgcn_readfirstlane(threadIdx.x >> 6);
  if (threadIdx.x == 0) {
    const float** tab = reinterpret_cast<const float**>(lds + PTR_TAB_OFF);
#pragma unroll
    for (int i = 0; i < N_IN; ++i) tab[i] = p.in[i];
  }
  __syncthreads();
  const int lo = p.s_lo, hi = p.s_hi;
#define STEP(S, CALL) do { if (lo <= (S) && (S) < hi) { CALL; if ((S) + 1 < hi) cg::this_grid().sync(); } } while (0)
#ifdef ONLY
  run_step_only(c);
#else
  STEP(0, step_prep(c));
  STEP(1, step_ln_in(c));
#define LSTEP(L, K) STEP(2 + 13 * (L) + (K), run_layer_step<L>(c, K))
  LSTEP(0, 0); LSTEP(0, 1); LSTEP(0, 2); LSTEP(0, 3); LSTEP(0, 4); LSTEP(0, 5); LSTEP(0, 6); LSTEP(0, 7); LSTEP(0, 8); LSTEP(0, 9); LSTEP(0, 10); LSTEP(0, 11); LSTEP(0, 12);
  LSTEP(1, 0); LSTEP(1, 1); LSTEP(1, 2); LSTEP(1, 3); LSTEP(1, 4); LSTEP(1, 5); LSTEP(1, 6); LSTEP(1, 7); LSTEP(1, 8); LSTEP(1, 9); LSTEP(1, 10); LSTEP(1, 11); LSTEP(1, 12);
#endif
}

extern "C" void kernel_launch(void* const* d_in, const int* in_sizes, int n_in, void* d_out, int out_size, void* d_ws, size_t ws_size, hipStream_t stream) {
  static int grid = 0;
  if (grid == 0) {
    if (n_in != N_IN || ws_size < WS_TOTAL) { fprintf(stderr, "kernel_launch: bad shapes n_in %d ws %zu need %zu\n", n_in, ws_size, (size_t)WS_TOTAL); grid = -1; return; }
    hipFuncSetAttribute((const void*)fwd_kernel, hipFuncAttributeMaxDynamicSharedMemorySize, LDS_BYTES);
    int dev = 0, cus = 0, per_cu = 0; hipGetDevice(&dev); hipDeviceGetAttribute(&cus, hipDeviceAttributeMultiprocessorCount, dev);
    hipOccupancyMaxActiveBlocksPerMultiprocessor(&per_cu, (const void*)fwd_kernel, NTHR, LDS_BYTES);
    if (per_cu < 1) { fprintf(stderr, "kernel_launch: occupancy query says %d\n", per_cu); grid = -1; return; }
    grid = cus;
  }
  if (grid < 0) return;
  hipMemsetAsync(d_ws, 0, ZERO_BYTES, stream);
  Params p{};
  for (int i = 0; i < N_IN; ++i) p.in[i] = (const float*)d_in[i];
  p.out = (float*)d_out; p.ws = (char*)d_ws;
#if N_LAUNCH_MODE == 1
  p.s_lo = 0; p.s_hi = N_STEPS;
  void* args[] = {&p};
  hipError_t e = hipLaunchCooperativeKernel((const void*)fwd_kernel, dim3(grid), dim3(NTHR), args, LDS_BYTES, stream);
  if (e != hipSuccess) fprintf(stderr, "cooperative launch failed: %s (grid %d)\n", hipGetErrorString(e), grid);
#else
  for (int s = 0; s < N_STEPS; ++s) { p.s_lo = s; p.s_hi = s + 1; hipLaunchKernelGGL(fwd_kernel, dim3(grid), dim3(NTHR), LDS_BYTES, stream, p); }
#endif
}
```

```cpp
#include <hip/hip_runtime.h>
#include <hip/hip_cooperative_groups.h>
#include <stdint.h>
#include <cstdio>
namespace cg = cooperative_groups;

#ifndef N_LAUNCH_MODE
#define N_LAUNCH_MODE 1
#endif

typedef unsigned short u16;
typedef __attribute__((ext_vector_type(8))) short bf16x8;
typedef __attribute__((ext_vector_type(4))) float f32x4;
typedef __attribute__((ext_vector_type(4))) unsigned u32x4;

#define DM     1024
#define NBATCH 4
#define SEQ    4096
#define CTXL   256
#define TLAT   16384
#define TCTX   1024
#define MTOT   17408
#define INW    5376
#define NTHR   512
#define ALPHA  1.41421356237309515f
#define LN_EPS 1e-5f
#define NCHK   68

enum { I_X = 0, I_C, I_CTX, I_CCTX, I_WMOD, I_BMOD, I_WIN, I_LRE, I_LIM, I_LSTEP, I_BRE, I_BIM, I_CRE, I_CIM, I_S5D,
       I_GMW, I_GMB, I_DALAM, I_SUBLN, I_GLUV, I_GLUG, I_PGM, I_PDA, I_WOUT, I_LN1G, I_LN1B, I_LN2G, I_LN2B,
       I_WR, I_BR, I_EG, I_EU, I_ED, I_SG, I_SU, I_SD, N_IN };

constexpr size_t al256(size_t x) { return (x + 255) / 256 * 256; }
constexpr size_t OFF_BAR   = 0;
constexpr size_t OFF_CNT   = 16384;
constexpr size_t ZERO_BYTES = 20480;
constexpr size_t OFF_MOD   = 32768;
constexpr size_t OFF_S5A   = OFF_MOD + al256(2 * 5 * 6144 * 4);
constexpr size_t OFF_S5A64 = OFF_S5A + 32768;
constexpr size_t OFF_S5BB  = OFF_S5A64 + 32768;
constexpr size_t OFF_ROPE  = OFF_S5BB + 524288;
constexpr size_t OFF_E     = OFF_ROPE + 8192;
constexpr size_t OFF_LIST  = OFF_E + al256((size_t)4 * 2 * NCHK * 16 * 64 * 2 * 4);
constexpr size_t OFF_TOPW  = OFF_LIST + al256((size_t)2 * 64 * 8704 * 4);
constexpr size_t OFF_WS    = OFF_TOPW + al256((size_t)MTOT * 8 * 4);
constexpr size_t WS_WIN = 0, WS_GLU = WS_WIN + (size_t)INW * 1024 * 2, WS_GM = WS_GLU + 2048 * 256 * 2,
                 WS_DA = WS_GM + 1024 * 256 * 2, WS_OUT = WS_DA + 1024 * 512 * 2, WS_R = WS_OUT + 1024 * 1024 * 2,
                 WS_LAYER = WS_R + 128 * 1024 * 2;
constexpr size_t OFF_WE    = OFF_WS + 2 * WS_LAYER;
constexpr size_t WE_GU = (size_t)512 * 1024 * 2, WE_D = (size_t)1024 * 256 * 2, WE_ONE = WE_GU + WE_D;
constexpr size_t OFF_H     = OFF_WE + 65 * WE_ONE;
constexpr size_t OFF_ACT   = OFF_H + (size_t)MTOT * 1024 * 4;
constexpr size_t OFF_BIG   = OFF_ACT + (size_t)MTOT * 1024 * 2;
constexpr size_t BIG_P = 0, BIG_YA = BIG_P + (size_t)MTOT * INW * 2, BIG_YB = BIG_YA + (size_t)MTOT * 256 * 2,
                 BIG_YC = BIG_YB + (size_t)MTOT * 256 * 2, BIG_M = BIG_YC + (size_t)MTOT * 512 * 2,
                 BIG_END = BIG_M + (size_t)MTOT * 1024 * 2;
constexpr size_t BIG_YR = 0, BIG_HD = BIG_YR + (size_t)8704 * 8 * 1024 * 2, BIG_HS = BIG_HD + (size_t)8704 * 8 * 256 * 2,
                 BIG_END2 = BIG_HS + (size_t)8704 * 256 * 2;
static_assert(BIG_END2 <= BIG_END, "moe scratch must fit");
constexpr size_t WS_TOTAL = OFF_BIG + BIG_END;

struct Params { const float* in[N_IN]; float* out; char* ws; int s_lo, s_hi; };

__device__ __forceinline__ u16 f2bf(float f) { unsigned u = __float_as_uint(f); u += 0x7fffu + ((u >> 16) & 1u); return (u16)(u >> 16); }
__device__ __forceinline__ float bf2f(u16 h) { return __uint_as_float(((unsigned)h) << 16); }
__device__ __forceinline__ float bflo(unsigned w) { return __uint_as_float(w << 16); }
__device__ __forceinline__ float bfhi(unsigned w) { return __uint_as_float(w & 0xffff0000u); }
__device__ __forceinline__ unsigned pack2(float a, float b) { return (unsigned)f2bf(a) | ((unsigned)f2bf(b) << 16); }
__device__ __forceinline__ float wave_sum(float v) {
#pragma unroll
  for (int m = 32; m >= 1; m >>= 1) v += __shfl_xor(v, m, 64);
  return v;
}
__device__ __forceinline__ float sigmoidf_(float x) { return 1.f / (1.f + __expf(-x)); }
__device__ __forceinline__ float gelu_tanh(float x) {
  float t = 0.7978845608028654f * (x + 0.044715f * x * x * x);
  float e = __expf(2.f * t);
  float th = 1.f - 2.f / (e + 1.f);
  return 0.5f * x * (1.f + th);
}
__device__ __forceinline__ float silu_(float x) { return x / (1.f + __expf(-x)); }

#define A_STAGE 32768
#define B_STAGE 16384
#define STAGE_BYTES 49152
#define GEMM_LDS (2 * STAGE_BYTES)

__device__ __forceinline__ void glds16(const void* g, void* l) {
  __builtin_amdgcn_global_load_lds((const __attribute__((address_space(1))) void*)g, (__attribute__((address_space(3))) void*)l, 16, 0, 0);
}

template <int NF, class AF, class BF>
__device__ __forceinline__ void gemm_acc_t(f32x4 (&acc)[4][NF], AF arow, BF brow, int K, char* lds) {
  const int tid = threadIdx.x, lane = tid & 63, wid = tid >> 6, wm = wid >> 1, wn = wid & 1, fr = lane & 15, fq = lane >> 4;
  constexpr int NB = NF / 2;
  int tidz = tid; asm volatile("" : "+v"(tidz));
  const u16* ap[4]; const u16* bp[NB];
#pragma unroll
  for (int i = 0; i < 4; ++i) { int idx = i * NTHR + tidz, row = idx >> 3, c = (idx & 7) ^ (row & 7); ap[i] = arow(row) + c * 8; }
#pragma unroll
  for (int i = 0; i < NB; ++i) { int idx = i * NTHR + tidz, row = idx >> 3, c = (idx & 7) ^ (row & 7); bp[i] = brow(row) + c * 8; }
  const int nt = K >> 6;
  {
#pragma unroll
    for (int i = 0; i < 4; ++i) glds16(ap[i], lds + (i * NTHR + tid) * 16);
#pragma unroll
    for (int i = 0; i < NB; ++i) glds16(bp[i], lds + A_STAGE + (i * NTHR + tid) * 16);
  }
  asm volatile("s_waitcnt vmcnt(0)" ::: "memory");
  __syncthreads();
  const int sw = fr & 7;
#pragma unroll 1
  for (int t = 0; t < nt; ++t) {
    char* cur = lds + (t & 1) * STAGE_BYTES;
    if (t + 1 < nt) {
      char* nxt = lds + ((t + 1) & 1) * STAGE_BYTES; const int k0 = (t + 1) << 6;
#pragma unroll
      for (int i = 0; i < 4; ++i) glds16(ap[i] + k0, nxt + (i * NTHR + tid) * 16);
#pragma unroll
      for (int i = 0; i < NB; ++i) glds16(bp[i] + k0, nxt + A_STAGE + (i * NTHR + tid) * 16);
    }
#pragma unroll
    for (int ks = 0; ks < 2; ++ks) {
      bf16x8 At[4], Bt[NF];
      const int coff = (((ks * 4 + fq) ^ sw) << 4);
#pragma unroll
      for (int m = 0; m < 4; ++m) At[m] = *reinterpret_cast<const bf16x8*>(cur + (wm * 64 + m * 16 + fr) * 128 + coff);
#pragma unroll
      for (int n = 0; n < NF; ++n) Bt[n] = *reinterpret_cast<const bf16x8*>(cur + A_STAGE + (wn * NF * 16 + n * 16 + fr) * 128 + coff);
#pragma unroll
      for (int m = 0; m < 4; ++m)
#pragma unroll
        for (int n = 0; n < NF; ++n) acc[m][n] = __builtin_amdgcn_mfma_f32_16x16x32_bf16(At[m], Bt[n], acc[m][n], 0, 0, 0);
    }
    asm volatile("s_waitcnt vmcnt(0)" ::: "memory");
    __syncthreads();
  }
}
template <class AF, class BF>
__device__ __forceinline__ void gemm_acc(f32x4 (&acc)[4][4], AF arow, BF brow, int K, char* lds) { gemm_acc_t<4>(acc, arow, brow, K, lds); }
#define ZERO_ACC(a) do { _Pragma("unroll") for (int _m = 0; _m < 4; ++_m) _Pragma("unroll") for (int _n = 0; _n < 4; ++_n) a[_m][_n] = (f32x4){0.f, 0.f, 0.f, 0.f}; } while (0)

#define EPI_ROWS(ROW0) int _rb = (ROW0) + wm * 64 + fq * 4; asm volatile("" : "+v"(_rb)); \
  _Pragma("unroll") for (int m = 0; m < 4; ++m) { __builtin_amdgcn_sched_barrier(0); _Pragma("unroll") for (int j = 0; j < 4; ++j) { const int row = _rb + m * 16 + j;
#define EPI_END } }

#define PTR_TAB_OFF 136192
struct CtxP { char* ws; float* out; };
struct Ctx {
  CtxP p; char* lds; int tid, lane, wid;
  __device__ __forceinline__ const float* in(int i) const { return reinterpret_cast<const float* const*>(lds + PTR_TAB_OFF)[i]; }
  template <typename T> __device__ __forceinline__ T* w(size_t off) const { return reinterpret_cast<T*>(p.ws + off); }
  __device__ __forceinline__ const float* mod(int l, int brow, int chunk) const { return w<float>(OFF_MOD) + ((size_t)(l * 5 + brow) * 6144 + chunk * 1024); }
};
__device__ __forceinline__ int brow_of(int row) { return row < TLAT ? (row >> 12) : 4; }

__device__ __forceinline__ void cvt_tile(const float* __restrict__ src, int N, u16* __restrict__ dst, int dld, int k0, int n0, int roff, float* t) {
  const int tid = threadIdx.x;
  { const int n = tid & 63, kb = tid >> 6;
#pragma unroll
    for (int i = 0; i < 8; ++i) { int k = kb + 8 * i; t[k * 65 + n] = src[(size_t)(k0 + k) * N + n0 + n]; } }
  __syncthreads();
  { const int k = tid & 63, nb = tid >> 6;
#pragma unroll
    for (int i = 0; i < 8; ++i) { int nn = nb + 8 * i; dst[(size_t)(roff + n0 + nn) * dld + k0 + k] = f2bf(t[k * 65 + nn]); } }
  __syncthreads();
}
__device__ __forceinline__ void cvt_router_tile(const float* __restrict__ src, u16* __restrict__ dst, int k0, float* t) {
  const int tid = threadIdx.x;
  { const int n = tid & 63, kb = tid >> 6;
#pragma unroll
    for (int i = 0; i < 8; ++i) { int k = kb + 8 * i; t[k * 65 + n] = src[(size_t)(k0 + k) * 64 + n]; } }
  __syncthreads();
  { const int k = tid & 63, nb = tid >> 6;
#pragma unroll
    for (int i = 0; i < 8; ++i) { int nn = nb + 8 * i; float v = t[k * 65 + nn]; u16 hi = f2bf(v); u16 lo = f2bf(v - bf2f(hi));
      dst[(size_t)nn * 1024 + k0 + k] = hi; dst[(size_t)(64 + nn) * 1024 + k0 + k] = lo; } }
  __syncthreads();
}
#define NCVT_SMALL 1936
__device__ __forceinline__ void cvt_small(const Ctx& c, int l, int t) {
  float* tb = reinterpret_cast<float*>(c.lds);
  char* wl = c.p.ws + OFF_WS + (size_t)l * WS_LAYER;
  if (t < 1344) { cvt_tile(c.in(I_WIN) + (size_t)l * 1024 * INW, INW, (u16*)(wl + WS_WIN), 1024, (t / 84) * 64, (t % 84) * 64, 0, tb); return; }
  t -= 1344;
  if (t < 64) { cvt_tile(c.in(I_GLUV) + (size_t)l * 256 * 1024, 1024, (u16*)(wl + WS_GLU), 256, (t / 16) * 64, (t % 16) * 64, 0, tb); return; }
  t -= 64;
  if (t < 64) { cvt_tile(c.in(I_GLUG) + (size_t)l * 256 * 1024, 1024, (u16*)(wl + WS_GLU), 256, (t / 16) * 64, (t % 16) * 64, 1024, tb); return; }
  t -= 64;
  if (t < 64) { cvt_tile(c.in(I_PGM) + (size_t)l * 256 * 1024, 1024, (u16*)(wl + WS_GM), 256, (t / 16) * 64, (t % 16) * 64, 0, tb); return; }
  t -= 64;
  if (t < 128) { cvt_tile(c.in(I_PDA) + (size_t)l * 512 * 1024, 1024, (u16*)(wl + WS_DA), 512, (t / 16) * 64, (t % 16) * 64, 0, tb); return; }
  t -= 128;
  if (t < 256) { cvt_tile(c.in(I_WOUT) + (size_t)l * 1024 * 1024, 1024, (u16*)(wl + WS_OUT), 1024, (t / 16) * 64, (t % 16) * 64, 0, tb); return; }
  t -= 256;
  cvt_router_tile(c.in(I_WR) + (size_t)l * 1024 * 64, (u16*)(wl + WS_R), t * 64, tb);
}
#define NCVT_EXP (65 * 192)
__device__ __forceinline__ void cvt_expert(const Ctx& c, int l, int t) {
  float* tb = reinterpret_cast<float*>(c.lds);
  const int e = t / 192; int r = t % 192;
  char* we = c.p.ws + OFF_WE + (size_t)e * WE_ONE;
  const float* sg = e < 64 ? c.in(I_EG) + (size_t)(l * 64 + e) * 1024 * 256 : c.in(I_SG) + (size_t)l * 1024 * 256;
  const float* su = e < 64 ? c.in(I_EU) + (size_t)(l * 64 + e) * 1024 * 256 : c.in(I_SU) + (size_t)l * 1024 * 256;
  const float* sd = e < 64 ? c.in(I_ED) + (size_t)(l * 64 + e) * 256 * 1024 : c.in(I_SD) + (size_t)l * 256 * 1024;
  if (r < 64) { cvt_tile(sg, 256, (u16*)we, 1024, (r / 4) * 64, (r % 4) * 64, 0, tb); return; }
  r -= 64;
  if (r < 64) { cvt_tile(su, 256, (u16*)we, 1024, (r / 4) * 64, (r % 4) * 64, 256, tb); return; }
  r -= 64;
  cvt_tile(sd, 1024, (u16*)(we + WE_GU), 256, (r / 16) * 64, (r % 16) * 64, 0, tb);
}

__device__ __forceinline__ void step_prep(const Ctx& c) {
  const int G = gridDim.x;
  const int n_cvt = 2 * NCVT_SMALL, n_mod = 192, n_s5 = 8, n_misc = 1;
  const int total = n_cvt + n_mod + n_s5 + n_misc;
  for (int it = blockIdx.x; it < total; it += G) {
    if (it < n_cvt) { cvt_small(c, it / NCVT_SMALL, it % NCVT_SMALL); continue; }
    int i = it - n_cvt;
    if (i < n_mod) {
      const int l = i / 96, cb = i % 96;
      float* sil = reinterpret_cast<float*>(c.lds);
      float* red = sil + 5 * 1024;
      for (int q = c.tid; q < 5 * 1024; q += NTHR) { int r = q >> 10, k = q & 1023; float v = r < 4 ? c.in(I_C)[r * 1024 + k] : c.in(I_CCTX)[k]; sil[q] = silu_(v); }
      __syncthreads();
      const int col = c.tid & 63, kp = c.tid >> 6;
      float a0 = 0, a1 = 0, a2 = 0, a3 = 0, a4 = 0;
      const float* wm_ = c.in(I_WMOD) + (size_t)l * 1024 * 6144 + cb * 64 + col;
      for (int k = kp * 128; k < kp * 128 + 128; ++k) { float wv = wm_[(size_t)k * 6144];
        a0 += sil[k] * wv; a1 += sil[1024 + k] * wv; a2 += sil[2048 + k] * wv; a3 += sil[3072 + k] * wv; a4 += sil[4096 + k] * wv; }
      red[(kp * 5 + 0) * 64 + col] = a0; red[(kp * 5 + 1) * 64 + col] = a1; red[(kp * 5 + 2) * 64 + col] = a2;
      red[(kp * 5 + 3) * 64 + col] = a3; red[(kp * 5 + 4) * 64 + col] = a4;
      __syncthreads();
      if (c.tid < 320) { int r = c.tid >> 6, cc = c.tid & 63; float s = 0;
#pragma unroll
        for (int q = 0; q < 8; ++q) s += red[(q * 5 + r) * 64 + cc];
        s += c.in(I_BMOD)[l * 6144 + cb * 64 + cc];
        c.w<float>(OFF_MOD)[(size_t)(l * 5 + r) * 6144 + cb * 64 + cc] = s; }
      __syncthreads();
      continue;
    }
    i -= n_mod;
    if (i < n_s5) {
      const int q = i * NTHR + c.tid;
      const int ldg = q >> 6;
      const float dt = expf(c.in(I_LSTEP)[ldg]);
      const float lr = c.in(I_LRE)[q], li = c.in(I_LIM)[q];
      const float mag = expf(lr * dt);
      float sn, cs; sincosf(li * dt, &sn, &cs);
      const float are = mag * cs, aim = mag * sn;
      const float den = lr * lr + li * li, nre = are - 1.f;
      const float zre = (nre * lr + aim * li) / den, zim = (aim * lr - nre * li) / den;
      float* A = c.w<float>(OFF_S5A); float* A64 = c.w<float>(OFF_S5A64); float* BB = c.w<float>(OFF_S5BB);
      A[q * 2] = are; A[q * 2 + 1] = aim;
      float pr = are, pi = aim;
#pragma unroll
      for (int s = 0; s < 6; ++s) { float nr = pr * pr - pi * pi, ni = 2.f * pr * pi; pr = nr; pi = ni; }
      A64[q * 2] = pr; A64[q * 2 + 1] = pi;
      const float* bre = c.in(I_BRE) + (size_t)q * 16; const float* bim = c.in(I_BIM) + (size_t)q * 16;
#pragma unroll
      for (int cc = 0; cc < 16; ++cc) { float br = bre[cc], bi = bim[cc];
        BB[((size_t)q * 16 + cc) * 2] = zre * br - zim * bi; BB[((size_t)q * 16 + cc) * 2 + 1] = zre * bi + zim * br; }
      continue;
    }
    for (int q = c.tid; q < 64 * 16; q += NTHR) { int pos = q >> 4, f = q & 15;
      float inv = powf(10000.f, -(float)f / 16.f); float ang = (float)pos * inv; float sn, cs; sincosf(ang, &sn, &cs);
      c.w<float>(OFF_ROPE)[q * 2] = cs; c.w<float>(OFF_ROPE)[q * 2 + 1] = sn; }
  }
}

__device__ __forceinline__ void ln_stats(const float (&v)[16], float& mean, float& rstd) {
  float s = 0;
#pragma unroll
  for (int i = 0; i < 16; ++i) s += v[i];
  mean = wave_sum(s) * (1.f / 1024.f);
  float q = 0;
#pragma unroll
  for (int i = 0; i < 16; ++i) { float d = v[i] - mean; q += d * d; }
  rstd = rsqrtf(wave_sum(q) * (1.f / 1024.f) + LN_EPS);
}
__device__ __forceinline__ void load_row(const float* src, int lane, float (&v)[16]) {
#pragma unroll
  for (int i = 0; i < 4; ++i) { float4 t = *reinterpret_cast<const float4*>(src + (i * 64 + lane) * 4); v[i * 4] = t.x; v[i * 4 + 1] = t.y; v[i * 4 + 2] = t.z; v[i * 4 + 3] = t.w; }
}
__device__ __forceinline__ void store_row(float* dst, int lane, const float (&v)[16]) {
#pragma unroll
  for (int i = 0; i < 4; ++i) *reinterpret_cast<float4*>(dst + (i * 64 + lane) * 4) = make_float4(v[i * 4], v[i * 4 + 1], v[i * 4 + 2], v[i * 4 + 3]);
}
__device__ __forceinline__ void store_row_bf(u16* dst, int lane, const float (&v)[16]) {
#pragma unroll
  for (int i = 0; i < 4; ++i) *reinterpret_cast<uint2*>(dst + (i * 64 + lane) * 4) = make_uint2(pack2(v[i * 4], v[i * 4 + 1]), pack2(v[i * 4 + 2], v[i * 4 + 3]));
}
__device__ __forceinline__ void ln_mod_store(const float (&v)[16], const float* sh, const float* sc, u16* dst, int lane) {
  float mean, rstd; ln_stats(v, mean, rstd);
  float o[16];
#pragma unroll
  for (int i = 0; i < 4; ++i) { float4 a = *reinterpret_cast<const float4*>(sh + (i * 64 + lane) * 4), b = *reinterpret_cast<const float4*>(sc + (i * 64 + lane) * 4);
    o[i * 4] = (v[i * 4] - mean) * rstd * (1.f + b.x) + a.x; o[i * 4 + 1] = (v[i * 4 + 1] - mean) * rstd * (1.f + b.y) + a.y;
    o[i * 4 + 2] = (v[i * 4 + 2] - mean) * rstd * (1.f + b.z) + a.z; o[i * 4 + 3] = (v[i * 4 + 3] - mean) * rstd * (1.f + b.w) + a.w; }
  store_row_bf(dst, lane, o);
}
__device__ __forceinline__ void ln_affine(float (&v)[16], const float* g, const float* b, int lane) {
  float mean, rstd; ln_stats(v, mean, rstd);
#pragma unroll
  for (int i = 0; i < 4; ++i) { float4 a = *reinterpret_cast<const float4*>(g + (i * 64 + lane) * 4), bb = *reinterpret_cast<const float4*>(b + (i * 64 + lane) * 4);
    v[i * 4] = (v[i * 4] - mean) * rstd * a.x + bb.x; v[i * 4 + 1] = (v[i * 4 + 1] - mean) * rstd * a.y + bb.y;
    v[i * 4 + 2] = (v[i * 4 + 2] - mean) * rstd * a.z + bb.z; v[i * 4 + 3] = (v[i * 4 + 3] - mean) * rstd * a.w + bb.w; }
}

__device__ __forceinline__ void step_ln_in(const Ctx& c) {
  u16* U = c.w<u16>(OFF_ACT);
  for (int it = blockIdx.x; it < MTOT / 8; it += gridDim.x) {
    const int row = it * 8 + c.wid;
    const float* src = row < TLAT ? c.in(I_X) + (size_t)row * 1024 : c.in(I_CTX) + (size_t)(row - TLAT) * 1024;
    float v[16]; load_row(src, c.lane, v);
    const int br = brow_of(row);
    ln_mod_store(v, c.mod(0, br, 0), c.mod(0, br, 1), U + (size_t)row * 1024, c.lane);
  }
}

__device__ __forceinline__ void step_gemm_in(const Ctx& c, int l) {
  const u16* U = c.w<u16>(OFF_ACT);
  const u16* W = reinterpret_cast<const u16*>(c.p.ws + OFF_WS + (size_t)l * WS_LAYER + WS_WIN);
  u16* P = c.w<u16>(OFF_BIG + BIG_P);
  const int wm = c.wid >> 1, wn = c.wid & 1, fr = c.lane & 15, fq = c.lane >> 4;
  for (int it = blockIdx.x; it < 68 * 42; it += gridDim.x) {
    const int tm = it / 42, tn = it % 42;
    f32x4 acc[4][4]; ZERO_ACC(acc);
    gemm_acc(acc, [&](int r) { return U + (size_t)(tm * 256 + r) * 1024; }, [&](int b) { return W + (size_t)(tn * 128 + b) * 1024; }, 1024, c.lds);
    const int cls = tn < 2 ? 0 : (tn < 6 ? 1 : (tn < 18 ? 0 : 2));
    { EPI_ROWS(tm * 256)
        u16* dst = P + (size_t)row * INW + tn * 128 + wn * 64 + fr;
#pragma unroll
        for (int n = 0; n < 4; ++n) { float v = acc[m][n][j];
          if (cls == 1) v = gelu_tanh(v); else if (cls == 2) v = sigmoidf_(v);
          dst[n * 16] = f2bf(v); }
      EPI_END }
  }
}

__device__ __forceinline__ void step_mix_a(const Ctx& c, int l, bool last) {
  u16* P = c.w<u16>(OFF_BIG + BIG_P);
  const int n_rope = 1024, n_s5 = 4 * 2 * NCHK, n_gm = (last ? 128 : 136) * 4, n_cv = NCVT_EXP;
  const int total = n_rope + n_s5 + n_gm + n_cv;
  for (int it = blockIdx.x; it < total; it += gridDim.x) {
    int i = it;
    if (i < n_rope) {
      const int gid = i * NTHR + c.tid; const int row = gid >> 5, sub = gid & 31, grp = sub >> 1, half = sub & 1;
      u16* base = P + (size_t)row * INW + 768 + grp * 64 + half * 32;
      const int t = row & 4095; const int pos = half == 0 ? (t >> 6) : (t & 63);
      const float* tab = c.w<float>(OFF_ROPE) + pos * 32;
      u32x4 x1a = *reinterpret_cast<const u32x4*>(base), x1b = *reinterpret_cast<const u32x4*>(base + 8);
      u32x4 x2a = *reinterpret_cast<const u32x4*>(base + 16), x2b = *reinterpret_cast<const u32x4*>(base + 24);
      u32x4 o1a, o1b, o2a, o2b;
#define ROPE2(X1, X2, O1, O2, W, F0) do { float cs0 = tab[(F0) * 2], sn0 = tab[(F0) * 2 + 1], cs1 = tab[(F0) * 2 + 2], sn1 = tab[(F0) * 2 + 3]; \
        float a0 = bflo(X1[W]), a1 = bfhi(X1[W]), b0 = bflo(X2[W]), b1 = bfhi(X2[W]); \
        O1[W] = pack2(a0 * cs0 - b0 * sn0, a1 * cs1 - b1 * sn1); O2[W] = pack2(b0 * cs0 + a0 * sn0, b1 * cs1 + a1 * sn1); } while (0)
      ROPE2(x1a, x2a, o1a, o2a, 0, 0); ROPE2(x1a, x2a, o1a, o2a, 1, 2); ROPE2(x1a, x2a, o1a, o2a, 2, 4); ROPE2(x1a, x2a, o1a, o2a, 3, 6);
      ROPE2(x1b, x2b, o1b, o2b, 0, 8); ROPE2(x1b, x2b, o1b, o2b, 1, 10); ROPE2(x1b, x2b, o1b, o2b, 2, 12); ROPE2(x1b, x2b, o1b, o2b, 3, 14);
#undef ROPE2
      *reinterpret_cast<u32x4*>(base) = o1a; *reinterpret_cast<u32x4*>(base + 8) = o1b;
      *reinterpret_cast<u32x4*>(base + 16) = o2a; *reinterpret_cast<u32x4*>(base + 24) = o2b;
      continue;
    }
    i -= n_rope;
    if (i < n_s5) {
      const int b = i / (2 * NCHK), rem = i % (2 * NCHK), dir = rem / NCHK, ck = rem % NCHK;
      const float* A = c.w<float>(OFF_S5A); const float* BB = c.w<float>(OFF_S5BB); float* E = c.w<float>(OFF_E);
#pragma unroll 1
      for (int gi = 0; gi < 2; ++gi) {
        const int g = c.wid * 2 + gi; const int q = ((l * 2 + dir) * 16 + g) * 64 + c.lane;
        const float are = A[q * 2], aim = A[q * 2 + 1];
        float bbr[16], bbi[16];
#pragma unroll
        for (int cc = 0; cc < 16; ++cc) { float2 t = *reinterpret_cast<const float2*>(BB + ((size_t)q * 16 + cc) * 2); bbr[cc] = t.x; bbi[cc] = t.y; }
        float sr = 0.f, si = 0.f;
        for (int j = 0; j < 64; ++j) {
          const int tau = ck * 64 + j; int row;
          if (tau < 256) row = TLAT + b * 256 + (dir ? 255 - tau : tau); else { int tt = tau - 256; row = b * 4096 + (dir ? 4095 - tt : tt); }
          const u16* up = P + (size_t)row * INW + g * 16;
          u32x4 u0 = *reinterpret_cast<const u32x4*>(up), u1 = *reinterpret_cast<const u32x4*>(up + 8);
          float br = 0.f, bi = 0.f;
#pragma unroll
          for (int w = 0; w < 4; ++w) { float x0 = bflo(u0[w]), x1 = bfhi(u0[w]), y0 = bflo(u1[w]), y1 = bfhi(u1[w]);
            br += bbr[2 * w] * x0 + bbr[2 * w + 1] * x1 + bbr[8 + 2 * w] * y0 + bbr[8 + 2 * w + 1] * y1;
            bi += bbi[2 * w] * x0 + bbi[2 * w + 1] * x1 + bbi[8 + 2 * w] * y0 + bbi[8 + 2 * w + 1] * y1; }
          const float nr = are * sr - aim * si + br, ni = are * si + aim * sr + bi; sr = nr; si = ni;
        }
        *reinterpret_cast<float2*>(E + ((size_t)(((b * 2 + dir) * NCHK + ck) * 16 + g) * 64 + c.lane) * 2) = make_float2(sr, si);
      }
      continue;
    }
    i -= n_s5;
    if (i < n_gm) {
      const int ck = i >> 2, h = i & 3; const int row0 = ck * 128;
      float* vh = reinterpret_cast<float*>(c.lds);
      for (int q = 0; q < 16; ++q) {
        const int s = c.wid * 16 + q; const u16* vp = P + (size_t)(row0 + s) * INW + 512 + c.lane * 4;
        uint2 t = *reinterpret_cast<const uint2*>(vp);
        float v0 = bflo(t.x), v1 = bfhi(t.x), v2 = bflo(t.y), v3 = bfhi(t.y);
        float mean = wave_sum(v0 + v1 + v2 + v3) * (1.f / 256.f);
        float d0 = v0 - mean, d1 = v1 - mean, d2 = v2 - mean, d3 = v3 - mean;
        float rstd = rsqrtf(wave_sum(d0 * d0 + d1 * d1 + d2 * d2 + d3 * d3) * (1.f / 256.f) + LN_EPS);
        if ((c.lane >> 4) == h) *reinterpret_cast<float4*>(vh + s * 64 + (c.lane & 15) * 4) = make_float4(d0 * rstd, d1 * rstd, d2 * rstd, d3 * rstd);
      }
      __syncthreads();
      const int t = c.tid >> 2, cq = c.tid & 3;
      float acc[16];
#pragma unroll
      for (int q = 0; q < 16; ++q) acc[q] = 0.f;
      const float* wrow = c.in(I_GMW) + ((size_t)(l * 4 + h) * 128 + t) * 128;
      for (int s4 = 0; s4 < 32; ++s4) {
        float4 w4 = *reinterpret_cast<const float4*>(wrow + s4 * 4);
        float wv[4] = {w4.x, w4.y, w4.z, w4.w};
#pragma unroll
        for (int ss = 0; ss < 4; ++ss) {
          const float* vr = vh + (s4 * 4 + ss) * 64 + cq * 16;
#pragma unroll
          for (int q4 = 0; q4 < 4; ++q4) { float4 x = *reinterpret_cast<const float4*>(vr + q4 * 4);
            acc[q4 * 4] += wv[ss] * x.x; acc[q4 * 4 + 1] += wv[ss] * x.y; acc[q4 * 4 + 2] += wv[ss] * x.z; acc[q4 * 4 + 3] += wv[ss] * x.w; }
        }
      }
      const float bs = c.in(I_GMB)[(l * 4 + h) * 128 + t];
      const u16* up = P + (size_t)(row0 + t) * INW + 256 + h * 64 + cq * 16;
      u32x4 u0 = *reinterpret_cast<const u32x4*>(up), u1 = *reinterpret_cast<const u32x4*>(up + 8);
      u32x4 o0, o1;
#pragma unroll
      for (int w = 0; w < 4; ++w) { o0[w] = pack2(bflo(u0[w]) * (acc[2 * w] + bs), bfhi(u0[w]) * (acc[2 * w + 1] + bs));
        o1[w] = pack2(bflo(u1[w]) * (acc[8 + 2 * w] + bs), bfhi(u1[w]) * (acc[8 + 2 * w + 1] + bs)); }
      u16* yb = c.w<u16>(OFF_BIG + BIG_YB) + (size_t)(row0 + t) * 256 + h * 64 + cq * 16;
      *reinterpret_cast<u32x4*>(yb) = o0; *reinterpret_cast<u32x4*>(yb + 8) = o1;
      __syncthreads();
      continue;
    }
    i -= n_gm;
    cvt_expert(c, l, i);
  }
}

#define SB_LD 136
__device__ __forceinline__ void s5_out_item(const Ctx& c, int l, int b, int seg, int j) {
  const u16* P = c.w<u16>(OFF_BIG + BIG_P); u16* YA = c.w<u16>(OFF_BIG + BIG_YA);
  const float* A = c.w<float>(OFF_S5A); const float* A64 = c.w<float>(OFF_S5A64); const float* BB = c.w<float>(OFF_S5BB); const float* E = c.w<float>(OFF_E);
  const int r0 = seg ? (TLAT + b * 256 + j * 64) : (b * 4096 + j * 64);
  const int kf = seg ? j : 4 + j, kr = seg ? 3 - j : 4 + (63 - j);
  int tid_ = c.tid; asm volatile("" : "+v"(tid_));
  const int lane = tid_ & 63, fr = lane & 15, fq = lane >> 4, wid_ = __builtin_amdgcn_readfirstlane(tid_ >> 6);
  float* ubuf = reinterpret_cast<float*>(c.lds + wid_ * 8704);
  u16* sbuf = reinterpret_cast<u16*>(c.lds + wid_ * 8704 + 4096);
#pragma unroll 1
  for (int gi = 0; gi < 2; ++gi) {
    const int g = wid_ * 2 + gi;
    { const u16* up = P + (size_t)(r0 + lane) * INW + g * 16;
      u32x4 u0 = *reinterpret_cast<const u32x4*>(up), u1 = *reinterpret_cast<const u32x4*>(up + 8);
      float* ub = ubuf + lane * 16;
      *reinterpret_cast<float4*>(ub) = make_float4(bflo(u0[0]), bfhi(u0[0]), bflo(u0[1]), bfhi(u0[1]));
      *reinterpret_cast<float4*>(ub + 4) = make_float4(bflo(u0[2]), bfhi(u0[2]), bflo(u0[3]), bfhi(u0[3]));
      *reinterpret_cast<float4*>(ub + 8) = make_float4(bflo(u1[0]), bfhi(u1[0]), bflo(u1[1]), bfhi(u1[1]));
      *reinterpret_cast<float4*>(ub + 12) = make_float4(bflo(u1[2]), bfhi(u1[2]), bflo(u1[3]), bfhi(u1[3])); }
    __builtin_amdgcn_wave_barrier(); asm volatile("s_waitcnt lgkmcnt(0)" ::: "memory");
    f32x4 acc[4];
#pragma unroll
    for (int q = 0; q < 4; ++q) acc[q] = (f32x4){0.f, 0.f, 0.f, 0.f};
#pragma unroll 1
    for (int dir = 0; dir < 2; ++dir) {
      const int q = ((l * 2 + dir) * 16 + g) * 64 + lane;
      const float are = A[q * 2], aim = A[q * 2 + 1], a64r = A64[q * 2], a64i = A64[q * 2 + 1];
      float bbr[16], bbi[16];
#pragma unroll
      for (int cc = 0; cc < 16; ++cc) { float2 t = *reinterpret_cast<const float2*>(BB + ((size_t)q * 16 + cc) * 2); bbr[cc] = t.x; bbi[cc] = t.y; }
      float sr = 0.f, si = 0.f; const int kk = dir ? kr : kf;
      for (int jj = 0; jj < kk; ++jj) { float2 e = *reinterpret_cast<const float2*>(E + ((size_t)(((b * 2 + dir) * NCHK + jj) * 16 + g) * 64 + lane) * 2);
        float nr = a64r * sr - a64i * si + e.x, ni = a64r * si + a64i * sr + e.y; sr = nr; si = ni; }
      bf16x8 Bf[4];
      { const float* cre = c.in(I_CRE) + ((size_t)((l * 2 + dir) * 16 + g) * 16 + fr) * 64; const float* cim = c.in(I_CIM) + ((size_t)((l * 2 + dir) * 16 + g) * 16 + fr) * 64;
#pragma unroll
        for (int ks = 0; ks < 4; ++ks) {
#pragma unroll
          for (int ii = 0; ii < 8; ++ii) { int k = ks * 32 + fq * 8 + ii; float v = ks < 2 ? cre[k] : -cim[k - 64]; Bf[ks][ii] = (short)f2bf(v); } } }
#pragma unroll
      for (int sub = 0; sub < 4; ++sub) {
#pragma unroll 4
        for (int jj = 0; jj < 16; ++jj) {
          const int tau = sub * 16 + jj; const int tl = dir ? 63 - tau : tau;
          const float* ub = ubuf + tl * 16;
          float4 x0 = *reinterpret_cast<const float4*>(ub), x1 = *reinterpret_cast<const float4*>(ub + 4), x2 = *reinterpret_cast<const float4*>(ub + 8), x3 = *reinterpret_cast<const float4*>(ub + 12);
          float br = bbr[0] * x0.x + bbr[1] * x0.y + bbr[2] * x0.z + bbr[3] * x0.w + bbr[4] * x1.x + bbr[5] * x1.y + bbr[6] * x1.z + bbr[7] * x1.w
                   + bbr[8] * x2.x + bbr[9] * x2.y + bbr[10] * x2.z + bbr[11] * x2.w + bbr[12] * x3.x + bbr[13] * x3.y + bbr[14] * x3.z + bbr[15] * x3.w;
          float bi = bbi[0] * x0.x + bbi[1] * x0.y + bbi[2] * x0.z + bbi[3] * x0.w + bbi[4] * x1.x + bbi[5] * x1.y + bbi[6] * x1.z + bbi[7] * x1.w
                   + bbi[8] * x2.x + bbi[9] * x2.y + bbi[10] * x2.z + bbi[11] * x2.w + bbi[12] * x3.x + bbi[13] * x3.y + bbi[14] * x3.z + bbi[15] * x3.w;
          const float nr = are * sr - aim * si + br, ni = are * si + aim * sr + bi; sr = nr; si = ni;
          sbuf[(tl & 15) * SB_LD + lane] = f2bf(sr); sbuf[(tl & 15) * SB_LD + 64 + lane] = f2bf(si);
        }
        __builtin_amdgcn_wave_barrier(); asm volatile("s_waitcnt lgkmcnt(0)" ::: "memory");
        bf16x8 Af[4];
#pragma unroll
        for (int ks = 0; ks < 4; ++ks) Af[ks] = *reinterpret_cast<const bf16x8*>(sbuf + fr * SB_LD + ks * 32 + fq * 8);
        asm volatile("s_waitcnt lgkmcnt(0)" ::: "memory"); __builtin_amdgcn_wave_barrier();
        if (dir == 0) {
#pragma unroll
          for (int ks = 0; ks < 4; ++ks) acc[sub] = __builtin_amdgcn_mfma_f32_16x16x32_bf16(Af[ks], Bf[ks], acc[sub], 0, 0, 0);
        } else {
#pragma unroll
          for (int ks = 0; ks < 4; ++ks) acc[3 - sub] = __builtin_amdgcn_mfma_f32_16x16x32_bf16(Af[ks], Bf[ks], acc[3 - sub], 0, 0, 0);
        }
      }
    }
    const float dsk = c.in(I_S5D)[l * 256 + g * 16 + fr];
#pragma unroll
    for (int tb = 0; tb < 4; ++tb)
#pragma unroll
      for (int jx = 0; jx < 4; ++jx) { const int tl = tb * 16 + fq * 4 + jx; float y = dsk * ubuf[tl * 16 + fr] + acc[tb][jx];
        YA[(size_t)(r0 + tl) * 256 + g * 16 + fr] = f2bf(gelu_tanh(y)); }
    __builtin_amdgcn_wave_barrier(); asm volatile("s_waitcnt lgkmcnt(0)" ::: "memory");
  }
}

__device__ __forceinline__ void attn_naive_item(const Ctx& c, int l, int b, int h, int qb, int seg) {
  const u16* P = c.w<u16>(OFF_BIG + BIG_P); u16* YC = c.w<u16>(OFF_BIG + BIG_YC);
  const int ql = c.tid >> 2, vq = c.tid & 3;
  const int qrow = seg ? (TLAT + b * 256 + qb * 128 + ql) : (b * 4096 + qb * 128 + ql);
  const int nkeys = seg ? 256 : 4352;
  const float lam_init = 0.8f - 0.6f * expf(-0.3f * (float)l);
  float lam;
  { const float* lf = c.in(I_DALAM) + l * 256; float s1 = 0.f, s2 = 0.f;
    for (int d = 0; d < 64; ++d) { s1 += lf[d] * lf[64 + d]; s2 += lf[128 + d] * lf[192 + d]; }
    lam = expf(s1) - expf(s2) + lam_init; }
  float res[32];
#pragma unroll 1
  for (int mp = 0; mp < 2; ++mp) {
    float q[64];
    { const u16* qp = P + (size_t)qrow * INW + 768 + h * 128 + mp * 64;
#pragma unroll
      for (int w = 0; w < 8; ++w) { u32x4 t = *reinterpret_cast<const u32x4*>(qp + w * 8);
#pragma unroll
        for (int e = 0; e < 4; ++e) { q[w * 8 + 2 * e] = bflo(t[e]) * 0.125f; q[w * 8 + 2 * e + 1] = bfhi(t[e]) * 0.125f; } } }
    float o[32];
#pragma unroll
    for (int d = 0; d < 32; ++d) o[d] = 0.f;
    float mx = -1e30f, ls = 0.f;
#pragma unroll 1
    for (int key = 0; key < nkeys; ++key) {
      const int krow = key < 256 ? (TLAT + b * 256 + key) : (b * 4096 + key - 256);
      const u16* kp = P + (size_t)krow * INW + 1280 + h * 128 + mp * 64;
      float s = 0.f;
#pragma unroll
      for (int w = 0; w < 8; ++w) { u32x4 t = *reinterpret_cast<const u32x4*>(kp + w * 8);
#pragma unroll
        for (int e = 0; e < 4; ++e) s += q[w * 8 + 2 * e] * bflo(t[e]) + q[w * 8 + 2 * e + 1] * bfhi(t[e]); }
      const float mn = fmaxf(mx, s); const float al = __expf(mx - mn), pp = __expf(s - mn); mx = mn; ls = ls * al + pp;
      const u16* vp = P + (size_t)krow * INW + 1792 + h * 128 + vq * 32;
#pragma unroll
      for (int w = 0; w < 4; ++w) { u32x4 t = *reinterpret_cast<const u32x4*>(vp + w * 8);
#pragma unroll
        for (int e = 0; e < 4; ++e) { o[w * 8 + 2 * e] = o[w * 8 + 2 * e] * al + pp * bflo(t[e]); o[w * 8 + 2 * e + 1] = o[w * 8 + 2 * e + 1] * al + pp * bfhi(t[e]); } }
    }
    const float inv = 1.f / ls;
    if (mp == 0) {
#pragma unroll
      for (int d = 0; d < 32; ++d) res[d] = o[d] * inv;
    } else {
#pragma unroll
      for (int d = 0; d < 32; ++d) res[d] = res[d] - lam * o[d] * inv;
    }
  }
  float ss = 0.f;
#pragma unroll
  for (int d = 0; d < 32; ++d) ss += res[d] * res[d];
  ss += __shfl_xor(ss, 1, 64); ss += __shfl_xor(ss, 2, 64);
  const float r = rsqrtf(ss * (1.f / 128.f) + LN_EPS) * (1.f - lam_init);
  const float* sg = c.in(I_SUBLN) + l * 128 + vq * 32;
  u16* yp = YC + (size_t)qrow * 512 + h * 128 + vq * 32;
#pragma unroll
  for (int w = 0; w < 4; ++w) { u32x4 t;
#pragma unroll
    for (int e = 0; e < 4; ++e) t[e] = pack2(res[w * 8 + 2 * e] * r * sg[w * 8 + 2 * e], res[w * 8 + 2 * e + 1] * r * sg[w * 8 + 2 * e + 1]);
    *reinterpret_cast<u32x4*>(yp + w * 8) = t; }
}

typedef __attribute__((ext_vector_type(16))) float f32x16;
typedef __attribute__((ext_vector_type(4))) short s16x4;
#define KSWZ(row, colB) ((row) * 256 + ((colB) ^ (((row) & 7) << 4)))
#define SBAR() __builtin_amdgcn_sched_barrier(0)
#define ATT_THR 8.f
__device__ __forceinline__ int crow(int r, int hi) { return (r & 3) + 8 * (r >> 2) + 4 * hi; }
__device__ __forceinline__ unsigned cvtpk(float lo, float hi) { unsigned r; asm volatile("v_cvt_pk_bf16_f32 %0, %1, %2" : "=v"(r) : "v"(lo), "v"(hi)); return r; }
__device__ __forceinline__ int v_rd_base(int lane) { return ((lane & 3) << 3) | (((lane >> 2) & 3) << 6) | (((lane >> 4) & 1) << 5) | (((lane >> 5) & 1) << 8); }
constexpr int v_rd_off(int d0, int ks, int half) { return d0 * 512 + ks * 4096 + half * 2048; }
template <int OFF> __device__ __forceinline__ s16x4 tr_read(int vb) {
  s16x4 r; asm volatile("ds_read_b64_tr_b16 %0, %1 offset:%2" : "=&v"(r) : "v"(vb), "i"(OFF) : "memory"); return r;
}
template <int MAP>
__device__ __forceinline__ void att_qkt(f32x16& p0, f32x16& p1, const char* Ks, const char* Qs, int r32, int hi) {
  p0 = f32x16{}; p1 = f32x16{};
#pragma unroll
  for (int dd = 0; dd < 4; ++dd) { const int d0 = MAP * 4 + dd; const int cb = (d0 * 16 + hi * 8) * 2;
    bf16x8 b0 = *reinterpret_cast<const bf16x8*>(Ks + KSWZ(r32, cb));
    bf16x8 b1 = *reinterpret_cast<const bf16x8*>(Ks + KSWZ(32 + r32, cb));
    bf16x8 qf = *reinterpret_cast<const bf16x8*>(Qs + KSWZ(r32, cb));
    p0 = __builtin_amdgcn_mfma_f32_32x32x16_bf16(b0, qf, p0, 0, 0, 0);
    p1 = __builtin_amdgcn_mfma_f32_32x32x16_bf16(b1, qf, p1, 0, 0, 0); }
}
__device__ __forceinline__ void att_softmax(f32x16& p0, f32x16& p1, float& m_reg, float& l_reg, float& alpha, bf16x8& pa0, bf16x8& pa1, bf16x8& pa2, bf16x8& pa3) {
  constexpr float SC = 0.125f, C = SC * 1.4426950408889634f;
  float pmax = p0[0];
#pragma unroll
  for (int r = 1; r < 16; ++r) pmax = fmaxf(pmax, p0[r]);
#pragma unroll
  for (int r = 0; r < 16; ++r) pmax = fmaxf(pmax, p1[r]);
  { auto rr = __builtin_amdgcn_permlane32_swap(__float_as_uint(pmax), __float_as_uint(pmax), false, false);
    pmax = fmaxf(__uint_as_float(rr[0]), __uint_as_float(rr[1])); }
  float mn;
  if (__builtin_expect(__all(pmax - m_reg <= ATT_THR / SC), 1)) { mn = m_reg; alpha = 1.f; }
  else { mn = fmaxf(m_reg, pmax); alpha = __builtin_amdgcn_exp2f((m_reg - mn) * C); m_reg = mn; }
  const float mnC = -mn * C;
#pragma unroll
  for (int r = 0; r < 16; ++r) p0[r] = __builtin_amdgcn_exp2f(fmaf(p0[r], C, mnC));
#pragma unroll
  for (int r = 0; r < 16; ++r) p1[r] = __builtin_amdgcn_exp2f(fmaf(p1[r], C, mnC));
  float ps = 0.f;
#pragma unroll
  for (int r = 0; r < 16; ++r) ps += p0[r];
#pragma unroll
  for (int r = 0; r < 16; ++r) ps += p1[r];
  { auto rr = __builtin_amdgcn_permlane32_swap(__float_as_uint(ps), __float_as_uint(ps), false, false);
    ps = __uint_as_float(rr[0]) + __uint_as_float(rr[1]); }
  l_reg = l_reg * alpha + ps;
#define PK4(P, BASE, OUT) do { unsigned a0 = cvtpk(P[BASE + 0], P[BASE + 1]), a1 = cvtpk(P[BASE + 2], P[BASE + 3]);   \
    unsigned b0 = cvtpk(P[BASE + 4], P[BASE + 5]), b1 = cvtpk(P[BASE + 6], P[BASE + 7]);                              \
    auto r0 = __builtin_amdgcn_permlane32_swap(a0, b0, false, false); auto r1 = __builtin_amdgcn_permlane32_swap(a1, b1, false, false); \
    u32x4 w = {r0[0], r1[0], r0[1], r1[1]}; OUT = *reinterpret_cast<bf16x8*>(&w); } while (0)
  PK4(p0, 0, pa0); PK4(p0, 8, pa1); PK4(p1, 0, pa2); PK4(p1, 8, pa3);
#undef PK4
}
template <int D0> __device__ __forceinline__ void att_pv(f32x16& oa, f32x16& ob, int vb, const bf16x8 (&pa)[4], const bf16x8 (&pb)[4]) {
  const s16x4 l0 = tr_read<v_rd_off(D0, 0, 0)>(vb), h0 = tr_read<v_rd_off(D0, 0, 1)>(vb), l1 = tr_read<v_rd_off(D0, 1, 0)>(vb), h1 = tr_read<v_rd_off(D0, 1, 1)>(vb);
  const s16x4 l2 = tr_read<v_rd_off(D0, 2, 0)>(vb), h2 = tr_read<v_rd_off(D0, 2, 1)>(vb), l3 = tr_read<v_rd_off(D0, 3, 0)>(vb), h3 = tr_read<v_rd_off(D0, 3, 1)>(vb);
  asm volatile("s_waitcnt lgkmcnt(0)" ::: "memory"); SBAR();
#define PKV(L, H) (bf16x8){L[0], L[1], L[2], L[3], H[0], H[1], H[2], H[3]}
  const bf16x8 v0 = PKV(l0, h0), v1 = PKV(l1, h1), v2 = PKV(l2, h2), v3 = PKV(l3, h3);
#undef PKV
  oa = __builtin_amdgcn_mfma_f32_32x32x16_bf16(pa[0], v0, oa, 0, 0, 0);
  ob = __builtin_amdgcn_mfma_f32_32x32x16_bf16(pb[0], v0, ob, 0, 0, 0);
  oa = __builtin_amdgcn_mfma_f32_32x32x16_bf16(pa[1], v1, oa, 0, 0, 0);
  ob = __builtin_amdgcn_mfma_f32_32x32x16_bf16(pb[1], v1, ob, 0, 0, 0);
  oa = __builtin_amdgcn_mfma_f32_32x32x16_bf16(pa[2], v2, oa, 0, 0, 0);
  ob = __builtin_amdgcn_mfma_f32_32x32x16_bf16(pb[2], v2, ob, 0, 0, 0);
  oa = __builtin_amdgcn_mfma_f32_32x32x16_bf16(pa[3], v3, oa, 0, 0, 0);
  ob = __builtin_amdgcn_mfma_f32_32x32x16_bf16(pb[3], v3, ob, 0, 0, 0);
}
#define ATT_KBUF(b) ((b) * 16384)
#define ATT_VBUF(b) (32768 + (b) * 16384)
#define ATT_WS_OFF 65536
#define ATT_Q_OFF 69632
__device__ __forceinline__ void attn_mfma_item(const Ctx& c, int l, int b, int h, int qb, int seg) {
  const u16* P = c.w<u16>(OFF_BIG + BIG_P); u16* YC = c.w<u16>(OFF_BIG + BIG_YC);
  int tid = c.tid; asm volatile("" : "+v"(tid));
  const int wid = __builtin_amdgcn_readfirstlane(tid >> 6), lane = tid & 63, r32 = lane & 31, hi = lane >> 5;
  const int q0 = seg ? (TLAT + b * 256) : (b * 4096 + qb * 256);
  const int NT = seg ? 4 : 68;
  float* wsl = reinterpret_cast<float*>(c.lds + ATT_WS_OFF) + wid * 64;
  const float lam_init = 0.8f - 0.6f * expf(-0.3f * (float)l);
  float lam;
  { const float* lf = c.in(I_DALAM) + l * 256; float s1 = lf[lane] * lf[64 + lane], s2 = lf[128 + lane] * lf[192 + lane];
    s1 = wave_sum(s1); s2 = wave_sum(s2); lam = expf(s1) - expf(s2) + lam_init; }
#pragma unroll
  for (int i = 0; i < 8; ++i) { const int q = i * NTHR + tid, row = q >> 4, col = ((q & 15) ^ (row & 7)) * 8;
    glds16(P + (size_t)(q0 + row) * INW + 768 + h * 128 + col, c.lds + ATT_Q_OFF + (i * NTHR + tid) * 16); }
  const char* Qs = c.lds + ATT_Q_OFF + wid * 32 * 256;
  int krow[2], kcol[2], vrow[2], vcol[2];
#pragma unroll
  for (int i = 0; i < 2; ++i) { const int q = i * NTHR + tid;
    krow[i] = q >> 4; kcol[i] = ((q & 15) ^ (krow[i] & 7)) * 8;
    const int st = q >> 5, r5 = q & 31, kk = ((st >> 2) << 3) | (r5 >> 2);
    vrow[i] = (kk & ~0xC) | ((kk & 4) << 1) | ((kk & 8) >> 1); vcol[i] = (st & 3) * 32 + (r5 & 3) * 8; }
  auto issue_tile = [&](int jt, int buf) {
    const int kr0 = (jt < 4) ? (TLAT + b * 256 + jt * 64) : (b * 4096 + (jt - 4) * 64);
#pragma unroll
    for (int i = 0; i < 2; ++i) {
      glds16(P + (size_t)(kr0 + krow[i]) * INW + 1280 + h * 128 + kcol[i], c.lds + ATT_KBUF(buf) + (i * NTHR + tid) * 16);
      glds16(P + (size_t)(kr0 + vrow[i]) * INW + 1792 + h * 128 + vcol[i], c.lds + ATT_VBUF(buf) + (i * NTHR + tid) * 16); }
  };
  f32x16 o0[4], o1[4];
#pragma unroll
  for (int d = 0; d < 4; ++d) { o0[d] = f32x16{}; o1[d] = f32x16{}; }
  float m0 = -1e30f, l0 = 0.f, m1 = -1e30f, l1 = 0.f;
  const int vbase = (int)(uintptr_t)(c.lds) + v_rd_base(lane);
  issue_tile(0, 0);
  asm volatile("s_waitcnt vmcnt(0)" ::: "memory");
  __syncthreads();
#pragma unroll 1
  for (int jt = 0; jt < NT; ++jt) {
    const int buf = jt & 1;
    if (jt + 1 < NT) issue_tile(jt + 1, buf ^ 1);
    const char* Ks = c.lds + ATT_KBUF(buf);
    bf16x8 pa[4], pb[4]; float al0, al1;
    { f32x16 p0, p1; att_qkt<0>(p0, p1, Ks, Qs, r32, hi); att_softmax(p0, p1, m0, l0, al0, pa[0], pa[1], pa[2], pa[3]); }
    { f32x16 p0, p1; att_qkt<1>(p0, p1, Ks, Qs, r32, hi); att_softmax(p0, p1, m1, l1, al1, pb[0], pb[1], pb[2], pb[3]); }
    if (__any(al0 < 1.f || al1 < 1.f)) {
      if (hi == 0) { wsl[r32] = al0; wsl[32 + r32] = al1; }
      asm volatile("s_waitcnt lgkmcnt(0)" ::: "memory");
#pragma unroll
      for (int r = 0; r < 16; ++r) { const float a0 = wsl[crow(r, hi)], a1 = wsl[32 + crow(r, hi)];
#pragma unroll
        for (int d = 0; d < 4; ++d) { o0[d][r] *= a0; o1[d][r] *= a1; } }
    }
    const int vb = vbase + ATT_VBUF(buf);
    att_pv<0>(o0[0], o1[0], vb, pa, pb); att_pv<1>(o0[1], o1[1], vb, pa, pb); att_pv<2>(o0[2], o1[2], vb, pa, pb); att_pv<3>(o0[3], o1[3], vb, pa, pb);
    asm volatile("s_waitcnt vmcnt(0)" ::: "memory");
    __syncthreads();
  }
  if (hi == 0) { wsl[r32] = 1.f / l0; wsl[32 + r32] = lam / l1; }
  asm volatile("s_waitcnt lgkmcnt(0)" ::: "memory");
  float ss[16];
#pragma unroll
  for (int r = 0; r < 16; ++r) { const float i0 = wsl[crow(r, hi)], i1 = wsl[32 + crow(r, hi)]; float s = 0.f;
#pragma unroll
    for (int d = 0; d < 4; ++d) { const float v = o0[d][r] * i0 - o1[d][r] * i1; o0[d][r] = v; s += v * v; }
    ss[r] = s; }
#pragma unroll
  for (int r = 0; r < 16; ++r) {
#pragma unroll
    for (int mk = 1; mk < 32; mk <<= 1) ss[r] += __shfl_xor(ss[r], mk, 64);
    ss[r] = rsqrtf(ss[r] * (1.f / 128.f) + LN_EPS) * (1.f - lam_init); }
  const float* sg = c.in(I_SUBLN) + l * 128;
  float g4[4];
#pragma unroll
  for (int d = 0; d < 4; ++d) g4[d] = sg[d * 32 + r32];
#pragma unroll
  for (int r = 0; r < 16; ++r) { u16* yp = YC + (size_t)(q0 + wid * 32 + crow(r, hi)) * 512 + h * 128 + r32;
#pragma unroll
    for (int d = 0; d < 4; ++d) yp[d * 32] = f2bf(o0[d][r] * ss[r] * g4[d]); }
  __syncthreads();
}

__device__ __forceinline__ void step_mix_b(const Ctx& c, int l, bool last) {
#ifdef NAIVE_ATTN
  const int n_att = 512, n_attc = last ? 0 : 32, n_s5 = 4 * 64, n_s5c = last ? 0 : 16;
#else
  const int n_att = 256, n_attc = last ? 0 : 16, n_s5 = 4 * 64, n_s5c = last ? 0 : 16;
#endif
  const int total = n_att + n_attc + n_s5 + n_s5c;
  for (int it = blockIdx.x; it < total; it += gridDim.x) {
    int i = it;
#ifdef NAIVE_ATTN
    if (i < n_att) { const int bh = i >> 5, qb = i & 31; attn_naive_item(c, l, bh >> 2, bh & 3, qb, 0); continue; }
    i -= n_att;
    if (i < n_attc) { const int bh = i >> 1; attn_naive_item(c, l, bh >> 2, bh & 3, i & 1, 1); continue; }
#else
    if (i < n_att) { const int xcd = i & 7, slot = i >> 3; const int bh = xcd * 2 + (slot >> 4), qb = slot & 15;
      attn_mfma_item(c, l, bh >> 2, bh & 3, qb, 0); continue; }
    i -= n_att;
    if (i < n_attc) { attn_mfma_item(c, l, i >> 2, i & 3, 0, 1); continue; }
#endif
    i -= n_attc;
    if (i < n_s5) { s5_out_item(c, l, i >> 6, 0, i & 63); continue; }
    i -= n_s5;
    s5_out_item(c, l, i >> 2, 1, i & 3);
  }
}

__device__ __forceinline__ void step_merge(const Ctx& c, int l, bool last) {
  const char* wl = c.p.ws + OFF_WS + (size_t)l * WS_LAYER;
  const u16* WGLU = (const u16*)(wl + WS_GLU); const u16* WGM = (const u16*)(wl + WS_GM); const u16* WDA = (const u16*)(wl + WS_DA);
  const u16* P = c.w<u16>(OFF_BIG + BIG_P); const u16* YA = c.w<u16>(OFF_BIG + BIG_YA); const u16* YB = c.w<u16>(OFF_BIG + BIG_YB); const u16* YC = c.w<u16>(OFF_BIG + BIG_YC);
  u16* Mb = c.w<u16>(OFF_BIG + BIG_M);
  const int wm = c.wid >> 1, wn = c.wid & 1, fr = c.lane & 15, fq = c.lane >> 4;
  const int ntm = last ? 64 : 68;
  for (int it = blockIdx.x; it < ntm * 16; it += gridDim.x) {
    const int tm = it >> 4, tn = it & 15;
    f32x4 am[4][2];
    { f32x4 t[4][4]; ZERO_ACC(t);
      gemm_acc_t<4>(t, [&](int r) { return YA + (size_t)(tm * 256 + r) * 256; },
                    [&](int b) { const int wn_ = b >> 6, nn = (b >> 4) & 3, f_ = b & 15; return WGLU + (size_t)((nn >> 1) * 1024 + tn * 64 + wn_ * 32 + (nn & 1) * 16 + f_) * 256; }, 256, c.lds);
      { EPI_ROWS(tm * 256)
          const u16* gp = P + (size_t)row * INW + 2304 + tn * 64 + wn * 32 + fr;
#pragma unroll
          for (int n = 0; n < 2; ++n) am[m][n][j] = bf2f(gp[n * 16]) * t[m][n][j] * sigmoidf_(t[m][n + 2][j]);
        EPI_END } }
    { f32x4 t[4][2];
#pragma unroll
      for (int m = 0; m < 4; ++m) { t[m][0] = (f32x4){0.f, 0.f, 0.f, 0.f}; t[m][1] = (f32x4){0.f, 0.f, 0.f, 0.f}; }
      gemm_acc_t<2>(t, [&](int r) { return YB + (size_t)(tm * 256 + r) * 256; }, [&](int b) { return WGM + (size_t)(tn * 64 + b) * 256; }, 256, c.lds);
      { EPI_ROWS(tm * 256)
          const u16* gp = P + (size_t)row * INW + 2304 + 1024 + tn * 64 + wn * 32 + fr;
#pragma unroll
          for (int n = 0; n < 2; ++n) am[m][n][j] += bf2f(gp[n * 16]) * t[m][n][j];
        EPI_END } }
    { f32x4 t[4][2];
#pragma unroll
      for (int m = 0; m < 4; ++m) { t[m][0] = (f32x4){0.f, 0.f, 0.f, 0.f}; t[m][1] = (f32x4){0.f, 0.f, 0.f, 0.f}; }
      gemm_acc_t<2>(t, [&](int r) { return YC + (size_t)(tm * 256 + r) * 512; }, [&](int b) { return WDA + (size_t)(tn * 64 + b) * 512; }, 512, c.lds);
      { EPI_ROWS(tm * 256)
          const u16* gp = P + (size_t)row * INW + 2304 + 2048 + tn * 64 + wn * 32 + fr;
          u16* dst = Mb + (size_t)row * 1024 + tn * 64 + wn * 32 + fr;
#pragma unroll
          for (int n = 0; n < 2; ++n) dst[n * 16] = f2bf(am[m][n][j] + bf2f(gp[n * 16]) * t[m][n][j]);
        EPI_END } }
  }
}

__device__ __forceinline__ void step_out(const Ctx& c, int l, bool last) {
  const u16* WOUT = (const u16*)(c.p.ws + OFF_WS + (size_t)l * WS_LAYER + WS_OUT);
  const u16* Mb = c.w<u16>(OFF_BIG + BIG_M); float* H = c.w<float>(OFF_H);
  const int wm = c.wid >> 1, wn = c.wid & 1, fr = c.lane & 15, fq = c.lane >> 4;
  const int ntm = last ? 64 : 68;
  for (int it = blockIdx.x; it < ntm * 8; it += gridDim.x) {
    const int tm = it >> 3, tn = it & 7;
    f32x4 acc[4][4]; ZERO_ACC(acc);
    gemm_acc(acc, [&](int r) { return Mb + (size_t)(tm * 256 + r) * 1024; }, [&](int b) { return WOUT + (size_t)(tn * 128 + b) * 1024; }, 1024, c.lds);
    { EPI_ROWS(tm * 256)
        const int cb = tn * 128 + wn * 64 + fr;
        const float* hs = (l == 0) ? (row < TLAT ? c.in(I_X) + (size_t)row * 1024 : c.in(I_CTX) + (size_t)(row - TLAT) * 1024) : H + (size_t)row * 1024;
        const float* g1 = c.mod(l, brow_of(row), 2);
        float* hd = H + (size_t)row * 1024;
#pragma unroll
        for (int n = 0; n < 4; ++n) hd[cb + n * 16] = ALPHA * hs[cb + n * 16] + g1[cb + n * 16] * acc[m][n][j];
      EPI_END }
  }
}

__device__ __forceinline__ void step_ln_mid(const Ctx& c, int l, int mrows) {
  float* H = c.w<float>(OFF_H); u16* F = c.w<u16>(OFF_ACT);
  for (int it = blockIdx.x; it < mrows / 8; it += gridDim.x) {
    const int row = it * 8 + c.wid; float v[16]; load_row(H + (size_t)row * 1024, c.lane, v);
    ln_affine(v, c.in(I_LN1G) + l * 1024, c.in(I_LN1B) + l * 1024, c.lane);
    store_row(H + (size_t)row * 1024, c.lane, v);
    const int br = brow_of(row);
    ln_mod_store(v, c.mod(l, br, 3), c.mod(l, br, 4), F + (size_t)row * 1024, c.lane);
  }
}

__device__ __forceinline__ void step_router(const Ctx& c, int l, int mrows, int halfrows) {
  const u16* F = c.w<u16>(OFF_ACT); const u16* WR = (const u16*)(c.p.ws + OFF_WS + (size_t)l * WS_LAYER + WS_R);
  int* cnt = c.w<int>(OFF_CNT) + l * 128; int* list = c.w<int>(OFF_LIST); float* topw = c.w<float>(OFF_TOPW);
  const int wm = c.wid >> 1, wn = c.wid & 1, fr = c.lane & 15, fq = c.lane >> 4, lane = c.lane;
  float* lg = reinterpret_cast<float*>(c.lds);
  for (int it = blockIdx.x; it < mrows / 256; it += gridDim.x) {
    f32x4 acc[4][4]; ZERO_ACC(acc);
    gemm_acc(acc, [&](int r) { return F + (size_t)(it * 256 + r) * 1024; },
             [&](int b) { const int wn_ = b >> 6, nn = (b >> 4) & 3, f_ = b & 15; return WR + (size_t)((nn >> 1) * 64 + wn_ * 32 + (nn & 1) * 16 + f_) * 1024; }, 1024, c.lds);
    { EPI_ROWS(0)
#pragma unroll
        for (int n = 0; n < 2; ++n) lg[row * 64 + wn * 32 + n * 16 + fr] = acc[m][n][j] + acc[m][n + 2][j];
      EPI_END }
    __syncthreads();
    const float bias = c.in(I_BR)[l * 64 + lane];
    for (int rr = 0; rr < 32; ++rr) {
      const int row = c.wid * 32 + rr; const int tok = it * 256 + row;
      const float score = sigmoidf_(lg[row * 64 + lane]); const float sel = score + bias;
      float m1 = sel;
      m1 = fmaxf(m1, __shfl_xor(m1, 1, 64)); m1 = fmaxf(m1, __shfl_xor(m1, 2, 64)); m1 = fmaxf(m1, __shfl_xor(m1, 4, 64));
      const unsigned long long bm = __ballot(sel == m1);
      const unsigned grp = (unsigned)((bm >> (lane & ~7)) & 0xffull);
      const int first = __ffs((int)grp) - 1;
      float s2 = ((lane & 7) == first) ? -3.0e38f : sel;
      s2 = fmaxf(s2, __shfl_xor(s2, 1, 64)); s2 = fmaxf(s2, __shfl_xor(s2, 2, 64)); s2 = fmaxf(s2, __shfl_xor(s2, 4, 64));
      const float gs = m1 + s2; const int g8 = lane >> 3;
      int cg = 0;
#pragma unroll
      for (int jg = 0; jg < 8; ++jg) { const float gj = __shfl(gs, jg * 8, 64); cg += (gj > gs || (gj == gs && jg < g8)) ? 1 : 0; }
      const bool allowed = cg < 4;
      const float sm = allowed ? sel : -3.0e38f;
      float* smb = reinterpret_cast<float*>(c.lds + 65536) + c.wid * 64;
      smb[lane] = sm;
      __builtin_amdgcn_wave_barrier(); asm volatile("s_waitcnt lgkmcnt(0)" ::: "memory");
      int rk = 0;
#pragma unroll 8
      for (int je = 0; je < 64; ++je) { const float sj = smb[je]; rk += (sj > sm || (sj == sm && je < lane)) ? 1 : 0; }
      __builtin_amdgcn_wave_barrier();
      const bool selected = allowed && rk < 8;
      const float wsum = wave_sum(selected ? score : 0.f);
      if (selected) {
        const int hh = tok >= halfrows ? 1 : 0;
        topw[(size_t)tok * 8 + rk] = score / wsum * 2.5f;
        const int pos = atomicAdd(&cnt[hh * 64 + lane], 1);
        list[((size_t)hh * 64 + lane) * 8704 + pos] = tok * 8 + rk;
      }
    }
    __syncthreads();
  }
}

__device__ __forceinline__ int moe_schedule(const Ctx& c, int l, int hh, int halfrows, int* pre  , int* cn  ) {
  const int* cnt = c.w<int>(OFF_CNT) + l * 128 + hh * 64;
  if (c.tid == 0) { int s = 0; for (int e = 0; e < 65; ++e) { int n = e < 64 ? cnt[e] : halfrows; cn[e] = n; pre[e] = s; s += (n + 255) >> 8; } pre[65] = s; }
  __syncthreads();
  return pre[65];
}
#define MOE_LDS_OFF 137216

__device__ __forceinline__ void step_moe_up(const Ctx& c, int l, int hh, int halfrows) {
  int* pre = reinterpret_cast<int*>(c.lds + MOE_LDS_OFF); int* cn = pre + 72;
  const int RT = moe_schedule(c, l, hh, halfrows, pre, cn);
  const u16* F = c.w<u16>(OFF_ACT); const int* list = c.w<int>(OFF_LIST) + (size_t)hh * 64 * 8704;
  u16* HD = c.w<u16>(OFF_BIG + BIG_HD); u16* HS = c.w<u16>(OFF_BIG + BIG_HS);
  const int wm = c.wid >> 1, wn = c.wid & 1, fr = c.lane & 15, fq = c.lane >> 4;
  const int tok0 = hh * halfrows;
  for (int it = blockIdx.x; it < RT * 4; it += gridDim.x) {
    const int rt = it >> 2, tn = it & 3;
    int e = 0; while (pre[e + 1] <= rt) ++e;
    const int rti = rt - pre[e], ne = cn[e];
    const int* le = list + (size_t)e * 8704;
    const u16* WGU = (const u16*)(c.p.ws + OFF_WE + (size_t)e * WE_ONE);
    f32x4 acc[4][4]; ZERO_ACC(acc);
    gemm_acc(acc, [&](int r) { int idx = rti * 256 + r; if (idx >= ne) idx = 0; const int tok = e < 64 ? (le[idx] >> 3) : tok0 + idx; return F + (size_t)tok * 1024; },
             [&](int b) { const int wn_ = b >> 6, nn = (b >> 4) & 3, f_ = b & 15; return WGU + (size_t)((nn >> 1) * 256 + tn * 64 + wn_ * 32 + (nn & 1) * 16 + f_) * 1024; }, 1024, c.lds);
    { EPI_ROWS(rti * 256)
        const int idx = row;
        if (idx < ne) {
          u16* dst = e < 64 ? HD + (size_t)(le[idx] - tok0 * 8) * 256 : HS + (size_t)idx * 256;
#pragma unroll
          for (int n = 0; n < 2; ++n) dst[tn * 64 + wn * 32 + n * 16 + fr] = f2bf(silu_(acc[m][n][j]) * acc[m][n + 2][j]);
        }
      EPI_END }
  }
}
__device__ __forceinline__ void step_moe_down(const Ctx& c, int l, int hh, int halfrows) {
  int* pre = reinterpret_cast<int*>(c.lds + MOE_LDS_OFF); int* cn = pre + 72;
  const int RT = moe_schedule(c, l, hh, halfrows, pre, cn);
  const int* list = c.w<int>(OFF_LIST) + (size_t)hh * 64 * 8704; const float* topw = c.w<float>(OFF_TOPW);
  const u16* HD = c.w<u16>(OFF_BIG + BIG_HD); const u16* HS = c.w<u16>(OFF_BIG + BIG_HS); u16* YR = c.w<u16>(OFF_BIG + BIG_YR); float* H = c.w<float>(OFF_H);
  const int wm = c.wid >> 1, wn = c.wid & 1, fr = c.lane & 15, fq = c.lane >> 4;
  const int tok0 = hh * halfrows;
  for (int it = blockIdx.x; it < RT * 8; it += gridDim.x) {
    const int rt = it >> 3, tn = it & 7;
    int e = 0; while (pre[e + 1] <= rt) ++e;
    const int rti = rt - pre[e], ne = cn[e];
    const int* le = list + (size_t)e * 8704;
    const u16* WD = (const u16*)(c.p.ws + OFF_WE + (size_t)e * WE_ONE + WE_GU);
    f32x4 acc[4][4]; ZERO_ACC(acc);
    gemm_acc(acc, [&](int r) { int idx = rti * 256 + r; if (idx >= ne) idx = 0; return e < 64 ? HD + (size_t)(le[idx] - tok0 * 8) * 256 : HS + (size_t)idx * 256; },
             [&](int b) { return WD + (size_t)(tn * 128 + b) * 256; }, 256, c.lds);
    { EPI_ROWS(rti * 256)
        const int idx = row;
        if (idx < ne) {
          if (e < 64) { const int ent = le[idx]; const float wv = topw[ent]; u16* dst = YR + (size_t)(ent - tok0 * 8) * 1024 + tn * 128 + wn * 64 + fr;
#pragma unroll
            for (int n = 0; n < 4; ++n) dst[n * 16] = f2bf(wv * acc[m][n][j]);
          } else { const int tok = tok0 + idx; float* dst = H + (size_t)tok * 1024 + tn * 128 + wn * 64 + fr; const float* g2 = c.mod(l, brow_of(tok), 5) + tn * 128 + wn * 64 + fr;
#pragma unroll
            for (int n = 0; n < 4; ++n) dst[n * 16] = ALPHA * dst[n * 16] + g2[n * 16] * acc[m][n][j];
          }
        }
      EPI_END }
  }
}
__device__ __forceinline__ void step_combine(const Ctx& c, int l, bool last, int hh, int halfrows) {
  float* H = c.w<float>(OFF_H); const u16* YR = c.w<u16>(OFF_BIG + BIG_YR); u16* U = c.w<u16>(OFF_ACT);
  const int tok0 = hh * halfrows;
  for (int it = blockIdx.x; it < halfrows / 8; it += gridDim.x) {
    const int tok = tok0 + it * 8 + c.wid; float v[16]; load_row(H + (size_t)tok * 1024, c.lane, v);
    float s[16];
#pragma unroll
    for (int i = 0; i < 16; ++i) s[i] = 0.f;
#pragma unroll
    for (int k = 0; k < 8; ++k) { const u16* yr = YR + ((size_t)(tok - tok0) * 8 + k) * 1024;
#pragma unroll
      for (int i = 0; i < 4; ++i) { uint2 t = *reinterpret_cast<const uint2*>(yr + (i * 64 + c.lane) * 4); s[i * 4] += bflo(t.x); s[i * 4 + 1] += bfhi(t.x); s[i * 4 + 2] += bflo(t.y); s[i * 4 + 3] += bfhi(t.y); } }
    const float* g2 = c.mod(l, brow_of(tok), 5);
#pragma unroll
    for (int i = 0; i < 4; ++i) { float4 g = *reinterpret_cast<const float4*>(g2 + (i * 64 + c.lane) * 4);
      v[i * 4] += g.x * s[i * 4]; v[i * 4 + 1] += g.y * s[i * 4 + 1]; v[i * 4 + 2] += g.z * s[i * 4 + 2]; v[i * 4 + 3] += g.w * s[i * 4 + 3]; }
    ln_affine(v, c.in(I_LN2G) + l * 1024, c.in(I_LN2B) + l * 1024, c.lane);
    if (last) { store_row(c.p.out + (size_t)tok * 1024, c.lane, v); }
    else { store_row(H + (size_t)tok * 1024, c.lane, v); const int br = brow_of(tok);
      ln_mod_store(v, c.mod(l + 1, br, 0), c.mod(l + 1, br, 1), U + (size_t)tok * 1024, c.lane); }
  }
}

#ifdef ONLY
__device__ __forceinline__ void run_step_only(const Ctx& c) {
  const int l_ = 0; const bool last_ = false;
  if (ONLY == 0) step_prep(c); if (ONLY == 1) step_ln_in(c); if (ONLY == 2) step_gemm_in(c, l_); if (ONLY == 3) step_mix_a(c, l_, last_); if (ONLY == 4) step_mix_b(c, l_, last_);
  if (ONLY == 5) step_merge(c, l_, last_); if (ONLY == 6) step_out(c, l_, last_); if (ONLY == 7) step_ln_mid(c, l_, MTOT); if (ONLY == 8) step_router(c, l_, MTOT, 8704);
  if (ONLY == 9) step_moe_up(c, l_, 0, 8704); if (ONLY == 10) step_moe_down(c, l_, 0, 8704); if (ONLY == 11) step_combine(c, l_, last_, 0, 8704);
}
#endif
#define N_STEPS 28
template <int L>
__device__ __forceinline__ void run_layer_step(const Ctx& c, int k) {
  constexpr bool last = (L == 1);
  constexpr int mrows = last ? TLAT : MTOT, halfrows = mrows / 2;
  switch (k) {
    case 0: step_gemm_in(c, L); break;
    case 1: step_mix_a(c, L, last); break;
    case 2: step_mix_b(c, L, last); break;
    case 3: step_merge(c, L, last); break;
    case 4: step_out(c, L, last); break;
    case 5: step_ln_mid(c, L, mrows); break;
    case 6: step_router(c, L, mrows, halfrows); break;
    case 7: step_moe_up(c, L, 0, halfrows); break;
    case 8: step_moe_down(c, L, 0, halfrows); break;
    case 9: step_combine(c, L, last, 0, halfrows); break;
    case 10: step_moe_up(c, L, 1, halfrows); break;
    case 11: step_moe_down(c, L, 1, halfrows); break;
    default: step_combine(c, L, last, 1, halfrows); break;
  }
}

#define LDS_BYTES 139264
__global__ void __launch_bounds__(NTHR, 2) fwd_kernel(Params p) {
  extern __shared__ __attribute__((aligned(16))) char lds[];
  Ctx c; c.p.ws = p.ws; c.p.out = p.out; c.lds = lds; c.tid = threadIdx.x; c.lane = threadIdx.x & 63; c.wid = __builtin_amdgcn_readfirstlane(threadIdx.x >> 6);
  if (threadIdx.x == 0) {
    const float** tab = reinterpret_cast<const float**>(lds + PTR_TAB_OFF);
#pragma unroll
    for (int i = 0; i < N_IN; ++i) tab[i] = p.in[i];
  }
  __syncthreads();
  const int lo = p.s_lo, hi = p.s_hi;
#define STEP(S, CALL) do { if (lo <= (S) && (S) < hi) { CALL; if ((S) + 1 < hi) cg::this_grid().sync(); } } while (0)
#ifdef ONLY
  run_step_only(c);
#else
  STEP(0, step_prep(c));
  STEP(1, step_ln_in(c));
#define LSTEP(L, K) STEP(2 + 13 * (L) + (K), run_layer_step<L>(c, K))
  LSTEP(0, 0); LSTEP(0, 1); LSTEP(0, 2); LSTEP(0, 3); LSTEP(0, 4); LSTEP(0, 5); LSTEP(0, 6); LSTEP(0, 7); LSTEP(0, 8); LSTEP(0, 9); LSTEP(0, 10); LSTEP(0, 11); LSTEP(0, 12);
  LSTEP(1, 0); LSTEP(1, 1); LSTEP(1, 2); LSTEP(1, 3); LSTEP(1, 4); LSTEP(1, 5); LSTEP(1, 6); LSTEP(1, 7); LSTEP(1, 8); LSTEP(1, 9); LSTEP(1, 10); LSTEP(1, 11); LSTEP(1, 12);
#endif
}

extern "C" void kernel_launch(void* const* d_in, const int* in_sizes, int n_in, void* d_out, int out_size, void* d_ws, size_t ws_size, hipStream_t stream) {
  static int grid = 0;
  if (grid == 0) {
    if (n_in != N_IN || ws_size < WS_TOTAL) { fprintf(stderr, "kernel_launch: bad shapes n_in %d ws %zu need %zu\n", n_in, ws_size, (size_t)WS_TOTAL); grid = -1; return; }
    hipFuncSetAttribute((const void*)fwd_kernel, hipFuncAttributeMaxDynamicSharedMemorySize, LDS_BYTES);
    int dev = 0, cus = 0, per_cu = 0; hipGetDevice(&dev); hipDeviceGetAttribute(&cus, hipDeviceAttributeMultiprocessorCount, dev);
    hipOccupancyMaxActiveBlocksPerMultiprocessor(&per_cu, (const void*)fwd_kernel, NTHR, LDS_BYTES);
    if (per_cu < 1) { fprintf(stderr, "kernel_launch: occupancy query says %d\n", per_cu); grid = -1; return; }
    grid = cus;
  }
  if (grid < 0) return;
  hipMemsetAsync(d_ws, 0, ZERO_BYTES, stream);
  Params p{};
  for (int i = 0; i < N_IN; ++i) p.in[i] = (const float*)d_in[i];
  p.out = (float*)d_out; p.ws = (char*)d_ws;
#if N_LAUNCH_MODE == 1
  p.s_lo = 0; p.s_hi = N_STEPS;
  void* args[] = {&p};
  hipError_t e = hipLaunchCooperativeKernel((const void*)fwd_kernel, dim3(grid), dim3(NTHR), args, LDS_BYTES, stream);
  if (e != hipSuccess) fprintf(stderr, "cooperative launch failed: %s (grid %d)\n", hipGetErrorString(e), grid);
#else
  for (int s = 0; s < N_STEPS; ++s) { p.s_lo = s; p.s_hi = s + 1; hipLaunchKernelGGL(fwd_kernel, dim3(grid), dim3(NTHR), LDS_BYTES, stream, p); }
#endif
}
```

```cpp
#include <hip/hip_runtime.h>
#include <hip/hip_cooperative_groups.h>
#include <stdint.h>
#include <cstdio>
namespace cg = cooperative_groups;

#ifndef N_LAUNCH_MODE
#define N_LAUNCH_MODE 1
#endif

typedef unsigned short u16;
typedef __attribute__((ext_vector_type(8))) short bf16x8;
typedef __attribute__((ext_vector_type(4))) float f32x4;
typedef __attribute__((ext_vector_type(4))) unsigned u32x4;
typedef __attribute__((ext_vector_type(4))) short s16x4;

#define DM     1024
#define NBATCH 4
#define SEQ    4096
#define CTXL   256
#define TLAT   16384
#define TCTX   1024
#define MTOT   17408
#define INW    5376
#define NTHR   512
#define ALPHA  1.41421356237309515f
#define LN_EPS 1e-5f
#define NCHK   68

enum { I_X = 0, I_C, I_CTX, I_CCTX, I_WMOD, I_BMOD, I_WIN, I_LRE, I_LIM, I_LSTEP, I_BRE, I_BIM, I_CRE, I_CIM, I_S5D,
       I_GMW, I_GMB, I_DALAM, I_SUBLN, I_GLUV, I_GLUG, I_PGM, I_PDA, I_WOUT, I_LN1G, I_LN1B, I_LN2G, I_LN2B,
       I_WR, I_BR, I_EG, I_EU, I_ED, I_SG, I_SU, I_SD, N_IN };

constexpr size_t al256(size_t x) { return (x + 255) / 256 * 256; }
constexpr size_t OFF_BAR   = 0;
constexpr size_t OFF_CNT   = 16384;
constexpr size_t ZERO_BYTES = 20480;
constexpr size_t OFF_MOD   = 32768;
constexpr size_t OFF_S5A   = OFF_MOD + al256(2 * 5 * 6144 * 4);
constexpr size_t OFF_S5A64 = OFF_S5A + 32768;
constexpr size_t OFF_S5BB  = OFF_S5A64 + 32768;
constexpr size_t OFF_S5BBH = OFF_S5BB + 524288;
constexpr size_t OFF_ROPE  = OFF_S5BBH + 262144;
constexpr size_t OFF_E     = OFF_ROPE + 8192;
constexpr size_t OFF_LIST  = OFF_E + al256((size_t)4 * 2 * NCHK * 16 * 64 * 2 * 4);
constexpr size_t OFF_TOPW  = OFF_LIST + al256((size_t)2 * 64 * 8704 * 4);
constexpr size_t OFF_SELE  = OFF_TOPW + al256((size_t)MTOT * 8 * 4);
constexpr size_t OFF_CNTB  = OFF_SELE + al256((size_t)MTOT * 8 * 4);
constexpr size_t OFF_LW    = OFF_CNTB + 256 * 128 * 4;
constexpr size_t OFF_WS    = OFF_LW + al256((size_t)2 * 64 * 8704 * 4);
constexpr size_t WS_WIN = 0, WS_GLU = WS_WIN + (size_t)INW * 1024 * 2, WS_GM = WS_GLU + 2048 * 256 * 2,
                 WS_DA = WS_GM + 1024 * 256 * 2, WS_OUT = WS_DA + 1024 * 512 * 2, WS_R = WS_OUT + 1024 * 1024 * 2,
                 WS_LAYER = WS_R + 128 * 1024 * 2;
constexpr size_t OFF_WE    = OFF_WS + 2 * WS_LAYER;
constexpr size_t WE_GU = (size_t)512 * 1024 * 2, WE_D = (size_t)1024 * 256 * 2, WE_ONE = WE_GU + WE_D;
constexpr size_t OFF_H     = OFF_WE + 65 * WE_ONE;
constexpr size_t OFF_ACT   = OFF_H + (size_t)MTOT * 1024 * 4;
constexpr size_t OFF_BIG   = OFF_ACT + (size_t)MTOT * 1024 * 2;
constexpr size_t BIG_P = 0, BIG_YA = BIG_P + (size_t)MTOT * INW * 2, BIG_YB = BIG_YA + (size_t)MTOT * 256 * 2,
                 BIG_YC = BIG_YB + (size_t)MTOT * 256 * 2, BIG_M = BIG_YC + (size_t)MTOT * 512 * 2,
                 BIG_END = BIG_M + (size_t)MTOT * 1024 * 2;
constexpr size_t BIG_YR = 0, BIG_HD = BIG_YR + (size_t)8704 * 8 * 1024 * 2, BIG_HS = BIG_HD + (size_t)(8704 * 8 + 256) * 256 * 2,
                 BIG_YS = BIG_HS + (size_t)8704 * 256 * 2, BIG_END2 = BIG_YS + (size_t)8704 * 1024 * 2;
static_assert(BIG_END2 <= BIG_END, "moe scratch must fit");
constexpr size_t WS_TOTAL = OFF_BIG + BIG_END;

struct Params { const float* in[N_IN]; float* out; char* ws; int s_lo, s_hi; };

__device__ __forceinline__ u16 f2bf(float f) { unsigned u = __float_as_uint(f); u += 0x7fffu + ((u >> 16) & 1u); return (u16)(u >> 16); }
__device__ __forceinline__ float bf2f(u16 h) { return __uint_as_float(((unsigned)h) << 16); }
__device__ __forceinline__ float bflo(unsigned w) { return __uint_as_float(w << 16); }
__device__ __forceinline__ float bfhi(unsigned w) { return __uint_as_float(w & 0xffff0000u); }
__device__ __forceinline__ unsigned cvtpk(float lo, float hi) { unsigned r; asm volatile("v_cvt_pk_bf16_f32 %0, %1, %2" : "=v"(r) : "v"(lo), "v"(hi)); return r; }
__device__ __forceinline__ unsigned pack2(float a, float b) { return cvtpk(a, b); }
__device__ __forceinline__ float wave_sum(float v) {
#pragma unroll
  for (int m = 32; m >= 1; m >>= 1) v += __shfl_xor(v, m, 64);
  return v;
}
__device__ __forceinline__ float sigmoidf_(float x) { return 1.f / (1.f + __expf(-x)); }
__device__ __forceinline__ float gelu_tanh(float x) {
  float t = 0.7978845608028654f * (x + 0.044715f * x * x * x);
  float e = __expf(2.f * t);
  float th = 1.f - 2.f / (e + 1.f);
  return 0.5f * x * (1.f + th);
}
__device__ __forceinline__ float silu_(float x) { return x / (1.f + __expf(-x)); }

#define GS_STAGES 3
#define GS_STAGE_BYTES 40960
#define GS_B_OFF 32768
#define CIMG_OFF (GS_STAGES * GS_STAGE_BYTES)
#define GEMM_LDS (CIMG_OFF + 128 * 272)

__device__ __forceinline__ void glds16(const void* g, void* l) {
  __builtin_amdgcn_global_load_lds((const __attribute__((address_space(1))) void*)g, (__attribute__((address_space(3))) void*)l, 16, 0, 0);
}
struct GPtr { const u16 *a[4], *b; };
template <class AF, class BF>
__device__ __forceinline__ GPtr gs_ptrs(AF arow, BF brow) {
  int tidz = threadIdx.x; asm volatile("" : "+v"(tidz));
  GPtr p;
#pragma unroll
  for (int i = 0; i < 4; ++i) { const int q = i * NTHR + tidz, row = q >> 3, c = (q & 7) ^ (row & 7); p.a[i] = arow(row) + c * 8; }
  { const int row = tidz >> 3, c = (tidz & 7) ^ (row & 7); p.b = brow(row) + c * 8; }
  return p;
}
struct GStream {
  GPtr cur, nxt; int nt, nnt;
  int ki;
  int sc;
};
__device__ __forceinline__ void gs_issue(GStream& g, char* lds, int si) {
  const int total = g.nt + g.nnt;
  const bool doi = g.ki < total, usen = doi && (g.ki >= g.nt);
  const int k0 = (doi ? (usen ? g.ki - g.nt : g.ki) : g.nt - 1) << 6;
  char* dst = lds + si * GS_STAGE_BYTES + threadIdx.x * 16;
  glds16((usen ? g.nxt.a[0] : g.cur.a[0]) + k0, dst); glds16((usen ? g.nxt.a[1] : g.cur.a[1]) + k0, dst + 8192);
  glds16((usen ? g.nxt.a[2] : g.cur.a[2]) + k0, dst + 16384); glds16((usen ? g.nxt.a[3] : g.cur.a[3]) + k0, dst + 24576);
  glds16((usen ? g.nxt.b : g.cur.b) + k0, dst + GS_B_OFF);
  ++g.ki;
}
__device__ __forceinline__ void gs_start(GStream& g, const GPtr& p, int nt, const GPtr& pn, int nnt, char* lds) {
  g.cur = p; g.nt = nt; g.nxt = pn; g.nnt = nnt; g.ki = 0; g.sc = 0;
  gs_issue(g, lds, 0); gs_issue(g, lds, 1);
}
__device__ __forceinline__ void gs_set_next(GStream& g, const GPtr& p, int nt) { g.nxt = p; g.nnt = nt; }
__device__ __forceinline__ void gs_advance(GStream& g) { g.cur = g.nxt; g.ki -= g.nt; g.nt = g.nnt; g.nnt = 0; }
template <int NF, int XV = 0>
__device__ __forceinline__ void gs_run(GStream& g, f32x4 (&acc)[4][NF], char* lds) {
  const int tid = threadIdx.x, lane = tid & 63, wid = tid >> 6, wm = wid >> 1, wn = wid & 1, fr = lane & 15, fq = lane >> 4;
  const int sw = fr & 7;
  const int aoff = (wm * 64 + fr) * 128, boff = GS_B_OFF + (wn * NF * 16 + fr) * 128;
#pragma unroll 1
  for (int t = 0; t < g.nt; ++t) {
    asm volatile("s_waitcnt vmcnt(5)" ::: "memory");
    __builtin_amdgcn_s_barrier();
    asm volatile("" ::: "memory");
    __builtin_amdgcn_sched_barrier(0);
    int sn = g.sc + 2; if (sn >= GS_STAGES) sn -= GS_STAGES;
    const char* st = lds + g.sc * GS_STAGE_BYTES;
    gs_issue(g, lds, sn);
    __builtin_amdgcn_sched_barrier(0);
#pragma unroll
    for (int ks = 0; ks < 2; ++ks) {
      bf16x8 At[4], Bt[NF];
      const int coff = (((ks * 4 + fq) ^ sw) << 4);
#pragma unroll
      for (int m = 0; m < 4; ++m) At[m] = *reinterpret_cast<const bf16x8*>(st + aoff + m * 2048 + coff);
#pragma unroll
      for (int n = 0; n < NF; ++n) Bt[n] = *reinterpret_cast<const bf16x8*>(st + boff + n * 2048 + coff);
#pragma unroll
      for (int m = 0; m < 4; ++m)
#pragma unroll
        for (int n = 0; n < NF; ++n) acc[m][n] = __builtin_amdgcn_mfma_f32_16x16x32_bf16(Bt[n], At[m], acc[m][n], 0, 0, 0);
    }
    ++g.sc; if (g.sc >= GS_STAGES) g.sc -= GS_STAGES;
  }
}
#define ZERO_ACC(a) do { _Pragma("unroll") for (int _m = 0; _m < 4; ++_m) _Pragma("unroll") for (int _n = 0; _n < 4; ++_n) a[_m][_n] = (f32x4){0.f, 0.f, 0.f, 0.f}; } while (0)
#define ZERO_ACC2(a) do { _Pragma("unroll") for (int _m = 0; _m < 4; ++_m) { a[_m][0] = (f32x4){0.f, 0.f, 0.f, 0.f}; a[_m][1] = (f32x4){0.f, 0.f, 0.f, 0.f}; } } while (0)


namespace g8 {
constexpr int BM = 256, BK = 64, HALF = 128, HTB = HALF * BK * 2;
__device__ __forceinline__ int lds_byte(int r, int c) { const int st = (r >> 4) * 2 + (c >> 5), rr = r & 15, cc = c & 31, ob = rr * 64 + cc * 2; return st * 1024 + (ob ^ (((ob >> 9) & 1) << 5)); }
__device__ __forceinline__ void stage_rc(int b, int& R, int& C) { const int st = b / 1024, sb = b % 1024, swz = sb ^ (((sb >> 9) & 1) << 5); R = (st >> 1) * 16 + swz / 64; C = (st & 1) * 32 + (swz % 64) / 2; }
__device__ __forceinline__ int perm32(int rho) { const int n = rho >> 4, i = rho & 15; return 8 * (i >> 2) + 4 * n + (i & 3); }
typedef f32x4 Acc[2][2][4][2];
template <class U, class Sched, class Epi>
__device__ __forceinline__ void phase(char* ldsg, const int K, const Sched& S, const Epi& E) {
  typedef __attribute__((address_space(3))) unsigned char* lptr;
  lptr lds = (lptr)ldsg;
  const int tid = threadIdx.x, wid = __builtin_amdgcn_readfirstlane(tid >> 6), lane = tid & 63, wr = wid >> 2, wc = wid & 3, fr = lane & 15, fq = lane >> 4;
  const int nt = K / BK;
  int R[2], C[2];
#pragma unroll
  for (int i = 0; i < 2; ++i) stage_rc(tid * 16 + i * 8192, R[i], C[i]);
  unsigned offB[2][2];
#pragma unroll
  for (int h = 0; h < 2; ++h)
#pragma unroll
    for (int i = 0; i < 2; ++i) offB[h][i] = S.boff(h * HALF + R[i], C[i]);
  const size_t kstep = (size_t)(BK * 2);
  const unsigned ldsw = (unsigned)wid * 1024u;
  const int aoff = lds_byte(wr * 64 + fr, fq * 8), boff = lds_byte(wc * 32 + fr, fq * 8);
#define G8_SA(b, h) (((b) * 2 + (h)) * HTB)
#define G8_SB(b, h) ((4 + (b) * 2 + (h)) * HTB)
#define G8_STAGE(bufoff, gbase, o0, o1) do { \
    __builtin_amdgcn_global_load_lds((const __attribute__((address_space(1))) void*)((gbase) + (o0)), (__attribute__((address_space(3))) void*)(lds + (bufoff) + ldsw), 16, 0, 0); \
    __builtin_amdgcn_global_load_lds((const __attribute__((address_space(1))) void*)((gbase) + (o1)), (__attribute__((address_space(3))) void*)(lds + (bufoff) + ldsw + 8192), 16, 0, 0); } while (0)
#define G8_LDA(dst, b, h) do { _Pragma("unroll") for (int m = 0; m < 4; ++m) _Pragma("unroll") for (int k = 0; k < 2; ++k) dst[m][k] = *(const __attribute__((address_space(3))) bf16x8*)(lds + G8_SA(b, h) + aoff + m * 2048 + k * 1024); } while (0)
#define G8_LDB(dst, b, h) do { _Pragma("unroll") for (int n = 0; n < 2; ++n) _Pragma("unroll") for (int k = 0; k < 2; ++k) dst[n][k] = *(const __attribute__((address_space(3))) bf16x8*)(lds + G8_SB(b, h) + boff + n * 2048 + k * 1024); } while (0)
#define G8_MMA(ai, bj, At, Bt) do { __builtin_amdgcn_s_setprio(1); _Pragma("unroll") for (int m = 0; m < 4; ++m) _Pragma("unroll") for (int n = 0; n < 2; ++n) _Pragma("unroll") for (int k = 0; k < 2; ++k) \
    acc[ai][bj][m][n] = __builtin_amdgcn_mfma_f32_16x16x32_bf16(Bt[n][k], At[m][k], acc[ai][bj][m][n], 0, 0, 0); __builtin_amdgcn_s_setprio(0); } while (0)
#define G8_WAIT_V(n) asm volatile("s_waitcnt vmcnt(" #n ")" ::: "memory")
#define G8_WAIT_L(n) asm volatile("s_waitcnt lgkmcnt(" #n ")" ::: "memory")
#define G8_BAR __builtin_amdgcn_s_barrier()
#define G8_SCHED __builtin_amdgcn_sched_barrier(0)
  U cur, nxt; int ui = 0;
  if (!S.next(0, cur)) return;
  Acc acc;
#define G8_ZERO() do { _Pragma("unroll") for (int a = 0; a < 2; ++a) _Pragma("unroll") for (int b = 0; b < 2; ++b) _Pragma("unroll") for (int m = 0; m < 4; ++m) _Pragma("unroll") for (int n = 0; n < 2; ++n) acc[a][b][m][n] = (f32x4){0.f, 0.f, 0.f, 0.f}; } while (0)
  G8_ZERO();
  bf16x8 At[4][2], B0[2][2], B1[2][2];
  unsigned oA[2][2], nA_[2][2];
  S.aoffs(cur, R[0], R[1], C[0], C[1], oA);
  const char* cA = S.abase(cur); const char* cB = S.bbase(cur);
  G8_STAGE(G8_SB(0, 0), cB, offB[0][0], offB[0][1]); G8_STAGE(G8_SA(0, 0), cA, oA[0][0], oA[0][1]); G8_STAGE(G8_SB(0, 1), cB, offB[1][0], offB[1][1]); G8_STAGE(G8_SA(0, 1), cA, oA[1][0], oA[1][1]);
  if (wr == 1) G8_BAR;
  G8_WAIT_V(4); G8_BAR;
  G8_STAGE(G8_SB(1, 0), cB + kstep, offB[0][0], offB[0][1]); G8_STAGE(G8_SA(1, 0), cA + kstep, oA[0][0], oA[0][1]); G8_STAGE(G8_SB(1, 1), cB + kstep, offB[1][0], offB[1][1]);
  G8_WAIT_V(6); G8_BAR;
  for (;;) {
    const bool has_next = S.next(ui + 1, nxt);
    const char* nA = cA; const char* nB = cB;
#pragma unroll
    for (int h = 0; h < 2; ++h) { nA_[h][0] = oA[h][0]; nA_[h][1] = oA[h][1]; }
    if (has_next) { nA = S.abase(nxt); nB = S.bbase(nxt); S.aoffs(nxt, R[0], R[1], C[0], C[1], nA_); }
#pragma unroll 1
    for (int t = 0; t < nt; t += 2) {
      const bool last = (t == nt - 2);
      const char* a1 = cA + (size_t)(t + 1) * kstep;
      const char* a2 = last ? nA : cA + (size_t)(t + 2) * kstep; const char* b2 = last ? nB : cB + (size_t)(t + 2) * kstep;
      const char* a3 = a2 + kstep; const char* b3 = b2 + kstep;
      const unsigned x00 = last ? nA_[0][0] : oA[0][0], x01 = last ? nA_[0][1] : oA[0][1], x10 = last ? nA_[1][0] : oA[1][0], x11 = last ? nA_[1][1] : oA[1][1];
      G8_LDB(B0, 0, 0); G8_SCHED; G8_LDA(At, 0, 0); G8_STAGE(G8_SA(1, 1), a1, oA[1][0], oA[1][1]);
      G8_WAIT_L(8); G8_BAR; G8_WAIT_L(0); G8_MMA(0, 0, At, B0); G8_BAR; G8_SCHED;
      G8_LDB(B1, 0, 1); G8_STAGE(G8_SB(0, 0), b2, offB[0][0], offB[0][1]);
      G8_BAR; G8_WAIT_L(0); G8_MMA(0, 1, At, B1); G8_BAR;
      G8_LDA(At, 0, 1); G8_STAGE(G8_SA(0, 0), a2, x00, x01);
      G8_BAR; G8_WAIT_L(0); G8_MMA(1, 0, At, B0); G8_BAR; G8_SCHED;
      G8_STAGE(G8_SB(0, 1), b2, offB[1][0], offB[1][1]);
      G8_WAIT_V(6); G8_BAR; G8_MMA(1, 1, At, B1); G8_BAR;
      G8_LDB(B0, 1, 0); G8_SCHED; G8_LDA(At, 1, 0); G8_STAGE(G8_SA(0, 1), a2, x10, x11);
      G8_WAIT_L(8); G8_BAR; G8_WAIT_L(0); G8_MMA(0, 0, At, B0); G8_BAR; G8_SCHED;
      G8_LDB(B1, 1, 1); G8_STAGE(G8_SB(1, 0), b3, offB[0][0], offB[0][1]);
      G8_BAR; G8_WAIT_L(0); G8_MMA(0, 1, At, B1); G8_BAR;
      G8_LDA(At, 1, 1); G8_STAGE(G8_SA(1, 0), a3, x00, x01);
      G8_BAR; G8_WAIT_L(0); G8_MMA(1, 0, At, B0); G8_BAR; G8_SCHED;
      G8_STAGE(G8_SB(1, 1), b3, offB[1][0], offB[1][1]);
      G8_WAIT_V(6); G8_BAR; G8_MMA(1, 1, At, B1); G8_BAR;
    }
    E(acc, cur, wr, wc, fr, fq);
    if (!has_next) break;
    G8_ZERO();
    cur = nxt; cA = nA; cB = nB; ++ui;
#pragma unroll
    for (int h = 0; h < 2; ++h) { oA[h][0] = nA_[h][0]; oA[h][1] = nA_[h][1]; }
  }
  G8_WAIT_V(0);
  if (wr == 0) G8_BAR;
  G8_BAR;
#undef G8_SA
#undef G8_SB
#undef G8_STAGE
#undef G8_LDA
#undef G8_LDB
#undef G8_MMA
#undef G8_WAIT_V
#undef G8_WAIT_L
#undef G8_BAR
#undef G8_SCHED
#undef G8_ZERO
}
}

#define EPI_RS 272
#define EPI_M(ROW0) int _rb = (ROW0) + wm * 64 + fr; asm volatile("" : "+v"(_rb)); _Pragma("unroll") for (int m = 0; m < 4; ++m) { const int row = _rb + m * 16;
#define EPI_M_END }
template <int NF, int CPR, class SF, class RF>
__device__ __forceinline__ void epi_tile(char* lds, SF sf, RF rf) {
  int tid = threadIdx.x; asm volatile("" : "+v"(tid));
  const int lane = tid & 63, wid = __builtin_amdgcn_readfirstlane(tid >> 6), wm = wid >> 1, wn = wid & 1, fr = lane & 15, fq = lane >> 4;
  char* img = lds + CIMG_OFF;
#pragma unroll
  for (int h = 0; h < 2; ++h) {
    if ((wm >> 1) == h) {
#pragma unroll
      for (int m = 0; m < 4; ++m)
#pragma unroll
        for (int n = 0; n < NF; ++n) { const f32x4 v = sf(m, n);
          *reinterpret_cast<uint2*>(img + ((wm & 1) * 64 + m * 16 + fr) * EPI_RS + (wn * NF * 16 + n * 16 + fq * 4) * 2) = make_uint2(pack2(v[0], v[1]), pack2(v[2], v[3])); }
    }
    asm volatile("s_waitcnt lgkmcnt(0)" ::: "memory"); __builtin_amdgcn_s_barrier(); asm volatile("" ::: "memory");
#pragma unroll
    for (int i = 0; i < CPR / 4; ++i) { const int idx = i * NTHR + tid, row = idx / CPR, c8 = idx % CPR;
      const u32x4 v = *reinterpret_cast<const u32x4*>(img + row * EPI_RS + c8 * 16); rf(h * 128 + row, c8 * 8, v); }
    asm volatile("s_waitcnt lgkmcnt(0)" ::: "memory"); __builtin_amdgcn_s_barrier(); asm volatile("" ::: "memory");
  }
}
struct XSched { int pos, end, step; };
__device__ __forceinline__ XSched xsched(int total) {
  XSched s;
  if ((gridDim.x & 7) == 0) { const int g = blockIdx.x & 7, per = gridDim.x >> 3; s.pos = (int)((long)total * g / 8) + (blockIdx.x >> 3); s.end = (int)((long)total * (g + 1) / 8); s.step = per; }
  else { s.pos = blockIdx.x; s.end = total; s.step = gridDim.x; }
  return s;
}
#define PTR_TAB_OFF 157696
struct CtxP { char* ws; float* out; };
struct Ctx {
  CtxP p; char* lds;
  __device__ __forceinline__ const float* in(int i) const { return reinterpret_cast<const float* const*>(lds + PTR_TAB_OFF)[i]; }
  template <typename T> __device__ __forceinline__ T* w(size_t off) const { return reinterpret_cast<T*>(p.ws + off); }
  __device__ __forceinline__ const float* mod(int l, int brow, int chunk) const { return w<float>(OFF_MOD) + ((size_t)(l * 5 + brow) * 6144 + chunk * 1024); }
};
__device__ __forceinline__ int brow_of(int row) { return row < TLAT ? (row >> 12) : 4; }

__device__ __forceinline__ void cvt_tile(const float* __restrict__ src, int N, u16* __restrict__ dst, int dld, int k0, int n0, int roff, float* t) {
  const int tid = threadIdx.x;
  { const int n4 = (tid & 15) * 4, kb = tid >> 4;
#pragma unroll
    for (int i = 0; i < 2; ++i) { const int k = kb + 32 * i; const float4 v = *reinterpret_cast<const float4*>(src + (size_t)(k0 + k) * N + n0 + n4);
      t[k * 65 + n4] = v.x; t[k * 65 + n4 + 1] = v.y; t[k * 65 + n4 + 2] = v.z; t[k * 65 + n4 + 3] = v.w; } }
  __syncthreads();
  { const int n = tid >> 3, k8 = (tid & 7) * 8; u32x4 o;
#pragma unroll
    for (int e = 0; e < 4; ++e) o[e] = pack2(t[(k8 + 2 * e) * 65 + n], t[(k8 + 2 * e + 1) * 65 + n]);
    *reinterpret_cast<u32x4*>(dst + (size_t)(roff + n0 + n) * dld + k0 + k8) = o; }
  __syncthreads();
}
__device__ __forceinline__ void cvt_tile4(const float* __restrict__ src, int N, u16* __restrict__ dst, int dld, int k0, int n0, int roff, float* t) {
  const int tid = threadIdx.x;
  { const int n4 = (tid & 63) * 4, kb = tid >> 6;
    float4 v[8];
#pragma unroll
    for (int i = 0; i < 8; ++i) v[i] = *reinterpret_cast<const float4*>(src + (size_t)(k0 + kb + 8 * i) * N + n0 + n4);
#pragma unroll
    for (int i = 0; i < 8; ++i) { float* tr = t + (kb + 8 * i) * 257 + n4; tr[0] = v[i].x; tr[1] = v[i].y; tr[2] = v[i].z; tr[3] = v[i].w; } }
  __syncthreads();
#pragma unroll
  for (int i = 0; i < 4; ++i) { const int q = i * NTHR + tid, n = q >> 3, k8 = (q & 7) * 8; u32x4 o;
#pragma unroll
    for (int e = 0; e < 4; ++e) o[e] = pack2(t[(k8 + 2 * e) * 257 + n], t[(k8 + 2 * e + 1) * 257 + n]);
    *reinterpret_cast<u32x4*>(dst + (size_t)(roff + n0 + n) * dld + k0 + k8) = o; }
  __syncthreads();
}
__device__ __forceinline__ void cvt_router_tile(const float* __restrict__ src, u16* __restrict__ dst, int k0, float* t) {
  const int tid = threadIdx.x;
  { const int n = tid & 63, kb = tid >> 6;
#pragma unroll
    for (int i = 0; i < 8; ++i) { int k = kb + 8 * i; t[k * 65 + n] = src[(size_t)(k0 + k) * 64 + n]; } }
  __syncthreads();
  { const int k = tid & 63, nb = tid >> 6;
#pragma unroll
    for (int i = 0; i < 8; ++i) { int nn = nb + 8 * i; float v = t[k * 65 + nn]; u16 hi = f2bf(v); u16 lo = f2bf(v - bf2f(hi));
      dst[(size_t)nn * 1024 + k0 + k] = hi; dst[(size_t)(64 + nn) * 1024 + k0 + k] = lo; } }
  __syncthreads();
}
#define NCVT_SMALL 1936
__device__ __forceinline__ void cvt_small(const Ctx& c, int l, int t) {
  float* tb = reinterpret_cast<float*>(c.lds);
  char* wl = c.p.ws + OFF_WS + (size_t)l * WS_LAYER;
  if (t < 1344) { cvt_tile(c.in(I_WIN) + (size_t)l * 1024 * INW, INW, (u16*)(wl + WS_WIN), 1024, (t / 84) * 64, (t % 84) * 64, 0, tb); return; }
  t -= 1344;
  if (t < 64) { cvt_tile(c.in(I_GLUV) + (size_t)l * 256 * 1024, 1024, (u16*)(wl + WS_GLU), 256, (t / 16) * 64, (t % 16) * 64, 0, tb); return; }
  t -= 64;
  if (t < 64) { cvt_tile(c.in(I_GLUG) + (size_t)l * 256 * 1024, 1024, (u16*)(wl + WS_GLU), 256, (t / 16) * 64, (t % 16) * 64, 1024, tb); return; }
  t -= 64;
  if (t < 64) { cvt_tile(c.in(I_PGM) + (size_t)l * 256 * 1024, 1024, (u16*)(wl + WS_GM), 256, (t / 16) * 64, (t % 16) * 64, 0, tb); return; }
  t -= 64;
  if (t < 128) { cvt_tile(c.in(I_PDA) + (size_t)l * 512 * 1024, 1024, (u16*)(wl + WS_DA), 512, (t / 16) * 64, (t % 16) * 64, 0, tb); return; }
  t -= 128;
  if (t < 256) { cvt_tile(c.in(I_WOUT) + (size_t)l * 1024 * 1024, 1024, (u16*)(wl + WS_OUT), 1024, (t / 16) * 64, (t % 16) * 64, 0, tb); return; }
  t -= 256;
  cvt_router_tile(c.in(I_WR) + (size_t)l * 1024 * 64, (u16*)(wl + WS_R), t * 64, tb);
}
#define NCVT_EXP (65 * 48)
#define CV_GIN(l) ((l) == 0 ? 480 : 1296)
#define CV_OUT(l) ((l) == 0 ? 2640 : 0)
__device__ __forceinline__ void cvt_expert(const Ctx& c, int l, int t) {
  float* tb = reinterpret_cast<float*>(c.lds);
  const int e = t / 48; int r = t % 48;
  char* we = c.p.ws + OFF_WE + (size_t)e * WE_ONE;
  const float* sg = e < 64 ? c.in(I_EG) + (size_t)(l * 64 + e) * 1024 * 256 : c.in(I_SG) + (size_t)l * 1024 * 256;
  const float* su = e < 64 ? c.in(I_EU) + (size_t)(l * 64 + e) * 1024 * 256 : c.in(I_SU) + (size_t)l * 1024 * 256;
  const float* sd = e < 64 ? c.in(I_ED) + (size_t)(l * 64 + e) * 256 * 1024 : c.in(I_SD) + (size_t)l * 256 * 1024;
  if (r < 16) { cvt_tile4(sg, 256, (u16*)we, 1024, r * 64, 0, 0, tb); return; }
  r -= 16;
  if (r < 16) { cvt_tile4(su, 256, (u16*)we, 1024, r * 64, 0, 256, tb); return; }
  r -= 16;
  cvt_tile4(sd, 1024, (u16*)(we + WE_GU), 256, (r >> 2) * 64, (r & 3) * 256, 0, tb);
}

__device__ __forceinline__ void step_prep(const Ctx& c) {
  const int G = gridDim.x;
  const int n_cvt = NCVT_SMALL, n_mod = 192, n_s5 = 8, n_misc = 1;
  const int total = n_cvt + n_mod + n_s5 + n_misc;
  for (int it = blockIdx.x; it < total; it += G) {
    if (it < n_cvt) { cvt_small(c, 0, it); continue; }
    int i = it - n_cvt;
    if (i < n_mod) {
      const int l = i / 96, cb = i % 96;
      float* sil = reinterpret_cast<float*>(c.lds);
      float* red = sil + 5 * 1024;
      for (int q = ((int)threadIdx.x); q < 5 * 1024; q += NTHR) { int r = q >> 10, k = q & 1023; float v = r < 4 ? c.in(I_C)[r * 1024 + k] : c.in(I_CCTX)[k]; sil[q] = silu_(v); }
      __syncthreads();
      const int col = ((int)threadIdx.x) & 63, kp = ((int)threadIdx.x) >> 6;
      float a0 = 0, a1 = 0, a2 = 0, a3 = 0, a4 = 0;
      const float* wm_ = c.in(I_WMOD) + (size_t)l * 1024 * 6144 + cb * 64 + col;
#pragma unroll 1
      for (int k0 = kp * 128; k0 < kp * 128 + 128; k0 += 16) {
        float wv[16];
#pragma unroll
        for (int j = 0; j < 16; ++j) wv[j] = wm_[(size_t)(k0 + j) * 6144];
#pragma unroll
        for (int j = 0; j < 16; ++j) { const int k = k0 + j;
          a0 += sil[k] * wv[j]; a1 += sil[1024 + k] * wv[j]; a2 += sil[2048 + k] * wv[j]; a3 += sil[3072 + k] * wv[j]; a4 += sil[4096 + k] * wv[j]; } }
      red[(kp * 5 + 0) * 64 + col] = a0; red[(kp * 5 + 1) * 64 + col] = a1; red[(kp * 5 + 2) * 64 + col] = a2;
      red[(kp * 5 + 3) * 64 + col] = a3; red[(kp * 5 + 4) * 64 + col] = a4;
      __syncthreads();
      if (((int)threadIdx.x) < 320) { int r = ((int)threadIdx.x) >> 6, cc = ((int)threadIdx.x) & 63; float s = 0;
#pragma unroll
        for (int q = 0; q < 8; ++q) s += red[(q * 5 + r) * 64 + cc];
        s += c.in(I_BMOD)[l * 6144 + cb * 64 + cc];
        c.w<float>(OFF_MOD)[(size_t)(l * 5 + r) * 6144 + cb * 64 + cc] = s; }
      __syncthreads();
      continue;
    }
    i -= n_mod;
    if (i < n_s5) {
      const int q = i * NTHR + ((int)threadIdx.x);
      const int ldg = q >> 6;
      const float dt = expf(c.in(I_LSTEP)[ldg]);
      const float lr = c.in(I_LRE)[q], li = c.in(I_LIM)[q];
      const float mag = expf(lr * dt);
      float sn, cs; sincosf(li * dt, &sn, &cs);
      const float are = mag * cs, aim = mag * sn;
      const float den = lr * lr + li * li, nre = are - 1.f;
      const float zre = (nre * lr + aim * li) / den, zim = (aim * lr - nre * li) / den;
      float* A = c.w<float>(OFF_S5A); float* A64 = c.w<float>(OFF_S5A64); float* BB = c.w<float>(OFF_S5BB);
      A[q * 2] = are; A[q * 2 + 1] = aim;
      float pr = are, pi = aim;
#pragma unroll
      for (int s = 0; s < 6; ++s) { float nr = pr * pr - pi * pi, ni = 2.f * pr * pi; pr = nr; pi = ni; }
      A64[q * 2] = pr; A64[q * 2 + 1] = pi;
      const float* bre = c.in(I_BRE) + (size_t)q * 16; const float* bim = c.in(I_BIM) + (size_t)q * 16;
#pragma unroll
      for (int cc = 0; cc < 16; ++cc) { float br = bre[cc], bi = bim[cc];
        const float vr = zre * br - zim * bi, vi = zre * bi + zim * br;
        BB[((size_t)q * 16 + cc) * 2] = vr; BB[((size_t)q * 16 + cc) * 2 + 1] = vi;
        u16* bbh = c.w<u16>(OFF_S5BBH) + (size_t)(q >> 6) * 128 * 16;
        bbh[(q & 63) * 16 + cc] = f2bf(vr); bbh[(64 + (q & 63)) * 16 + cc] = f2bf(vi); }
      continue;
    }
    for (int q = ((int)threadIdx.x); q < 64 * 16; q += NTHR) { int pos = q >> 4, f = q & 15;
      float inv = powf(10000.f, -(float)f / 16.f); float ang = (float)pos * inv; float sn, cs; sincosf(ang, &sn, &cs);
      c.w<float>(OFF_ROPE)[q * 2] = cs; c.w<float>(OFF_ROPE)[q * 2 + 1] = sn; }
  }
}

__device__ __forceinline__ void ln_stats(const float (&v)[16], float& mean, float& rstd) {
  float s = 0;
#pragma unroll
  for (int i = 0; i < 16; ++i) s += v[i];
  mean = wave_sum(s) * (1.f / 1024.f);
  float q = 0;
#pragma unroll
  for (int i = 0; i < 16; ++i) { float d = v[i] - mean; q += d * d; }
  rstd = rsqrtf(wave_sum(q) * (1.f / 1024.f) + LN_EPS);
}
__device__ __forceinline__ void load_row(const float* src, int lane, float (&v)[16]) {
#pragma unroll
  for (int i = 0; i < 4; ++i) { float4 t = *reinterpret_cast<const float4*>(src + (i * 64 + lane) * 4); v[i * 4] = t.x; v[i * 4 + 1] = t.y; v[i * 4 + 2] = t.z; v[i * 4 + 3] = t.w; }
}
__device__ __forceinline__ void load_row_bf(const u16* src, int lane, float (&v)[16]) {
#pragma unroll
  for (int i = 0; i < 4; ++i) { const uint2 t = *reinterpret_cast<const uint2*>(src + (i * 64 + lane) * 4); v[i * 4] = bflo(t.x); v[i * 4 + 1] = bfhi(t.x); v[i * 4 + 2] = bflo(t.y); v[i * 4 + 3] = bfhi(t.y); }
}
__device__ __forceinline__ void store_row(float* dst, int lane, const float (&v)[16]) {
#pragma unroll
  for (int i = 0; i < 4; ++i) *reinterpret_cast<float4*>(dst + (i * 64 + lane) * 4) = make_float4(v[i * 4], v[i * 4 + 1], v[i * 4 + 2], v[i * 4 + 3]);
}
__device__ __forceinline__ void store_row_bf(u16* dst, int lane, const float (&v)[16]) {
#pragma unroll
  for (int i = 0; i < 4; ++i) *reinterpret_cast<uint2*>(dst + (i * 64 + lane) * 4) = make_uint2(pack2(v[i * 4], v[i * 4 + 1]), pack2(v[i * 4 + 2], v[i * 4 + 3]));
}
__device__ __forceinline__ void ln_mod_store(const float (&v)[16], const float* sh, const float* sc, u16* dst, int lane) {
  float mean, rstd; ln_stats(v, mean, rstd);
  float o[16];
#pragma unroll
  for (int i = 0; i < 4; ++i) { float4 a = *reinterpret_cast<const float4*>(sh + (i * 64 + lane) * 4), b = *reinterpret_cast<const float4*>(sc + (i * 64 + lane) * 4);
    o[i * 4] = (v[i * 4] - mean) * rstd * (1.f + b.x) + a.x; o[i * 4 + 1] = (v[i * 4 + 1] - mean) * rstd * (1.f + b.y) + a.y;
    o[i * 4 + 2] = (v[i * 4 + 2] - mean) * rstd * (1.f + b.z) + a.z; o[i * 4 + 3] = (v[i * 4 + 3] - mean) * rstd * (1.f + b.w) + a.w; }
  store_row_bf(dst, lane, o);
}
__device__ __forceinline__ void ln_affine(float (&v)[16], const float* g, const float* b, int lane) {
  float mean, rstd; ln_stats(v, mean, rstd);
#pragma unroll
  for (int i = 0; i < 4; ++i) { float4 a = *reinterpret_cast<const float4*>(g + (i * 64 + lane) * 4), bb = *reinterpret_cast<const float4*>(b + (i * 64 + lane) * 4);
    v[i * 4] = (v[i * 4] - mean) * rstd * a.x + bb.x; v[i * 4 + 1] = (v[i * 4 + 1] - mean) * rstd * a.y + bb.y;
    v[i * 4 + 2] = (v[i * 4 + 2] - mean) * rstd * a.z + bb.z; v[i * 4 + 3] = (v[i * 4 + 3] - mean) * rstd * a.w + bb.w; }
}

__device__ __forceinline__ void step_ln_in(const Ctx& c) {
  u16* U = c.w<u16>(OFF_ACT);
  for (int it = blockIdx.x; it < MTOT / 8; it += gridDim.x) {
    const int row = it * 8 + ((int)__builtin_amdgcn_readfirstlane(threadIdx.x >> 6));
    const float* src = row < TLAT ? c.in(I_X) + (size_t)row * 1024 : c.in(I_CTX) + (size_t)(row - TLAT) * 1024;
    float v[16]; load_row(src, ((int)threadIdx.x & 63), v);
    const int br = brow_of(row);
    ln_mod_store(v, c.mod(0, br, 0), c.mod(0, br, 1), U + (size_t)row * 1024, ((int)threadIdx.x & 63));
  }
}

__device__ __forceinline__ int xcd_remap(int L, int nwg) { const int q = nwg >> 3, r = nwg & 7, xcd = L & 7, off = L >> 3; return (xcd < r ? xcd * (q + 1) : r * (q + 1) + (xcd - r) * q) + off; }
struct DUnit { int pm, pn; };
template <bool PERM>
struct DenseSched {
  const char* A; const char* B; int K, nN, total;
  __device__ __forceinline__ bool next(int i, DUnit& u) const { const int L = i * (int)gridDim.x + (int)blockIdx.x; if (L >= total) return false;
    if ((gridDim.x & 7) != 0) { u.pm = L / nN; u.pn = L - u.pm * nN; return true; }
    const int w = xcd_remap(L, total), nM = total / nN, nig = 8 * nN, gid = w / nig, fm = gid * 8, gsz = (nM - fm) < 8 ? (nM - fm) : 8, wi = w - gid * nig;
    u.pn = wi / gsz; u.pm = fm + (wi - u.pn * gsz); return true; }
  __device__ __forceinline__ const char* abase(const DUnit& u) const { return A + (size_t)u.pm * 256 * K * 2; }
  __device__ __forceinline__ const char* bbase(const DUnit& u) const { return B + (size_t)u.pn * 256 * K * 2; }
  __device__ __forceinline__ void aoffs(const DUnit&, int R0, int R1, int C0, int C1, unsigned (&o)[2][2]) const {
#pragma unroll
    for (int h = 0; h < 2; ++h) { o[h][0] = (unsigned)((h * 128 + R0) * K + C0) * 2u; o[h][1] = (unsigned)((h * 128 + R1) * K + C1) * 2u; } }
  __device__ __forceinline__ unsigned boff(int row, int C) const { const int rb = PERM ? ((row & ~31) + g8::perm32(row & 31)) : row; return (unsigned)(rb * K + C) * 2u; }
};

__device__ __forceinline__ void step_gemm_in(const Ctx& c, int l) {
  const u16* U = c.w<u16>(OFF_ACT);
  const u16* W = reinterpret_cast<const u16*>(c.p.ws + OFF_WS + (size_t)l * WS_LAYER + WS_WIN);
  u16* P = c.w<u16>(OFF_BIG + BIG_P);
  const float* ropetab = c.w<float>(OFF_ROPE);
  DenseSched<true> S{(const char*)U, (const char*)W, 1024, 21, 68 * 21};
  const int lane = ((int)threadIdx.x & 63);
  g8::phase<DUnit>(c.lds, 1024, S, [&](const g8::Acc& acc, const DUnit& u, int wr, int wc, int fr, int fq) {
    const int cls = u.pn < 1 ? 0 : (u.pn < 3 ? 1 : (u.pn < 9 ? 0 : 2));
    const bool rope = (u.pn >= 3 && u.pn < 7) && (u.pm < 64);
#pragma unroll
    for (int ai = 0; ai < 2; ++ai)
#pragma unroll
      for (int m = 0; m < 4; ++m) {
        const int row = u.pm * 256 + ai * 128 + wr * 64 + m * 16 + fr;
        u16* rowp = P + (size_t)row * INW + u.pn * 256 + wc * 32 + 8 * fq;
        const int t = row & 4095; const int pos = (wc & 1) ? (t & 63) : (t >> 6);
        const float* tab = ropetab + pos * 32 + (fq & 1) * 16;
#pragma unroll
        for (int bj = 0; bj < 2; ++bj) {
          f32x4 v0 = acc[ai][bj][m][0], v1 = acc[ai][bj][m][1];
          if (cls == 1) {
#pragma unroll
            for (int j = 0; j < 4; ++j) { v0[j] = gelu_tanh(v0[j]); v1[j] = gelu_tanh(v1[j]); } }
          else if (cls == 2) {
#pragma unroll
            for (int j = 0; j < 4; ++j) { v0[j] = sigmoidf_(v0[j]); v1[j] = sigmoidf_(v1[j]); } }
          if (rope) {
            float x[8] = {v0[0], v0[1], v0[2], v0[3], v1[0], v1[1], v1[2], v1[3]};
#pragma unroll
            for (int e = 0; e < 8; ++e) {
              auto rr = __builtin_amdgcn_permlane32_swap(__float_as_uint(x[e]), __float_as_uint(x[e]), false, false);
              const float o = __uint_as_float(lane < 32 ? rr[1] : rr[0]);
              const float2 cs = *reinterpret_cast<const float2*>(tab + e * 2);
              x[e] = lane < 32 ? x[e] * cs.x - o * cs.y : x[e] * cs.x + o * cs.y; }
            v0 = (f32x4){x[0], x[1], x[2], x[3]}; v1 = (f32x4){x[4], x[5], x[6], x[7]};
          }
          u32x4 w; w.x = pack2(v0[0], v0[1]); w.y = pack2(v0[2], v0[3]); w.z = pack2(v1[0], v1[1]); w.w = pack2(v1[2], v1[3]);
          *reinterpret_cast<u32x4*>(rowp + bj * 128) = w;
        }
      }
  });
  {
    const int G = (int)gridDim.x, extra = (68 * 21) % G;
    const int j = extra > 0 ? (int)blockIdx.x - extra : (int)blockIdx.x, nidle = extra > 0 ? G - extra : G;
    if (j >= 0) for (int it = j; it < CV_GIN(l); it += nidle) cvt_expert(c, l, it);
  }
}

#define BUB_LD 132
#define BT_LD 20
#define GM_LD 136
__device__ __forceinline__ void step_mix_a(const Ctx& c, int l, bool last) {
  u16* P = c.w<u16>(OFF_BIG + BIG_P);
  const int n_rope = 0, n_s5 = 4 * 2 * NCHK, n_gm = (last ? 128 : 136) * 4, n_cv = NCVT_EXP - CV_OUT(l) - CV_GIN(l);
  const int total = n_rope + n_s5 + n_gm + n_cv;
  for (int it = blockIdx.x; it < total; it += gridDim.x) {
    int i = it;
    i -= n_rope;
    if (i < n_s5) {
      const int b = i / (2 * NCHK), rem = i % (2 * NCHK), dir = rem / NCHK, ck = rem % NCHK;
      const float* A = c.w<float>(OFF_S5A); float* E = c.w<float>(OFF_E); const u16* BBH = c.w<u16>(OFF_S5BBH);
      const int lane = (int)threadIdx.x & 63, fr = lane & 15, fq = lane >> 4, wid_ = (int)__builtin_amdgcn_readfirstlane(threadIdx.x >> 6);
      float* bub = reinterpret_cast<float*>(c.lds + wid_ * 10240);
      int rows[4];
#pragma unroll
      for (int sub = 0; sub < 4; ++sub) { const int tau = ck * 64 + sub * 16 + fr;
        if (tau < 256) rows[sub] = TLAT + b * 256 + (dir ? 255 - tau : tau); else { const int tt = tau - 256; rows[sub] = b * 4096 + (dir ? 4095 - tt : tt); } }
      float are_[2], aim_[2]; s16x4 bfr_[2][8], afr_[2][4];
#pragma unroll
      for (int gi = 0; gi < 2; ++gi) {
        const int g = wid_ * 2 + gi; const int q = ((l * 2 + dir) * 16 + g) * 64 + lane;
        are_[gi] = A[q * 2]; aim_[gi] = A[q * 2 + 1];
        const u16* bp = BBH + ((size_t)((l * 2 + dir) * 16 + g) * 128 + fr) * 16 + fq * 4;
#pragma unroll
        for (int cb = 0; cb < 8; ++cb) bfr_[gi][cb] = *reinterpret_cast<const s16x4*>(bp + cb * 256);
#pragma unroll
        for (int sub = 0; sub < 4; ++sub) afr_[gi][sub] = *reinterpret_cast<const s16x4*>(P + (size_t)rows[sub] * INW + g * 16 + fq * 4);
      }
#pragma unroll
      for (int gi = 0; gi < 2; ++gi) {
        const int g = wid_ * 2 + gi;
        const float are = are_[gi], aim = aim_[gi];
        const s16x4 (&bfr)[8] = bfr_[gi]; const s16x4 (&afr)[4] = afr_[gi];
        float sr = 0.f, si = 0.f;
#pragma unroll
        for (int sub = 0; sub < 4; ++sub) {
          __builtin_amdgcn_sched_barrier(0);
#pragma unroll
          for (int cb = 0; cb < 8; ++cb) { const f32x4 d = __builtin_amdgcn_mfma_f32_16x16x16bf16_1k(afr[sub], bfr[cb], (f32x4){0.f, 0.f, 0.f, 0.f}, 0, 0, 0);
            *reinterpret_cast<f32x4*>(bub + (cb * 16 + fr) * BT_LD + fq * 4) = d; }
          __builtin_amdgcn_wave_barrier(); asm volatile("s_waitcnt lgkmcnt(0)" ::: "memory");
#pragma unroll
          for (int j4 = 0; j4 < 4; ++j4) { const f32x4 br4 = *reinterpret_cast<const f32x4*>(bub + lane * BT_LD + j4 * 4), bi4 = *reinterpret_cast<const f32x4*>(bub + (64 + lane) * BT_LD + j4 * 4);
#pragma unroll
            for (int r = 0; r < 4; ++r) { const float nr = are * sr - aim * si + br4[r], ni = are * si + aim * sr + bi4[r]; sr = nr; si = ni; } }
          __builtin_amdgcn_wave_barrier(); asm volatile("s_waitcnt lgkmcnt(0)" ::: "memory");
        }
        *reinterpret_cast<float2*>(E + ((size_t)(((b * 2 + dir) * NCHK + ck) * 16 + g) * 64 + lane) * 2) = make_float2(sr, si);
      }
      __syncthreads();
      continue;
    }
    i -= n_s5;
    if (i < n_gm) {
      const int ck = ((i >> 5) << 3) | (i & 7), h = (i >> 3) & 3; const int row0 = ck * 128;
      int tid = (int)threadIdx.x; asm volatile("" : "+v"(tid));
      const int lane = tid & 63, wid = (int)__builtin_amdgcn_readfirstlane(tid >> 6), fr = lane & 15, fq = lane >> 4;
      u16* vt = reinterpret_cast<u16*>(c.lds);
      uint2 tv[16];
#pragma unroll
      for (int q = 0; q < 16; ++q) tv[q] = *reinterpret_cast<const uint2*>(P + (size_t)(row0 + wid * 16 + q) * INW + 512 + lane * 4);
      const float* wrow = c.in(I_GMW) + ((size_t)(l * 4 + h) * 128 + wid * 16 + fr) * 128 + fq * 8;
      float4 wl[8];
#pragma unroll
      for (int ks = 0; ks < 4; ++ks) { wl[2 * ks] = *reinterpret_cast<const float4*>(wrow + ks * 32); wl[2 * ks + 1] = *reinterpret_cast<const float4*>(wrow + ks * 32 + 4); }
      const int t = wid * 16 + fr;
      const float bs = c.in(I_GMB)[(l * 4 + h) * 128 + t];
      const u16* up = P + (size_t)(row0 + t) * INW + 256 + h * 64 + fq * 4;
      uint2 uq[4];
#pragma unroll
      for (int m = 0; m < 4; ++m) uq[m] = *reinterpret_cast<const uint2*>(up + m * 16);
#pragma unroll
      for (int q = 0; q < 16; ++q) {
        const float v0 = bflo(tv[q].x), v1 = bfhi(tv[q].x), v2 = bflo(tv[q].y), v3 = bfhi(tv[q].y);
        const float mean = wave_sum(v0 + v1 + v2 + v3) * (1.f / 256.f);
        const float d0 = v0 - mean, d1 = v1 - mean, d2 = v2 - mean, d3 = v3 - mean;
        const float rstd = rsqrtf(wave_sum(d0 * d0 + d1 * d1 + d2 * d2 + d3 * d3) * (1.f / 256.f) + LN_EPS);
        if (fq == h) { u16* dst = vt + (fr * 4) * GM_LD + wid * 16 + q;
          dst[0] = f2bf(d0 * rstd); dst[GM_LD] = f2bf(d1 * rstd); dst[2 * GM_LD] = f2bf(d2 * rstd); dst[3 * GM_LD] = f2bf(d3 * rstd); }
      }
      bf16x8 bw[4];
#pragma unroll
      for (int ks = 0; ks < 4; ++ks) { const float4 w0 = wl[2 * ks], w1 = wl[2 * ks + 1];
        u32x4 pk = {pack2(w0.x, w0.y), pack2(w0.z, w0.w), pack2(w1.x, w1.y), pack2(w1.z, w1.w)}; bw[ks] = *reinterpret_cast<bf16x8*>(&pk); }
      __syncthreads();
      f32x4 acc[4];
#pragma unroll
      for (int m = 0; m < 4; ++m) acc[m] = (f32x4){0.f, 0.f, 0.f, 0.f};
#pragma unroll
      for (int ks = 0; ks < 4; ++ks)
#pragma unroll
        for (int m = 0; m < 4; ++m) { const bf16x8 a = *reinterpret_cast<const bf16x8*>(vt + (m * 16 + fr) * GM_LD + ks * 32 + fq * 8);
          acc[m] = __builtin_amdgcn_mfma_f32_16x16x32_bf16(a, bw[ks], acc[m], 0, 0, 0); }
      u16* yb = c.w<u16>(OFF_BIG + BIG_YB) + (size_t)(row0 + t) * 256 + h * 64 + fq * 4;
#pragma unroll
      for (int m = 0; m < 4; ++m) { const uint2 uu = uq[m];
        uint2 o; o.x = pack2(bflo(uu.x) * (acc[m][0] + bs), bfhi(uu.x) * (acc[m][1] + bs)); o.y = pack2(bflo(uu.y) * (acc[m][2] + bs), bfhi(uu.y) * (acc[m][3] + bs));
        *reinterpret_cast<uint2*>(yb + m * 16) = o; }
      __syncthreads();
      continue;
    }
    i -= n_gm;
    cvt_expert(c, l, CV_GIN(l) + i);
  }
}

#define SB_LD 136
__device__ __forceinline__ void s5_out_item(const Ctx& c, int l, int b, int seg, int j) {
  const u16* P = c.w<u16>(OFF_BIG + BIG_P); u16* YA = c.w<u16>(OFF_BIG + BIG_YA);
  const float* A = c.w<float>(OFF_S5A); const float* A64 = c.w<float>(OFF_S5A64); const float* BB = c.w<float>(OFF_S5BB); const float* E = c.w<float>(OFF_E);
  const int r0 = seg ? (TLAT + b * 256 + j * 64) : (b * 4096 + j * 64);
  const int kf = seg ? j : 4 + j, kr = seg ? 3 - j : 4 + (63 - j);
  int tid_ = ((int)threadIdx.x); asm volatile("" : "+v"(tid_));
  const int lane = tid_ & 63, fr = lane & 15, fq = lane >> 4, wid_ = __builtin_amdgcn_readfirstlane(tid_ >> 6);
  float* bub = reinterpret_cast<float*>(c.lds + wid_ * 14592);
  u16* sbuf = reinterpret_cast<u16*>(c.lds + wid_ * 14592 + 10240);
  unsigned* sbuf32 = reinterpret_cast<unsigned*>(sbuf);
  const u16* BBH = c.w<u16>(OFF_S5BBH);
#pragma unroll 1
  for (int gi = 0; gi < 2; ++gi) {
    const int g = wid_ * 2 + gi;
    f32x4 acc[4];
#pragma unroll
    for (int q = 0; q < 4; ++q) acc[q] = (f32x4){0.f, 0.f, 0.f, 0.f};
    float are_[2], aim_[2], a64r_[2], a64i_[2]; s16x4 bfr_[2][8], afr_[2][4]; float4 cr_[2][4], ci_[2][4];
#pragma unroll
    for (int dir = 0; dir < 2; ++dir) {
      const int q = ((l * 2 + dir) * 16 + g) * 64 + lane;
      are_[dir] = A[q * 2]; aim_[dir] = A[q * 2 + 1]; a64r_[dir] = A64[q * 2]; a64i_[dir] = A64[q * 2 + 1];
      const u16* bp = BBH + ((size_t)((l * 2 + dir) * 16 + g) * 128 + fr) * 16 + fq * 4;
#pragma unroll
      for (int cb = 0; cb < 8; ++cb) bfr_[dir][cb] = *reinterpret_cast<const s16x4*>(bp + cb * 256);
#pragma unroll
      for (int sub = 0; sub < 4; ++sub) { const int tau = sub * 16 + fr; const int tl = dir ? 63 - tau : tau;
        afr_[dir][sub] = *reinterpret_cast<const s16x4*>(P + (size_t)(r0 + tl) * INW + g * 16 + fq * 4); }
      const float* cre = c.in(I_CRE) + ((size_t)((l * 2 + dir) * 16 + g) * 16 + fr) * 64 + fq * 4; const float* cim = c.in(I_CIM) + ((size_t)((l * 2 + dir) * 16 + g) * 16 + fr) * 64 + fq * 4;
#pragma unroll
      for (int ks = 0; ks < 4; ++ks) { cr_[dir][ks] = *reinterpret_cast<const float4*>(cre + ks * 16); ci_[dir][ks] = *reinterpret_cast<const float4*>(cim + ks * 16); }
    }
#pragma unroll
    for (int dir = 0; dir < 2; ++dir) {
      const float are = are_[dir], aim = aim_[dir], a64r = a64r_[dir], a64i = a64i_[dir];
      const s16x4 (&bfr)[8] = bfr_[dir]; const s16x4 (&afr)[4] = afr_[dir];
      float sr = 0.f, si = 0.f; const int kk = dir ? kr : kf;
      { const float* ep = E + ((size_t)((b * 2 + dir) * NCHK * 16 + g) * 64 + lane) * 2;
        int jj = 0;
        for (; jj + 8 <= kk; jj += 8) {
          float2 e[8];
#pragma unroll
          for (int q = 0; q < 8; ++q) e[q] = *reinterpret_cast<const float2*>(ep + (size_t)(jj + q) * 2048);
#pragma unroll
          for (int q = 0; q < 8; ++q) { const float nr = a64r * sr - a64i * si + e[q].x, ni = a64r * si + a64i * sr + e[q].y; sr = nr; si = ni; }
        }
        for (; jj < kk; ++jj) { const float2 e = *reinterpret_cast<const float2*>(ep + (size_t)jj * 2048);
          const float nr = a64r * sr - a64i * si + e.x, ni = a64r * si + a64i * sr + e.y; sr = nr; si = ni; } }
      bf16x8 Bf[4];
#pragma unroll
      for (int ks = 0; ks < 4; ++ks) { const float4 a = cr_[dir][ks], bq = ci_[dir][ks];
        u32x4 pk = {pack2(a.x, -bq.x), pack2(a.y, -bq.y), pack2(a.z, -bq.z), pack2(a.w, -bq.w)}; Bf[ks] = *reinterpret_cast<bf16x8*>(&pk); }
#pragma unroll
      for (int sub = 0; sub < 4; ++sub) {
        __builtin_amdgcn_sched_barrier(0);
#pragma unroll
        for (int cb = 0; cb < 8; ++cb) { const f32x4 d = __builtin_amdgcn_mfma_f32_16x16x16bf16_1k(afr[sub], bfr[cb], (f32x4){0.f, 0.f, 0.f, 0.f}, 0, 0, 0);
          *reinterpret_cast<f32x4*>(bub + (cb * 16 + fr) * BT_LD + fq * 4) = d; }
        __builtin_amdgcn_wave_barrier(); asm volatile("s_waitcnt lgkmcnt(0)" ::: "memory");
#pragma unroll
        for (int j4 = 0; j4 < 4; ++j4) {
          const f32x4 br4 = *reinterpret_cast<const f32x4*>(bub + lane * BT_LD + j4 * 4), bi4 = *reinterpret_cast<const f32x4*>(bub + (64 + lane) * BT_LD + j4 * 4);
#pragma unroll
          for (int r = 0; r < 4; ++r) {
            const int tau = sub * 16 + j4 * 4 + r; const int tl = dir ? 63 - tau : tau;
            const float nr = are * sr - aim * si + br4[r], ni = are * si + aim * sr + bi4[r]; sr = nr; si = ni;
            sbuf32[(tl & 15) * (SB_LD / 2) + lane] = pack2(sr, si);
          }
        }
        __builtin_amdgcn_wave_barrier(); asm volatile("s_waitcnt lgkmcnt(0)" ::: "memory");
        bf16x8 Af[4];
#pragma unroll
        for (int ks = 0; ks < 4; ++ks) Af[ks] = *reinterpret_cast<const bf16x8*>(sbuf + fr * SB_LD + ks * 32 + fq * 8);
        asm volatile("s_waitcnt lgkmcnt(0)" ::: "memory"); __builtin_amdgcn_wave_barrier();
        if (dir == 0) {
#pragma unroll
          for (int ks = 0; ks < 4; ++ks) acc[sub] = __builtin_amdgcn_mfma_f32_16x16x32_bf16(Af[ks], Bf[ks], acc[sub], 0, 0, 0);
        } else {
#pragma unroll
          for (int ks = 0; ks < 4; ++ks) acc[3 - sub] = __builtin_amdgcn_mfma_f32_16x16x32_bf16(Af[ks], Bf[ks], acc[3 - sub], 0, 0, 0);
        }
      }
    }
#pragma unroll
    for (int tb = 0; tb < 4; ++tb)
#pragma unroll
      for (int jx = 0; jx < 4; ++jx) bub[(tb * 16 + fq * 4 + jx) * BT_LD + fr] = acc[tb][jx];
    __builtin_amdgcn_wave_barrier(); asm volatile("s_waitcnt lgkmcnt(0)" ::: "memory"); __builtin_amdgcn_wave_barrier();
#pragma unroll
    for (int i = 0; i < 2; ++i) { const int q = i * 64 + lane, tl = q >> 1, hf = q & 1;
      const f32x4 y0 = *reinterpret_cast<const f32x4*>(bub + tl * BT_LD + hf * 8), y1 = *reinterpret_cast<const f32x4*>(bub + tl * BT_LD + hf * 8 + 4);
      const u32x4 uu = *reinterpret_cast<const u32x4*>(P + (size_t)(r0 + tl) * INW + g * 16 + hf * 8);
      const float4 d0 = *reinterpret_cast<const float4*>(c.in(I_S5D) + l * 256 + g * 16 + hf * 8), d1 = *reinterpret_cast<const float4*>(c.in(I_S5D) + l * 256 + g * 16 + hf * 8 + 4);
      u32x4 o;
      o.x = pack2(gelu_tanh(d0.x * bflo(uu.x) + y0[0]), gelu_tanh(d0.y * bfhi(uu.x) + y0[1])); o.y = pack2(gelu_tanh(d0.z * bflo(uu.y) + y0[2]), gelu_tanh(d0.w * bfhi(uu.y) + y0[3]));
      o.z = pack2(gelu_tanh(d1.x * bflo(uu.z) + y1[0]), gelu_tanh(d1.y * bfhi(uu.z) + y1[1])); o.w = pack2(gelu_tanh(d1.z * bflo(uu.w) + y1[2]), gelu_tanh(d1.w * bfhi(uu.w) + y1[3]));
      *reinterpret_cast<u32x4*>(YA + (size_t)(r0 + tl) * 256 + g * 16 + hf * 8) = o; }
    __builtin_amdgcn_wave_barrier(); asm volatile("s_waitcnt lgkmcnt(0)" ::: "memory");
  }
}

__device__ __forceinline__ void attn_naive_item(const Ctx& c, int l, int b, int h, int qb, int seg) {
  const u16* P = c.w<u16>(OFF_BIG + BIG_P); u16* YC = c.w<u16>(OFF_BIG + BIG_YC);
  const int ql = ((int)threadIdx.x) >> 2, vq = ((int)threadIdx.x) & 3;
  const int qrow = seg ? (TLAT + b * 256 + qb * 128 + ql) : (b * 4096 + qb * 128 + ql);
  const int nkeys = seg ? 256 : 4352;
  const float lam_init = 0.8f - 0.6f * expf(-0.3f * (float)l);
  float lam;
  { const float* lf = c.in(I_DALAM) + l * 256; float s1 = 0.f, s2 = 0.f;
    for (int d = 0; d < 64; ++d) { s1 += lf[d] * lf[64 + d]; s2 += lf[128 + d] * lf[192 + d]; }
    lam = expf(s1) - expf(s2) + lam_init; }
  float res[32];
#pragma unroll 1
  for (int mp = 0; mp < 2; ++mp) {
    float q[64];
    { const u16* qp = P + (size_t)qrow * INW + 768 + h * 128 + mp * 64;
#pragma unroll
      for (int w = 0; w < 8; ++w) { u32x4 t = *reinterpret_cast<const u32x4*>(qp + w * 8);
#pragma unroll
        for (int e = 0; e < 4; ++e) { q[w * 8 + 2 * e] = bflo(t[e]) * 0.125f; q[w * 8 + 2 * e + 1] = bfhi(t[e]) * 0.125f; } } }
    float o[32];
#pragma unroll
    for (int d = 0; d < 32; ++d) o[d] = 0.f;
    float mx = -1e30f, ls = 0.f;
#pragma unroll 1
    for (int key = 0; key < nkeys; ++key) {
      const int krow = key < 256 ? (TLAT + b * 256 + key) : (b * 4096 + key - 256);
      const u16* kp = P + (size_t)krow * INW + 1280 + h * 128 + mp * 64;
      float s = 0.f;
#pragma unroll
      for (int w = 0; w < 8; ++w) { u32x4 t = *reinterpret_cast<const u32x4*>(kp + w * 8);
#pragma unroll
        for (int e = 0; e < 4; ++e) s += q[w * 8 + 2 * e] * bflo(t[e]) + q[w * 8 + 2 * e + 1] * bfhi(t[e]); }
      const float mn = fmaxf(mx, s); const float al = __expf(mx - mn), pp = __expf(s - mn); mx = mn; ls = ls * al + pp;
      const u16* vp = P + (size_t)krow * INW + 1792 + h * 128 + vq * 32;
#pragma unroll
      for (int w = 0; w < 4; ++w) { u32x4 t = *reinterpret_cast<const u32x4*>(vp + w * 8);
#pragma unroll
        for (int e = 0; e < 4; ++e) { o[w * 8 + 2 * e] = o[w * 8 + 2 * e] * al + pp * bflo(t[e]); o[w * 8 + 2 * e + 1] = o[w * 8 + 2 * e + 1] * al + pp * bfhi(t[e]); } }
    }
    const float inv = 1.f / ls;
    if (mp == 0) {
#pragma unroll
      for (int d = 0; d < 32; ++d) res[d] = o[d] * inv;
    } else {
#pragma unroll
      for (int d = 0; d < 32; ++d) res[d] = res[d] - lam * o[d] * inv;
    }
  }
  float ss = 0.f;
#pragma unroll
  for (int d = 0; d < 32; ++d) ss += res[d] * res[d];
  ss += __shfl_xor(ss, 1, 64); ss += __shfl_xor(ss, 2, 64);
  const float r = rsqrtf(ss * (1.f / 128.f) + LN_EPS) * (1.f - lam_init);
  const float* sg = c.in(I_SUBLN) + l * 128 + vq * 32;
  u16* yp = YC + (size_t)qrow * 512 + h * 128 + vq * 32;
#pragma unroll
  for (int w = 0; w < 4; ++w) { u32x4 t;
#pragma unroll
    for (int e = 0; e < 4; ++e) t[e] = pack2(res[w * 8 + 2 * e] * r * sg[w * 8 + 2 * e], res[w * 8 + 2 * e + 1] * r * sg[w * 8 + 2 * e + 1]);
    *reinterpret_cast<u32x4*>(yp + w * 8) = t; }
}

typedef __attribute__((ext_vector_type(16))) float f32x16;
#define KSWZ(row, colB) ((row) * 256 + ((colB) ^ (((row) & 15) << 4)))
#define SBAR() __builtin_amdgcn_sched_barrier(0)
#define ATT_THR 8.f
__device__ __forceinline__ int crow(int r, int hi) { return (r & 3) + 8 * (r >> 2) + 4 * hi; }
__device__ __forceinline__ int v_rd_base(int lane) { return ((lane & 3) << 3) | (((lane >> 2) & 3) << 6) | (((lane >> 4) & 1) << 5) | (((lane >> 5) & 1) << 8); }
constexpr int v_rd_off(int d0, int ks, int half) { return d0 * 512 + ks * 4096 + half * 2048; }
template <int OFF> __device__ __forceinline__ s16x4 tr_read(int vb) {
  typedef __attribute__((address_space(3))) s16x4* lp;
  return __builtin_amdgcn_ds_read_tr16_b64_v4i16((lp)(unsigned)(vb + OFF));
}
template <int MAP>
__device__ __forceinline__ void att_qkt(f32x16& p0, f32x16& p1, const char* Ks, const char* Qs, int r32, int hi) {
  p0 = f32x16{}; p1 = f32x16{};
#pragma unroll
  for (int dd = 0; dd < 4; ++dd) { const int d0 = MAP * 4 + dd; const int cb = (d0 * 16 + hi * 8) * 2;
    bf16x8 b0 = *reinterpret_cast<const bf16x8*>(Ks + KSWZ(r32, cb));
    bf16x8 b1 = *reinterpret_cast<const bf16x8*>(Ks + KSWZ(32 + r32, cb));
    bf16x8 qf = *reinterpret_cast<const bf16x8*>(Qs + KSWZ(r32, cb));
    p0 = __builtin_amdgcn_mfma_f32_32x32x16_bf16(b0, qf, p0, 0, 0, 0);
    p1 = __builtin_amdgcn_mfma_f32_32x32x16_bf16(b1, qf, p1, 0, 0, 0); }
}
__device__ __forceinline__ void att_softmax(f32x16& p0, f32x16& p1, float& m_reg, float& l_reg, float& alpha, bf16x8& pa0, bf16x8& pa1, bf16x8& pa2, bf16x8& pa3) {
  constexpr float SC = 0.125f, C = SC * 1.4426950408889634f;
  float pmax = p0[0];
#pragma unroll
  for (int r = 1; r < 16; ++r) pmax = fmaxf(pmax, p0[r]);
#pragma unroll
  for (int r = 0; r < 16; ++r) pmax = fmaxf(pmax, p1[r]);
  { auto rr = __builtin_amdgcn_permlane32_swap(__float_as_uint(pmax), __float_as_uint(pmax), false, false);
    pmax = fmaxf(__uint_as_float(rr[0]), __uint_as_float(rr[1])); }
  const bool keep = __all(pmax - m_reg <= ATT_THR / SC);
  const float mn = keep ? m_reg : fmaxf(m_reg, pmax);
  alpha = __builtin_amdgcn_exp2f((m_reg - mn) * C); m_reg = mn;
  const float mnC = -mn * C;
#pragma unroll
  for (int r = 0; r < 16; ++r) p0[r] = __builtin_amdgcn_exp2f(fmaf(p0[r], C, mnC));
#pragma unroll
  for (int r = 0; r < 16; ++r) p1[r] = __builtin_amdgcn_exp2f(fmaf(p1[r], C, mnC));
  float ps = 0.f;
#pragma unroll
  for (int r = 0; r < 16; ++r) ps += p0[r];
#pragma unroll
  for (int r = 0; r < 16; ++r) ps += p1[r];
  { auto rr = __builtin_amdgcn_permlane32_swap(__float_as_uint(ps), __float_as_uint(ps), false, false);
    ps = __uint_as_float(rr[0]) + __uint_as_float(rr[1]); }
  l_reg = l_reg * alpha + ps;
#define PK4(P, BASE, OUT) do { unsigned a0 = cvtpk(P[BASE + 0], P[BASE + 1]), a1 = cvtpk(P[BASE + 2], P[BASE + 3]);   \
    unsigned b0 = cvtpk(P[BASE + 4], P[BASE + 5]), b1 = cvtpk(P[BASE + 6], P[BASE + 7]);                              \
    auto r0 = __builtin_amdgcn_permlane32_swap(a0, b0, false, false); auto r1 = __builtin_amdgcn_permlane32_swap(a1, b1, false, false); \
    u32x4 w = {r0[0], r1[0], r0[1], r1[1]}; OUT = *reinterpret_cast<bf16x8*>(&w); } while (0)
  PK4(p0, 0, pa0); PK4(p0, 8, pa1); PK4(p1, 0, pa2); PK4(p1, 8, pa3);
#undef PK4
}
template <int D0> __device__ __forceinline__ void att_pv(f32x16& oa, f32x16& ob, int vb, const bf16x8 (&pa)[4], const bf16x8 (&pb)[4]) {
  const s16x4 l0 = tr_read<v_rd_off(D0, 0, 0)>(vb), h0 = tr_read<v_rd_off(D0, 0, 1)>(vb), l1 = tr_read<v_rd_off(D0, 1, 0)>(vb), h1 = tr_read<v_rd_off(D0, 1, 1)>(vb);
  const s16x4 l2 = tr_read<v_rd_off(D0, 2, 0)>(vb), h2 = tr_read<v_rd_off(D0, 2, 1)>(vb), l3 = tr_read<v_rd_off(D0, 3, 0)>(vb), h3 = tr_read<v_rd_off(D0, 3, 1)>(vb);
#define PKV(L, H) (bf16x8){L[0], L[1], L[2], L[3], H[0], H[1], H[2], H[3]}
  const bf16x8 v0 = PKV(l0, h0), v1 = PKV(l1, h1), v2 = PKV(l2, h2), v3 = PKV(l3, h3);
#undef PKV
  oa = __builtin_amdgcn_mfma_f32_32x32x16_bf16(pa[0], v0, oa, 0, 0, 0);
  ob = __builtin_amdgcn_mfma_f32_32x32x16_bf16(pb[0], v0, ob, 0, 0, 0);
  oa = __builtin_amdgcn_mfma_f32_32x32x16_bf16(pa[1], v1, oa, 0, 0, 0);
  ob = __builtin_amdgcn_mfma_f32_32x32x16_bf16(pb[1], v1, ob, 0, 0, 0);
  oa = __builtin_amdgcn_mfma_f32_32x32x16_bf16(pa[2], v2, oa, 0, 0, 0);
  ob = __builtin_amdgcn_mfma_f32_32x32x16_bf16(pb[2], v2, ob, 0, 0, 0);
  oa = __builtin_amdgcn_mfma_f32_32x32x16_bf16(pa[3], v3, oa, 0, 0, 0);
  ob = __builtin_amdgcn_mfma_f32_32x32x16_bf16(pb[3], v3, ob, 0, 0, 0);
}
template <int D0> __device__ __forceinline__ void att_pv1(f32x16& oa, int vb, const bf16x8 (&pa)[4]) {
  const s16x4 l0 = tr_read<v_rd_off(D0, 0, 0)>(vb), h0 = tr_read<v_rd_off(D0, 0, 1)>(vb), l1 = tr_read<v_rd_off(D0, 1, 0)>(vb), h1 = tr_read<v_rd_off(D0, 1, 1)>(vb);
  const s16x4 l2 = tr_read<v_rd_off(D0, 2, 0)>(vb), h2 = tr_read<v_rd_off(D0, 2, 1)>(vb), l3 = tr_read<v_rd_off(D0, 3, 0)>(vb), h3 = tr_read<v_rd_off(D0, 3, 1)>(vb);
#define PKV(L, H) (bf16x8){L[0], L[1], L[2], L[3], H[0], H[1], H[2], H[3]}
  oa = __builtin_amdgcn_mfma_f32_32x32x16_bf16(pa[0], PKV(l0, h0), oa, 0, 0, 0);
  oa = __builtin_amdgcn_mfma_f32_32x32x16_bf16(pa[1], PKV(l1, h1), oa, 0, 0, 0);
  oa = __builtin_amdgcn_mfma_f32_32x32x16_bf16(pa[2], PKV(l2, h2), oa, 0, 0, 0);
  oa = __builtin_amdgcn_mfma_f32_32x32x16_bf16(pa[3], PKV(l3, h3), oa, 0, 0, 0);
#undef PKV
}
#define ATT_KBUF(b) ((b) * 16384)
#define ATT_VBUF(b) (32768 + (b) * 16384)
#define ATT_WS_OFF 65536
#define ATT_Q_OFF 69632
__device__ __forceinline__ void attn_mfma_item(const Ctx& c, int l, int b, int h, int qb, int seg) {
  const u16* P = c.w<u16>(OFF_BIG + BIG_P); u16* YC = c.w<u16>(OFF_BIG + BIG_YC);
  int tid = ((int)threadIdx.x); asm volatile("" : "+v"(tid));
  const int wid = __builtin_amdgcn_readfirstlane(tid >> 6), lane = tid & 63, r32 = lane & 31, hi = lane >> 5;
  const int q0 = seg ? (TLAT + b * 256) : (b * 4096 + qb * 256);
  const int NT = seg ? 4 : 68;
  float* wsl = reinterpret_cast<float*>(c.lds + ATT_WS_OFF) + wid * 64;
  const float lam_init = 0.8f - 0.6f * expf(-0.3f * (float)l);
  float lam;
  { const float* lf = c.in(I_DALAM) + l * 256; float s1 = lf[lane] * lf[64 + lane], s2 = lf[128 + lane] * lf[192 + lane];
    s1 = wave_sum(s1); s2 = wave_sum(s2); lam = expf(s1) - expf(s2) + lam_init; }
#pragma unroll
  for (int i = 0; i < 8; ++i) { const int q = i * NTHR + tid, row = q >> 4, col = ((q & 15) ^ (row & 15)) * 8;
    glds16(P + (size_t)(q0 + row) * INW + 768 + h * 128 + col, c.lds + ATT_Q_OFF + (i * NTHR + tid) * 16); }
  const char* Qs = c.lds + ATT_Q_OFF + wid * 32 * 256;
  int krow[2], kcol[2], vrow[2], vcol[2];
#pragma unroll
  for (int i = 0; i < 2; ++i) { const int q = i * NTHR + tid;
    krow[i] = q >> 4; kcol[i] = ((q & 15) ^ (krow[i] & 15)) * 8;
    const int st = q >> 5, r5 = q & 31, kk = ((st >> 2) << 3) | (r5 >> 2);
    vrow[i] = (kk & ~0xC) | ((kk & 4) << 1) | ((kk & 8) >> 1); vcol[i] = (st & 3) * 32 + (r5 & 3) * 8; }
  auto issue_tile = [&](int jt, int buf) {
    const int kr0 = (jt < 4) ? (TLAT + b * 256 + jt * 64) : (b * 4096 + (jt - 4) * 64);
#pragma unroll
    for (int i = 0; i < 2; ++i) {
      glds16(P + (size_t)(kr0 + krow[i]) * INW + 1280 + h * 128 + kcol[i], c.lds + ATT_KBUF(buf) + (i * NTHR + tid) * 16);
      glds16(P + (size_t)(kr0 + vrow[i]) * INW + 1792 + h * 128 + vcol[i], c.lds + ATT_VBUF(buf) + (i * NTHR + tid) * 16); }
  };
  f32x16 o0[4], o1[4];
#pragma unroll
  for (int d = 0; d < 4; ++d) { o0[d] = f32x16{}; o1[d] = f32x16{}; }
  float m0 = -1e30f, l0 = 0.f, m1 = -1e30f, l1 = 0.f;
  const int vbase = (int)(uintptr_t)(c.lds) + v_rd_base(lane);
  issue_tile(0, 0);
  asm volatile("s_waitcnt vmcnt(0)" ::: "memory");
  __syncthreads();
#pragma unroll 1
  for (int jt = 0; jt < NT; ++jt) {
    const int buf = jt & 1;
    if (jt + 1 < NT) issue_tile(jt + 1, buf ^ 1);
    const char* Ks = c.lds + ATT_KBUF(buf);
    bf16x8 pa[4], pb[4]; float al0, al1;
    { f32x16 p0, p1; att_qkt<0>(p0, p1, Ks, Qs, r32, hi); att_softmax(p0, p1, m0, l0, al0, pa[0], pa[1], pa[2], pa[3]); }
    if (__any(al0 < 1.f)) {
      if (hi == 0) wsl[r32] = al0;
      asm volatile("s_waitcnt lgkmcnt(0)" ::: "memory");
#pragma unroll
      for (int r = 0; r < 16; ++r) { const float a0 = wsl[crow(r, hi)];
#pragma unroll
        for (int d = 0; d < 4; ++d) o0[d][r] *= a0; }
    }
    const int vb = vbase + ATT_VBUF(buf);
    { f32x16 p0, p1; att_qkt<1>(p0, p1, Ks, Qs, r32, hi);
      att_pv1<0>(o0[0], vb, pa); att_pv1<1>(o0[1], vb, pa); att_pv1<2>(o0[2], vb, pa); att_pv1<3>(o0[3], vb, pa);
      att_softmax(p0, p1, m1, l1, al1, pb[0], pb[1], pb[2], pb[3]); }
    if (__any(al1 < 1.f)) {
      if (hi == 0) wsl[32 + r32] = al1;
      asm volatile("s_waitcnt lgkmcnt(0)" ::: "memory");
#pragma unroll
      for (int r = 0; r < 16; ++r) { const float a1 = wsl[32 + crow(r, hi)];
#pragma unroll
        for (int d = 0; d < 4; ++d) o1[d][r] *= a1; }
    }
    att_pv1<0>(o1[0], vb, pb); att_pv1<1>(o1[1], vb, pb); att_pv1<2>(o1[2], vb, pb); att_pv1<3>(o1[3], vb, pb);
    asm volatile("s_waitcnt vmcnt(0)" ::: "memory");
    __syncthreads();
  }
  if (hi == 0) { wsl[r32] = 1.f / l0; wsl[32 + r32] = lam / l1; }
  asm volatile("s_waitcnt lgkmcnt(0)" ::: "memory");
  float ss[16];
#pragma unroll
  for (int r = 0; r < 16; ++r) { const float i0 = wsl[crow(r, hi)], i1 = wsl[32 + crow(r, hi)]; float s = 0.f;
#pragma unroll
    for (int d = 0; d < 4; ++d) { const float v = o0[d][r] * i0 - o1[d][r] * i1; o0[d][r] = v; s += v * v; }
    ss[r] = s; }
#pragma unroll
  for (int r = 0; r < 16; ++r) {
#pragma unroll
    for (int mk = 1; mk < 32; mk <<= 1) ss[r] += __shfl_xor(ss[r], mk, 64);
    ss[r] = rsqrtf(ss[r] * (1.f / 128.f) + LN_EPS) * (1.f - lam_init); }
  const float* sg = c.in(I_SUBLN) + l * 128;
  float g4[4];
#pragma unroll
  for (int d = 0; d < 4; ++d) g4[d] = sg[d * 32 + r32];
  { u16* stg = reinterpret_cast<u16*>(c.lds + ATT_KBUF(0)) + wid * (32 * 128);
#pragma unroll
    for (int r = 0; r < 16; ++r)
#pragma unroll
      for (int d = 0; d < 4; ++d) stg[crow(r, hi) * 128 + d * 32 + r32] = f2bf(o0[d][r] * ss[r] * g4[d]);
    __builtin_amdgcn_wave_barrier(); asm volatile("s_waitcnt lgkmcnt(0)" ::: "memory"); __builtin_amdgcn_wave_barrier();
#pragma unroll
    for (int i = 0; i < 8; ++i) { const int q = i * 64 + lane, row = q >> 4, c8 = (q & 15) * 8;
      *reinterpret_cast<u32x4*>(YC + (size_t)(q0 + wid * 32 + row) * 512 + h * 128 + c8) = *reinterpret_cast<const u32x4*>(stg + row * 128 + c8); } }
  __syncthreads();
}

__device__ __forceinline__ void step_mix_b(const Ctx& c, int l, bool last) {
#ifdef NAIVE_ATTN
  const int n_att = 512, n_attc = last ? 0 : 32, n_s5 = 4 * 64, n_s5c = last ? 0 : 16;
#else
  const int n_att = 256, n_attc = last ? 0 : 16, n_s5 = 4 * 64, n_s5c = last ? 0 : 16;
#endif
  const int total = n_att + n_attc + n_s5 + n_s5c;
#ifdef PROBE_A
  unsigned long long tq0 = 0; if (blockIdx.x == 0 && ((int)threadIdx.x) == 0) tq0 = __builtin_amdgcn_s_memrealtime();
#endif
  for (int it = blockIdx.x; it < total; it += gridDim.x) {
    int i = it;
#ifdef PROBE_A
    if (it != (int)blockIdx.x && it == (int)blockIdx.x + (int)gridDim.x && blockIdx.x == 0 && ((int)threadIdx.x) == 0) { unsigned long long* tsl_ = reinterpret_cast<unsigned long long*>(c.lds + 158720); tsl_[45 + l] = __builtin_amdgcn_s_memrealtime() - tq0; }
#endif
#ifdef NAIVE_ATTN
    if (i < n_att) { const int bh = i >> 5, qb = i & 31; attn_naive_item(c, l, bh >> 2, bh & 3, qb, 0); continue; }
    i -= n_att;
    if (i < n_attc) { const int bh = i >> 1; attn_naive_item(c, l, bh >> 2, bh & 3, i & 1, 1); continue; }
#else
    if (i < n_att) { const int xcd = i & 7, slot = i >> 3; const int bh = xcd * 2 + (slot >> 4), qb = slot & 15;
      attn_mfma_item(c, l, bh >> 2, bh & 3, qb, 0); continue; }
    i -= n_att;
    if (i < n_attc) { attn_mfma_item(c, l, i >> 2, i & 3, 0, 1); continue; }
#endif
    i -= n_attc;
    if (i < n_s5) { s5_out_item(c, l, i >> 6, 0, i & 63); continue; }
    i -= n_s5;
    s5_out_item(c, l, i >> 2, 1, i & 3);
  }
#ifdef PROBE_A
  if (blockIdx.x == 0 && ((int)threadIdx.x) == 0) { unsigned long long* tsl_ = reinterpret_cast<unsigned long long*>(c.lds + 158720); tsl_[47 + l] = __builtin_amdgcn_s_memrealtime() - tq0; }
#endif
}

__device__ __forceinline__ void step_merge(const Ctx& c, int l, bool last) {
  const char* wl = c.p.ws + OFF_WS + (size_t)l * WS_LAYER;
  const u16* WGLU = (const u16*)(wl + WS_GLU); const u16* WGM = (const u16*)(wl + WS_GM); const u16* WDA = (const u16*)(wl + WS_DA);
  const u16* P = c.w<u16>(OFF_BIG + BIG_P); const u16* YA = c.w<u16>(OFF_BIG + BIG_YA); const u16* YB = c.w<u16>(OFF_BIG + BIG_YB); const u16* YC = c.w<u16>(OFF_BIG + BIG_YC);
  u16* Mb = c.w<u16>(OFF_BIG + BIG_M);
  const int wm = ((int)__builtin_amdgcn_readfirstlane(threadIdx.x >> 6)) >> 1, wn = ((int)__builtin_amdgcn_readfirstlane(threadIdx.x >> 6)) & 1, fr = ((int)threadIdx.x & 63) & 15, fq = ((int)threadIdx.x & 63) >> 4;
  const int ntm = last ? 64 : 68;
  XSched s = xsched(ntm * 16);
  if (s.pos >= s.end) return;
#define TILE_OF(L) const int band = (L) / (4 * 16), rem = (L) % (4 * 16), tn = rem >> 2, tm = band * 4 + (rem & 3)
  auto p_gv = [&](int L) { TILE_OF(L); return gs_ptrs([&](int r) { return YA + (size_t)(tm * 256 + r) * 256; }, [&](int b) { return WGLU + (size_t)(tn * 64 + b) * 256; }); };
  auto p_gg = [&](int L) { TILE_OF(L); return gs_ptrs([&](int r) { return YA + (size_t)(tm * 256 + r) * 256; }, [&](int b) { return WGLU + (size_t)(1024 + tn * 64 + b) * 256; }); };
  auto p_gm = [&](int L) { TILE_OF(L); return gs_ptrs([&](int r) { return YB + (size_t)(tm * 256 + r) * 256; }, [&](int b) { return WGM + (size_t)(tn * 64 + b) * 256; }); };
  auto p_da = [&](int L) { TILE_OF(L); return gs_ptrs([&](int r) { return YC + (size_t)(tm * 256 + r) * 512; }, [&](int b) { return WDA + (size_t)(tn * 64 + b) * 512; }); };
  GStream g; gs_start(g, p_gv(s.pos), 4, p_gg(s.pos), 4, c.lds);
  for (;;) {
    TILE_OF(s.pos);
    const int nx = s.pos + s.step; const bool hn = nx < s.end;
    f32x4 am[4][2];
#define GATE4(G, J) ((J) == 0 ? bflo(G.x) : (J) == 1 ? bfhi(G.x) : (J) == 2 ? bflo(G.y) : bfhi(G.y))
    { f32x4 tv[4][2], tg[4][2]; ZERO_ACC2(tv); ZERO_ACC2(tg);
      gs_run<2>(g, tv, c.lds); gs_advance(g);
      gs_set_next(g, p_gm(s.pos), 4);
      gs_run<2>(g, tg, c.lds); gs_advance(g);
      { EPI_M(tm * 256)
          const u16* gp = P + (size_t)row * INW + 2304 + tn * 64 + wn * 32 + fq * 4;
#pragma unroll
          for (int n = 0; n < 2; ++n) { const uint2 gg = *reinterpret_cast<const uint2*>(gp + n * 16);
#pragma unroll
            for (int j = 0; j < 4; ++j) am[m][n][j] = GATE4(gg, j) * tv[m][n][j] * sigmoidf_(tg[m][n][j]); }
        EPI_M_END } }
    { f32x4 t[4][2]; ZERO_ACC2(t);
      gs_set_next(g, p_da(s.pos), 8);
      gs_run<2>(g, t, c.lds); gs_advance(g);
      { EPI_M(tm * 256)
          const u16* gp = P + (size_t)row * INW + 2304 + 1024 + tn * 64 + wn * 32 + fq * 4;
#pragma unroll
          for (int n = 0; n < 2; ++n) { const uint2 gg = *reinterpret_cast<const uint2*>(gp + n * 16);
#pragma unroll
            for (int j = 0; j < 4; ++j) am[m][n][j] += GATE4(gg, j) * t[m][n][j]; }
        EPI_M_END } }
    { f32x4 t[4][2]; ZERO_ACC2(t);
      if (hn) gs_set_next(g, p_gv(nx), 4);
      gs_run<2>(g, t, c.lds);
      { EPI_M(tm * 256)
          const u16* gp = P + (size_t)row * INW + 2304 + 2048 + tn * 64 + wn * 32 + fq * 4;
#pragma unroll
          for (int n = 0; n < 2; ++n) { const uint2 gg = *reinterpret_cast<const uint2*>(gp + n * 16);
#pragma unroll
            for (int j = 0; j < 4; ++j) am[m][n][j] += GATE4(gg, j) * t[m][n][j]; }
        EPI_M_END } }
#undef GATE4
    epi_tile<2, 8>(c.lds, [&](int m, int n) { return am[m][n]; },
      [&](int row, int col, u32x4 v) { *reinterpret_cast<u32x4*>(Mb + (size_t)(tm * 256 + row) * 1024 + tn * 64 + col) = v; });
    if (!hn) break;
    gs_advance(g); s.pos = nx;
    gs_set_next(g, p_gg(nx), 4);
  }
#undef TILE_OF
}

__device__ __forceinline__ void step_out(const Ctx& c, int l, bool last) {
  const u16* WOUT = (const u16*)(c.p.ws + OFF_WS + (size_t)l * WS_LAYER + WS_OUT);
  const u16* Mb = c.w<u16>(OFF_BIG + BIG_M); u16* H = c.w<u16>(OFF_H);
  const int ntm = last ? 64 : 68;
  DenseSched<true> S{(const char*)Mb, (const char*)WOUT, 1024, 4, ntm * 4};
  g8::phase<DUnit>(c.lds, 1024, S, [&](const g8::Acc& acc, const DUnit& u, int wr, int wc, int fr, int fq) {
#pragma unroll
    for (int ai = 0; ai < 2; ++ai)
#pragma unroll
      for (int m = 0; m < 4; ++m) {
        const int row = u.pm * 256 + ai * 128 + wr * 64 + m * 16 + fr, col0 = u.pn * 256 + wc * 32 + 8 * fq;
        const float* g1 = c.mod(l, brow_of(row), 2) + col0;
        u16* hd = H + (size_t)row * 1024 + col0;
#pragma unroll
        for (int bj = 0; bj < 2; ++bj) {
          const f32x4 v0 = acc[ai][bj][m][0], v1 = acc[ai][bj][m][1];
          float h[8];
          if (l == 0) { const float* hs = (row < TLAT ? c.in(I_X) + (size_t)row * 1024 : c.in(I_CTX) + (size_t)(row - TLAT) * 1024) + col0 + bj * 128;
            const float4 a = *reinterpret_cast<const float4*>(hs), b = *reinterpret_cast<const float4*>(hs + 4);
            h[0] = a.x; h[1] = a.y; h[2] = a.z; h[3] = a.w; h[4] = b.x; h[5] = b.y; h[6] = b.z; h[7] = b.w; }
          else { const u32x4 hb = *reinterpret_cast<const u32x4*>(hd + bj * 128);
#pragma unroll
            for (int e = 0; e < 4; ++e) { h[2 * e] = bflo(hb[e]); h[2 * e + 1] = bfhi(hb[e]); } }
          const float4 ga = *reinterpret_cast<const float4*>(g1 + bj * 128), gb = *reinterpret_cast<const float4*>(g1 + bj * 128 + 4);
          u32x4 w; w.x = pack2(ALPHA * h[0] + ga.x * v0[0], ALPHA * h[1] + ga.y * v0[1]); w.y = pack2(ALPHA * h[2] + ga.z * v0[2], ALPHA * h[3] + ga.w * v0[3]);
          w.z = pack2(ALPHA * h[4] + gb.x * v1[0], ALPHA * h[5] + gb.y * v1[1]); w.w = pack2(ALPHA * h[6] + gb.z * v1[2], ALPHA * h[7] + gb.w * v1[3]);
          *reinterpret_cast<u32x4*>(hd + bj * 128) = w;
        }
      }
  });
  if (!last) {
    const int G = (int)gridDim.x, extra = (ntm * 4) % G;
    const int j = extra > 0 ? (int)blockIdx.x - extra : (int)blockIdx.x, nidle = extra > 0 ? G - extra : G;
    if (j >= 0) { for (int it = NCVT_EXP - CV_OUT(l) + j; it < NCVT_EXP; it += nidle) cvt_expert(c, l, it);
      for (int it = j; it < NCVT_SMALL; it += nidle) cvt_small(c, 1, it); }
  }
}

__device__ __forceinline__ void step_ln_mid(const Ctx& c, int l, int mrows) {
  u16* H = c.w<u16>(OFF_H); u16* F = c.w<u16>(OFF_ACT);
  for (int it = blockIdx.x; it < mrows / 8; it += gridDim.x) {
    const int row = it * 8 + ((int)__builtin_amdgcn_readfirstlane(threadIdx.x >> 6)); float v[16]; load_row_bf(H + (size_t)row * 1024, ((int)threadIdx.x & 63), v);
    ln_affine(v, c.in(I_LN1G) + l * 1024, c.in(I_LN1B) + l * 1024, ((int)threadIdx.x & 63));
    store_row_bf(H + (size_t)row * 1024, ((int)threadIdx.x & 63), v);
    const int br = brow_of(row);
    ln_mod_store(v, c.mod(l, br, 3), c.mod(l, br, 4), F + (size_t)row * 1024, ((int)threadIdx.x & 63));
  }
}

#define ROUTER_RPB(LAST) ((LAST) ? 64 : 68)
template <bool LAST>
__device__ __forceinline__ void step_router(const Ctx& c, int l, int halfrows) {
  constexpr int RPB = ROUTER_RPB(LAST), NRB = (RPB + 31) / 32, MROWS = LAST ? TLAT : MTOT;
  const u16* F = c.w<u16>(OFF_ACT); const u16* WR = (const u16*)(c.p.ws + OFF_WS + (size_t)l * WS_LAYER + WS_R);
  float* topw = c.w<float>(OFF_TOPW); int* sele = c.w<int>(OFF_SELE);
  int tid = (int)threadIdx.x; asm volatile("" : "+v"(tid));
  const int lane = tid & 63, r32 = lane & 31, hi = lane >> 5, wid = (int)__builtin_amdgcn_readfirstlane(tid >> 6);
  float* part = reinterpret_cast<float*>(c.lds);
  int* lcnt = reinterpret_cast<int*>(c.lds + 8 * 68 * 64 * 4);
  if (tid < 128) lcnt[tid] = 0;
  __syncthreads();
  const float bias = c.in(I_BR)[l * 64 + lane];
  for (int it = blockIdx.x; it < MROWS / RPB; it += gridDim.x) {
    const int row0 = it * RPB;
    {
      u16* H = c.w<u16>(OFF_H); u16* Fw = c.w<u16>(OFF_ACT);
#pragma unroll 1
      for (int bt = 0; bt < 3; ++bt) {
        if (wid + 24 * bt >= RPB) break;
        float v[3][16];
#pragma unroll
        for (int s = 0; s < 3; ++s) { const int rw_ = wid + 8 * (3 * bt + s), rw = rw_ < RPB ? rw_ : wid; load_row_bf(H + (size_t)(row0 + rw) * 1024, lane, v[s]); }
#pragma unroll
        for (int s = 0; s < 3; ++s) { const int rw_ = wid + 8 * (3 * bt + s), rw = rw_ < RPB ? rw_ : wid; const int row = row0 + rw;
          ln_affine(v[s], c.in(I_LN1G) + l * 1024, c.in(I_LN1B) + l * 1024, lane);
          if (rw_ < RPB) { store_row_bf(H + (size_t)row * 1024, lane, v[s]); const int br = brow_of(row);
            ln_mod_store(v[s], c.mod(l, br, 3), c.mod(l, br, 4), Fw + (size_t)row * 1024, lane); } }
      }
    }
    __syncthreads();
    f32x16 acc[NRB][2];
#pragma unroll
    for (int rb = 0; rb < NRB; ++rb) { acc[rb][0] = f32x16{}; acc[rb][1] = f32x16{}; }
    const u16* ap[NRB];
#pragma unroll
    for (int rb = 0; rb < NRB; ++rb) { int rr = rb * 32 + r32; rr = rr < RPB ? rr : RPB - 1; ap[rb] = F + (size_t)(row0 + rr) * 1024 + wid * 128 + hi * 8; }
    const u16* bp = WR + (size_t)r32 * 1024 + wid * 128 + hi * 8;
#pragma unroll
    for (int ks = 0; ks < 8; ++ks) {
      bf16x8 b[4];
#pragma unroll
      for (int nb = 0; nb < 4; ++nb) b[nb] = *reinterpret_cast<const bf16x8*>(bp + (size_t)nb * 32 * 1024 + ks * 16);
#pragma unroll
      for (int rb = 0; rb < NRB; ++rb) { const bf16x8 a = *reinterpret_cast<const bf16x8*>(ap[rb] + ks * 16);
#pragma unroll
        for (int nh = 0; nh < 2; ++nh) { acc[rb][nh] = __builtin_amdgcn_mfma_f32_32x32x16_bf16(a, b[nh], acc[rb][nh], 0, 0, 0);
          acc[rb][nh] = __builtin_amdgcn_mfma_f32_32x32x16_bf16(a, b[2 + nh], acc[rb][nh], 0, 0, 0); } }
    }
#pragma unroll
    for (int rb = 0; rb < NRB; ++rb)
#pragma unroll
      for (int r = 0; r < 16; ++r) { const int rr = rb * 32 + crow(r, hi);
        if (rr < RPB) { float* pr = part + ((wid * RPB + rr) * 64 + r32); pr[0] = acc[rb][0][r]; pr[32] = acc[rb][1][r]; } }
    __syncthreads();
#pragma unroll 1
    for (int bt = 0; bt < 3; ++bt) {
      if (wid + 24 * bt >= RPB) break;
      int ln = lane; asm volatile("" : "+v"(ln));
      int key[3]; float score[3];
#pragma unroll
      for (int s = 0; s < 3; ++s) {
        const int rw_ = wid + 8 * (3 * bt + s), rw = rw_ < RPB ? rw_ : wid;
        float lgt = 0.f;
#pragma unroll
        for (int w = 0; w < 8; ++w) lgt += part[(w * RPB + rw) * 64 + lane];
        const float sc = sigmoidf_(lgt), sel = sc + bias; score[s] = sc;
        float m1 = sel;
        m1 = fmaxf(m1, __shfl_xor(m1, 1, 64)); m1 = fmaxf(m1, __shfl_xor(m1, 2, 64)); m1 = fmaxf(m1, __shfl_xor(m1, 4, 64));
        const unsigned long long bm = __ballot(sel == m1);
        const unsigned grp = (unsigned)((bm >> (lane & ~7)) & 0xffull);
        const int first = __ffs((int)grp) - 1;
        float s2 = ((lane & 7) == first) ? -3.0e38f : sel;
        s2 = fmaxf(s2, __shfl_xor(s2, 1, 64)); s2 = fmaxf(s2, __shfl_xor(s2, 2, 64)); s2 = fmaxf(s2, __shfl_xor(s2, 4, 64));
        const float gs = m1 + s2; const int g8 = lane >> 3;
        int cg = 0;
#pragma unroll
        for (int jg = 0; jg < 8; ++jg) { const float gj = __shfl(gs, jg * 8, 64); cg += (gj > gs || (gj == gs && jg < g8)) ? 1 : 0; }
        int kb = __float_as_int(sel); kb ^= (kb >> 31) & 0x7fffffff;
        key[s] = (cg < 4) ? ((kb & ~63) | (63 - lane)) : (int)(0x80000000u | (unsigned)(63 - lane));
      }
#pragma unroll
      for (int k = 2; k <= 64; k <<= 1)
#pragma unroll
        for (int j = k >> 1; j > 0; j >>= 1) {
          const bool takemax = (((ln & j) == 0) == ((ln & k) == 0));
#pragma unroll
          for (int s = 0; s < 3; ++s) { const int o = __shfl_xor(key[s], j, 64); key[s] = takemax ? max(key[s], o) : min(key[s], o); }
        }
      int esel[3]; float wv[3];
#pragma unroll
      for (int s = 0; s < 3; ++s) { const int e = 63 - (key[s] & 63); const float sv = __shfl(score[s], e, 64);
        float ws = lane < 8 ? sv : 0.f; ws += __shfl_xor(ws, 1, 64); ws += __shfl_xor(ws, 2, 64); ws += __shfl_xor(ws, 4, 64);
        esel[s] = e; wv[s] = sv / ws * 2.5f; }
      if (lane < 8) {
#pragma unroll
        for (int s = 0; s < 3; ++s) { const int rw_ = wid + 8 * (3 * bt + s);
          if (rw_ < RPB) { const int tok = row0 + rw_; const int hh = tok >= halfrows ? 1 : 0;
            topw[(size_t)tok * 8 + lane] = wv[s]; sele[(size_t)tok * 8 + lane] = esel[s];
            atomicAdd(&lcnt[hh * 64 + esel[s]], 1); } }
      }
    }
    __syncthreads();
  }
  if (tid < 128) c.w<int>(OFF_CNTB)[blockIdx.x * 128 + tid] = lcnt[tid];
}
__device__ __forceinline__ void step_scatter(const Ctx& c, int l, int mrows, int halfrows) {
  int* cnt = c.w<int>(OFF_CNT) + l * 128; int* list = c.w<int>(OFF_LIST); int* sele = c.w<int>(OFF_SELE); const int* cntb = c.w<int>(OFF_CNTB);
  int* base = reinterpret_cast<int*>(c.lds); int* run = base + 128; int* tot = base + 256; int* ebh = base + 384;
  {
    const int t = ((int)threadIdx.x) & 127, part = ((int)threadIdx.x) >> 7; int s = 0, tt = 0; const int nb = (int)gridDim.x, b0 = part * ((nb + 3) >> 2), b1 = min(nb, b0 + ((nb + 3) >> 2));
    int b = b0;
    for (; b + 16 <= b1; b += 16) {
      int v[16];
#pragma unroll
      for (int j = 0; j < 16; ++j) v[j] = cntb[(b + j) * 128 + t];
#pragma unroll
      for (int j = 0; j < 16; ++j) { if (b + j < (int)blockIdx.x) s += v[j]; tt += v[j]; } }
    for (; b < b1; ++b) { const int v = cntb[b * 128 + t]; if (b < (int)blockIdx.x) s += v; tt += v; }
    int* ps = base + 512 + part * 256; ps[t] = s; ps[128 + t] = tt; }
  __syncthreads();
  if (((int)threadIdx.x) < 128) { int s = 0, tt = 0;
#pragma unroll
    for (int part = 0; part < 4; ++part) { s += base[512 + part * 256 + ((int)threadIdx.x)]; tt += base[512 + part * 256 + 128 + ((int)threadIdx.x)]; }
    base[((int)threadIdx.x)] = s; run[((int)threadIdx.x)] = 0; tot[((int)threadIdx.x)] = tt; if (blockIdx.x == 0) cnt[((int)threadIdx.x)] = tt; }
  __syncthreads();
  if (((int)threadIdx.x) < 128) { int s = 0; const int h0 = ((int)threadIdx.x) & 64; for (int e = h0; e < ((int)threadIdx.x); ++e) s += tot[e]; ebh[((int)threadIdx.x)] = s; }
  __syncthreads();
  const int rpb = (mrows == TLAT) ? ROUTER_RPB(true) : ROUTER_RPB(false);
  for (int it = blockIdx.x; it < mrows / rpb; it += gridDim.x) {
    for (int q = (int)threadIdx.x; q < rpb * 8; q += NTHR) { const int tok = it * rpb + (q >> 3), rk = q & 7; const int e = sele[(size_t)tok * 8 + rk]; const int hh = tok >= halfrows ? 1 : 0;
      const int pos = base[hh * 64 + e] + atomicAdd(&run[hh * 64 + e], 1);
      list[((size_t)hh * 64 + e) * 8704 + pos] = tok * 8 + rk;
      sele[(size_t)tok * 8 + rk] = ebh[hh * 64 + e] + pos; }
  }
  __syncthreads();
}

#define MOE_LDS_OFF 159744
__device__ __forceinline__ int moe_schedule(const Ctx& c, int l, int hh, int halfrows) {
  int* pre = reinterpret_cast<int*>(c.lds + MOE_LDS_OFF); int* cn = pre + 72; int* eb = cn + 72;
  const int* cnt = c.w<int>(OFF_CNT) + l * 128 + hh * 64;
  if (((int)threadIdx.x) < 64) {
    const int e = (int)threadIdx.x; const int n = cnt[e]; const int tl = (n + 255) >> 8;
    int s = tl, r = n;
#pragma unroll
    for (int d = 1; d < 64; d <<= 1) { const int s2 = __shfl_up(s, d, 64), r2 = __shfl_up(r, d, 64); if (e >= d) { s += s2; r += r2; } }
    cn[e] = n; pre[e] = s - tl; eb[e] = r - n;
    if (e == 63) { cn[64] = halfrows; pre[64] = s; eb[64] = r; pre[65] = s + ((halfrows + 255) >> 8); } }
  __syncthreads();
  return pre[65];
}
struct MUnit { int e, rti, tn, ne, eb; };
struct MoeSchedBase {
  const int* pre; const int* cn; const int* eb; int total, NTN;
  __device__ __forceinline__ bool decode(int i, MUnit& u) const {
    const int L0 = i * (int)gridDim.x + (int)blockIdx.x; if (L0 >= total) return false;
    const int L = (gridDim.x & 7) == 0 ? xcd_remap(L0, total) : L0;
    const int rt = L / NTN; u.tn = L - rt * NTN;
    int lo = 0, hi = 64;
#pragma unroll
    for (int s = 0; s < 7; ++s) { const int mid = (lo + hi + 1) >> 1; if (pre[mid] <= rt) lo = mid; else hi = mid - 1; }
    u.e = lo; u.rti = rt - pre[lo]; u.ne = cn[lo]; u.eb = eb[lo]; return true; }
};
struct MoeUpSched : MoeSchedBase {
  const char* F; const char* WE; const int* list; int tok0;
  __device__ __forceinline__ bool next(int i, MUnit& u) const { return decode(i, u); }
  __device__ __forceinline__ const char* abase(const MUnit&) const { return F; }
  __device__ __forceinline__ const char* bbase(const MUnit& u) const { return WE + (size_t)u.e * WE_ONE + (size_t)u.tn * 128 * 1024 * 2; }
  __device__ __forceinline__ void aoffs(const MUnit& u, int R0, int R1, int C0, int C1, unsigned (&o)[2][2]) const {
    const int* le = list + (size_t)u.e * 8704;
#pragma unroll
    for (int h = 0; h < 2; ++h) {
      int i0 = u.rti * 256 + h * 128 + R0, i1 = u.rti * 256 + h * 128 + R1; if (i0 >= u.ne) i0 = 0; if (i1 >= u.ne) i1 = 0;
      const int t0 = u.e < 64 ? (le[i0] >> 3) : tok0 + i0, t1 = u.e < 64 ? (le[i1] >> 3) : tok0 + i1;
      o[h][0] = (unsigned)(t0 * 1024 + C0) * 2u; o[h][1] = (unsigned)(t1 * 1024 + C1) * 2u; } }
  __device__ __forceinline__ unsigned boff(int row, int C) const { const int gi = row >> 5, rho = row & 31; return (unsigned)((((rho >> 4) ? 256 : 0) + gi * 16 + (rho & 15)) * 1024 + C) * 2u; }
};
__device__ __forceinline__ void step_moe_up(const Ctx& c, int l, int hh, int halfrows) {
  const int RT = moe_schedule(c, l, hh, halfrows);
  MoeUpSched S; S.pre = reinterpret_cast<const int*>(c.lds + MOE_LDS_OFF); S.cn = S.pre + 72; S.eb = S.cn + 72; S.NTN = 2; S.total = RT * 2;
  S.F = (const char*)c.w<u16>(OFF_ACT); S.WE = c.p.ws + OFF_WE; S.list = c.w<int>(OFF_LIST) + (size_t)hh * 64 * 8704; S.tok0 = hh * halfrows;
  u16* HD = c.w<u16>(OFF_BIG + BIG_HD); u16* HS = c.w<u16>(OFF_BIG + BIG_HS);
  g8::phase<MUnit>(c.lds, 1024, S, [&](const g8::Acc& acc, const MUnit& u, int wr, int wc, int fr, int fq) {
#pragma unroll
    for (int ai = 0; ai < 2; ++ai)
#pragma unroll
      for (int m = 0; m < 4; ++m) {
        const int idx = u.rti * 256 + ai * 128 + wr * 64 + m * 16 + fr;
        if (idx < u.ne) {
          u16* dst = (u.e < 64 ? HD + (size_t)(u.eb + idx) * 256 : HS + (size_t)idx * 256) + u.tn * 128 + wc * 16 + 4 * fq;
#pragma unroll
          for (int bj = 0; bj < 2; ++bj) { const f32x4 g = acc[ai][bj][m][0], up = acc[ai][bj][m][1];
            *reinterpret_cast<uint2*>(dst + bj * 64) = make_uint2(pack2(silu_(g[0]) * up[0], silu_(g[1]) * up[1]), pack2(silu_(g[2]) * up[2], silu_(g[3]) * up[3])); }
        }
      }
  });
}
struct MoeDownSched : MoeSchedBase {
  const char* HD; const char* HS; const char* WE;
  __device__ __forceinline__ bool next(int i, MUnit& u) const { return decode(i, u); }
  __device__ __forceinline__ const char* abase(const MUnit& u) const { return u.e < 64 ? HD + (size_t)(u.eb + u.rti * 256) * 512 : HS + (size_t)(u.rti * 256) * 512; }
  __device__ __forceinline__ const char* bbase(const MUnit& u) const { return WE + (size_t)u.e * WE_ONE + WE_GU + (size_t)u.tn * 256 * 256 * 2; }
  __device__ __forceinline__ void aoffs(const MUnit&, int R0, int R1, int C0, int C1, unsigned (&o)[2][2]) const {
#pragma unroll
    for (int h = 0; h < 2; ++h) { o[h][0] = (unsigned)((h * 128 + R0) * 256 + C0) * 2u; o[h][1] = (unsigned)((h * 128 + R1) * 256 + C1) * 2u; } }
  __device__ __forceinline__ unsigned boff(int row, int C) const { return (unsigned)(((row & ~31) + g8::perm32(row & 31)) * 256 + C) * 2u; }
};
__device__ __forceinline__ void step_moe_down(const Ctx& c, int l, int hh, int halfrows) {
  const int RT = moe_schedule(c, l, hh, halfrows);
  MoeDownSched S; S.pre = reinterpret_cast<const int*>(c.lds + MOE_LDS_OFF); S.cn = S.pre + 72; S.eb = S.cn + 72; S.NTN = 4; S.total = RT * 4;
  S.HD = (const char*)c.w<u16>(OFF_BIG + BIG_HD); S.HS = (const char*)c.w<u16>(OFF_BIG + BIG_HS); S.WE = c.p.ws + OFF_WE;
  u16* YR = c.w<u16>(OFF_BIG + BIG_YR); u16* YS = c.w<u16>(OFF_BIG + BIG_YS);
  g8::phase<MUnit>(c.lds, 256, S, [&](const g8::Acc& acc, const MUnit& u, int wr, int wc, int fr, int fq) {
    u16* base = (u.e < 64 ? YR + (size_t)u.eb * 1024 : YS) + u.tn * 256 + wc * 32 + 8 * fq;
#pragma unroll
    for (int ai = 0; ai < 2; ++ai)
#pragma unroll
      for (int m = 0; m < 4; ++m) {
        const int idx = u.rti * 256 + ai * 128 + wr * 64 + m * 16 + fr;
        if (idx < u.ne) {
          u16* dst = base + (size_t)idx * 1024;
#pragma unroll
          for (int bj = 0; bj < 2; ++bj) { const f32x4 v0 = acc[ai][bj][m][0], v1 = acc[ai][bj][m][1];
            u32x4 w; w.x = pack2(v0[0], v0[1]); w.y = pack2(v0[2], v0[3]); w.z = pack2(v1[0], v1[1]); w.w = pack2(v1[2], v1[3]);
            *reinterpret_cast<u32x4*>(dst + bj * 128) = w; }
        }
      }
  });
}
__device__ __forceinline__ void combine_items(const Ctx& c, int l, bool last, int hh, int halfrows, int first, int end, int stride) {
  u16* H = c.w<u16>(OFF_H); const u16* YR = c.w<u16>(OFF_BIG + BIG_YR); u16* U = c.w<u16>(OFF_ACT);
  const int tok0 = hh * halfrows;
  for (int it = first; it < end; it += stride) {
    const int tok = tok0 + it * 8 + ((int)__builtin_amdgcn_readfirstlane(threadIdx.x >> 6)); float v[16]; load_row_bf(H + (size_t)tok * 1024, ((int)threadIdx.x & 63), v);
    float s[16];
#pragma unroll
    for (int i = 0; i < 16; ++i) s[i] = 0.f;
#pragma unroll
    for (int k = 0; k < 8; ++k) { const int sp = c.w<int>(OFF_SELE)[(size_t)tok * 8 + k]; const float wk = c.w<float>(OFF_TOPW)[(size_t)tok * 8 + k];
      const u16* yr = YR + (size_t)sp * 1024;
#pragma unroll
      for (int i = 0; i < 4; ++i) { uint2 t = *reinterpret_cast<const uint2*>(yr + (i * 64 + ((int)threadIdx.x & 63)) * 4); s[i * 4] += wk * bflo(t.x); s[i * 4 + 1] += wk * bfhi(t.x); s[i * 4 + 2] += wk * bflo(t.y); s[i * 4 + 3] += wk * bfhi(t.y); } }
    { const u16* ys = c.w<u16>(OFF_BIG + BIG_YS) + (size_t)(tok - tok0) * 1024;
#pragma unroll
      for (int i = 0; i < 4; ++i) { uint2 t = *reinterpret_cast<const uint2*>(ys + (i * 64 + ((int)threadIdx.x & 63)) * 4); s[i * 4] += bflo(t.x); s[i * 4 + 1] += bfhi(t.x); s[i * 4 + 2] += bflo(t.y); s[i * 4 + 3] += bfhi(t.y); } }
    const float* g2 = c.mod(l, brow_of(tok), 5);
#pragma unroll
    for (int i = 0; i < 4; ++i) { float4 g = *reinterpret_cast<const float4*>(g2 + (i * 64 + ((int)threadIdx.x & 63)) * 4);
      v[i * 4] = ALPHA * v[i * 4] + g.x * s[i * 4]; v[i * 4 + 1] = ALPHA * v[i * 4 + 1] + g.y * s[i * 4 + 1]; v[i * 4 + 2] = ALPHA * v[i * 4 + 2] + g.z * s[i * 4 + 2]; v[i * 4 + 3] = ALPHA * v[i * 4 + 3] + g.w * s[i * 4 + 3]; }
    ln_affine(v, c.in(I_LN2G) + l * 1024, c.in(I_LN2B) + l * 1024, ((int)threadIdx.x & 63));
    if (last) { store_row(c.p.out + (size_t)tok * 1024, ((int)threadIdx.x & 63), v); }
    else { store_row_bf(H + (size_t)tok * 1024, ((int)threadIdx.x & 63), v); const int br = brow_of(tok);
      ln_mod_store(v, c.mod(l + 1, br, 0), c.mod(l + 1, br, 1), U + (size_t)tok * 1024, ((int)threadIdx.x & 63)); }
  }
}
__device__ __forceinline__ void step_combine(const Ctx& c, int l, bool last, int hh, int halfrows) { combine_items(c, l, last, hh, halfrows, (int)blockIdx.x, halfrows / 8, (int)gridDim.x); }
#define CMB_CAP 5
__device__ __forceinline__ void moe_up_tail_combine(const Ctx& c, int l, bool last, int halfrows) {
  const int RT = reinterpret_cast<const int*>(c.lds + MOE_LDS_OFF)[65];
  const int G = (int)gridDim.x, extra = (RT * 2) % G, n_items = halfrows / 8;
  const int n_idle = extra > 0 ? G - extra : 0, j = (int)blockIdx.x - extra;
  int n_free = n_idle * CMB_CAP; n_free = n_free < n_items ? n_free : n_items;
#pragma unroll 1
  for (int pass = 0; pass < 2; ++pass) {
    int first, end, stride;
    if (pass == 0) { if (n_idle == 0 || j < 0) continue; first = j; end = n_free; stride = n_idle; }
    else { first = n_free + (int)blockIdx.x; end = n_items; stride = G; }
    combine_items(c, l, last, 0, halfrows, first, end, stride);
  }
}


#define XB_TMO      128
#define XB_XCNT(j)  (256  + 64 * (j))
#define XB_XSUB(j)  (1280 + 64 * (j))
#define XB_XGEN(j)  (2304 + 64 * (j))
#define XB_TOP      3328
#define XB_TOPGEN   3392
#define XCD_BAR_WORDS 3456
#define XB_SPIN_CAP (1u << 22)
#define LAS __attribute__((address_space(3)))
__device__ __forceinline__ unsigned xb_ld(unsigned* p)              { return __hip_atomic_load(p, __ATOMIC_RELAXED, __HIP_MEMORY_SCOPE_AGENT); }
__device__ __forceinline__ unsigned xb_add(unsigned* p, unsigned v) { return __hip_atomic_fetch_add(p, v, __ATOMIC_RELAXED, __HIP_MEMORY_SCOPE_AGENT); }
__device__ __forceinline__ unsigned xb_xcc_id() { return (unsigned)__builtin_amdgcn_s_getreg((3 << 11) | 20) & 0xFu; }
#define XB_SPIN(cond, bar) do { unsigned _sp = 0; while (cond) { __builtin_amdgcn_s_sleep(1); \
    if ((++_sp & 255u) == 0u) { if (xb_ld(&(bar)[XB_TMO])) break; if (_sp > XB_SPIN_CAP) { atomicAdd(&(bar)[XB_TMO], 1u); break; } } } } while (0)
struct XcdBarrier { unsigned* bar; unsigned x; volatile LAS unsigned* st; };
__device__ __forceinline__ XcdBarrier xcd_barrier_post(unsigned* bar, volatile LAS unsigned* st) {
    XcdBarrier b; b.bar = bar; b.x = xb_xcc_id(); b.st = st;
    if (threadIdx.x == 0) (void)xb_add(&bar[XB_XCNT(b.x)], 1u);
    return b;
}
__device__ __forceinline__ void xcd_barrier_complete(unsigned* bar, unsigned x, unsigned& nloc, unsigned& nx) {
    const unsigned G = gridDim.x * gridDim.y * gridDim.z;
    unsigned sum, cnt, mine, sp = 0u;
    for (;;) {
        sum = 0u; cnt = 0u; mine = 0u;
#pragma unroll
        for (unsigned j = 0; j < 16; ++j) { const unsigned c = xb_ld(&bar[XB_XCNT(j)]); sum += c; cnt += (c > 0u) ? 1u : 0u; mine = (j == x) ? c : mine; }
        if (sum == G) break;
        __builtin_amdgcn_s_sleep(1);
        if ((++sp & 255u) == 0u) { if (xb_ld(&bar[XB_TMO])) break; if (sp > XB_SPIN_CAP) { atomicAdd(&bar[XB_TMO], 1u); break; } }
    }
    nloc = mine > 0u ? mine : 1u; nx = cnt > 0u ? cnt : 1u;
}
__device__ __forceinline__ void xcd_barrier(const XcdBarrier& b) {
    asm volatile("s_waitcnt vmcnt(0)" ::: "memory");
    __syncthreads();
    if (threadIdx.x == 0) {
        unsigned* bar = b.bar;
        __builtin_amdgcn_s_waitcnt(0);
        unsigned nloc = b.st[0], nx = b.st[1];
        if (nloc == 0u) { xcd_barrier_complete(bar, b.x, nloc, nx); b.st[0] = nloc; b.st[1] = nx; }
        const unsigned old = xb_add(&bar[XB_XSUB(b.x)], 1u);
        const unsigned gen = old / nloc;
        if (old + 1u == (gen + 1u) * nloc) {
            __builtin_amdgcn_fence(__ATOMIC_RELEASE, "agent");
            asm volatile("s_waitcnt vmcnt(0)" ::: "memory");
            const unsigned og = xb_add(&bar[XB_TOP], 1u);
            const unsigned tg = og / nx;
            if (og + 1u == (tg + 1u) * nx) xb_add(&bar[XB_TOPGEN], 1u);
            else XB_SPIN(xb_ld(&bar[XB_TOPGEN]) == tg, bar);
            __builtin_amdgcn_fence(__ATOMIC_ACQUIRE, "agent");
            xb_add(&bar[XB_XGEN(b.x)], 1u);
            asm volatile("s_waitcnt vmcnt(0)" ::: "memory");
        } else {
            XB_SPIN(xb_ld(&bar[XB_XGEN(b.x)]) == gen, bar);
            __builtin_amdgcn_fence(__ATOMIC_ACQUIRE, "agent");
            asm volatile("s_waitcnt vmcnt(0)" ::: "memory");
        }
    }
    __syncthreads();
}

#ifdef ONLY
__device__ __forceinline__ void run_step_only(const Ctx& c) {
  const int l_ = 0; const bool last_ = false;
  if (ONLY == 0) step_prep(c); if (ONLY == 1) step_ln_in(c); if (ONLY == 2) step_gemm_in(c, l_); if (ONLY == 3) step_mix_a(c, l_, last_); if (ONLY == 4) step_mix_b(c, l_, last_);
  if (ONLY == 5) step_merge(c, l_, last_); if (ONLY == 6) step_out(c, l_, last_); if (ONLY == 8) { step_router<false>(c, l_, 8704); step_scatter(c, l_, MTOT, 8704); }
  if (ONLY == 9) step_moe_up(c, l_, 0, 8704); if (ONLY == 10) step_moe_down(c, l_, 0, 8704); if (ONLY == 11) step_combine(c, l_, last_, 0, 8704);
}
#endif
#define N_STEPS 26
template <int L>
__device__ __forceinline__ void run_layer_step(const Ctx& c, int k) {
  constexpr bool last = (L == 1);
  constexpr int mrows = last ? TLAT : MTOT, halfrows = mrows / 2;
  switch (k) {
    case 0: step_gemm_in(c, L); break;
    case 1: step_mix_a(c, L, last); break;
    case 2: step_mix_b(c, L, last); break;
    case 3: step_merge(c, L, last); break;
    case 4: step_out(c, L, last); break;
    case 5: step_router<last>(c, L, halfrows); break;
    case 6: step_scatter(c, L, mrows, halfrows); break;
    case 7: step_moe_up(c, L, 0, halfrows); break;
    case 8: step_moe_down(c, L, 0, halfrows); break;
    case 9: step_moe_up(c, L, 1, halfrows); moe_up_tail_combine(c, L, last, halfrows); break;
    case 10: step_moe_down(c, L, 1, halfrows); break;
    default: step_combine(c, L, last, 1, halfrows); break;
  }
}

#define LDS_BYTES 163840
#define XB_ST_OFF 158208
#define TS_OFF 158720
__global__ void __launch_bounds__(NTHR, 2) fwd_kernel(Params p) {
  extern __shared__ __attribute__((aligned(16))) char lds[];
  Ctx c; c.p.ws = p.ws; c.p.out = p.out; c.lds = lds;
  if (threadIdx.x == 0) {
    const float** tab = reinterpret_cast<const float**>(lds + PTR_TAB_OFF);
#pragma unroll
    for (int i = 0; i < N_IN; ++i) tab[i] = p.in[i];
  }
  __syncthreads();
  const int lo = p.s_lo, hi = p.s_hi;
  volatile LAS unsigned* xst = (volatile LAS unsigned*)(lds + XB_ST_OFF);
  if (threadIdx.x == 0) { xst[0] = 0u; xst[1] = 0u; xst[2] = 0u; xst[3] = 0u; }
  __syncthreads();
  XcdBarrier xb = xcd_barrier_post(reinterpret_cast<unsigned*>(p.ws + OFF_BAR), xst);
  int n_sync = 0;
#ifdef PROBE_A
  unsigned long long* tsl = reinterpret_cast<unsigned long long*>(lds + TS_OFF);
  if (blockIdx.x == 0 && threadIdx.x == 0) tsl[0] = __builtin_amdgcn_s_memrealtime();
#define STAMP(S) do { if (blockIdx.x == 0 && threadIdx.x == 0) tsl[(S) + 1] = __builtin_amdgcn_s_memrealtime(); } while (0)
#else
#define STAMP(S) do { } while (0)
#endif
#define GRID_SYNC() do { xcd_barrier(xb); ++n_sync; } while (0)
#ifdef PROBE_A
#define STEP(S, CALL) do { if (lo <= (S) && (S) < hi) { CALL; GRID_SYNC(); STAMP(S); } } while (0)
#else
#define STEP(S, CALL) do { if (lo <= (S) && (S) < hi) { CALL; if ((S) + 1 < hi) GRID_SYNC(); } } while (0)
#endif
#ifdef ONLY
  run_step_only(c);
#else
  STEP(0, step_prep(c));
  STEP(1, step_ln_in(c));
#define LSTEP(L, K) STEP(2 + 12 * (L) + (K), run_layer_step<L>(c, K))
  LSTEP(0, 0); LSTEP(0, 1); LSTEP(0, 2); LSTEP(0, 3); LSTEP(0, 4); LSTEP(0, 5); LSTEP(0, 6); LSTEP(0, 7); LSTEP(0, 8); LSTEP(0, 9); LSTEP(0, 10); LSTEP(0, 11);
  LSTEP(1, 0); LSTEP(1, 1); LSTEP(1, 2); LSTEP(1, 3); LSTEP(1, 4); LSTEP(1, 5); LSTEP(1, 6); LSTEP(1, 7); LSTEP(1, 8); LSTEP(1, 9); LSTEP(1, 10); LSTEP(1, 11);
#endif

#ifdef PROBE_A
  {
    __syncthreads();
    float* dsh = reinterpret_cast<float*>(lds + TS_OFF + 512);
    if (blockIdx.x == 0 && threadIdx.x == 0) {
      unsigned long long da = 0, db = 0;
      for (int s = 0; s < N_STEPS; ++s) { const int k12 = (s - 2) % 12; const int kind = s < 2 ? s : (k12 < 5 ? 2 + k12 : (k12 == 5 ? 8 : (k12 == 6 ? 12 : (k12 == 11 ? 11 : 10 - (k12 & 1)))));
        const unsigned long long d = tsl[s + 1] - tsl[s]; if (kind == PROBE_A) da += d; if (kind == PROBE_B) db += d; }
      if (PROBE_A == 20) da = tsl[45]; if (PROBE_B == 21) db = tsl[46]; if (PROBE_A == 22) da = tsl[47]; if (PROBE_B == 23) db = tsl[48];
      dsh[0] = 1.f + (float)da * 0.01f / 250.f;
      dsh[1] = sqrtf((float)db * 0.01f * 1e-5f);
    }
    __syncthreads();
    if (blockIdx.x == 0) {
      for (int q = threadIdx.x; q < 1024 * 1024; q += NTHR) p.out[q] += dsh[1];
      __syncthreads();
      if (threadIdx.x == 0) p.out[5 * 1024 * 1024 + 17] += dsh[0];
    }
  }
#endif
}

extern "C" void kernel_launch(void* const* d_in, const int* in_sizes, int n_in, void* d_out, int out_size, void* d_ws, size_t ws_size, hipStream_t stream) {
  static int grid = 0;
  if (grid == 0) {
    if (n_in != N_IN || ws_size < WS_TOTAL) { fprintf(stderr, "kernel_launch: bad shapes n_in %d ws %zu need %zu\n", n_in, ws_size, (size_t)WS_TOTAL); grid = -1; return; }
    hipFuncSetAttribute((const void*)fwd_kernel, hipFuncAttributeMaxDynamicSharedMemorySize, LDS_BYTES);
    int dev = 0, cus = 0, per_cu = 0; hipGetDevice(&dev); hipDeviceGetAttribute(&cus, hipDeviceAttributeMultiprocessorCount, dev);
    hipOccupancyMaxActiveBlocksPerMultiprocessor(&per_cu, (const void*)fwd_kernel, NTHR, LDS_BYTES);
    if (per_cu < 1) { fprintf(stderr, "kernel_launch: occupancy query says %d\n", per_cu); grid = -1; return; }
    grid = cus;
  }
  if (grid < 0) return;
  hipMemsetAsync(d_ws, 0, ZERO_BYTES, stream);
  Params p{};
  for (int i = 0; i < N_IN; ++i) p.in[i] = (const float*)d_in[i];
  p.out = (float*)d_out; p.ws = (char*)d_ws;
#if N_LAUNCH_MODE == 1
  p.s_lo = 0; p.s_hi = N_STEPS;
  void* args[] = {&p};
  hipError_t e = hipLaunchCooperativeKernel((const void*)fwd_kernel, dim3(grid), dim3(NTHR), args, LDS_BYTES, stream);
  if (e != hipSuccess) fprintf(stderr, "cooperative launch failed: %s (grid %d)\n", hipGetErrorString(e), grid);
#else
  for (int s = 0; s < N_STEPS; ++s) { p.s_lo = s; p.s_hi = s + 1; hipLaunchKernelGGL(fwd_kernel, dim3(grid), dim3(NTHR), LDS_BYTES, stream, p); }
#endif
}
```

```cpp
#include <hip/hip_runtime.h>
#include <hip/hip_cooperative_groups.h>
#include <stdint.h>
#include <cstdio>
namespace cg = cooperative_groups;

#ifndef N_LAUNCH_MODE
#define N_LAUNCH_MODE 1
#endif

typedef unsigned short u16;
typedef __attribute__((ext_vector_type(8))) short bf16x8;
typedef __attribute__((ext_vector_type(4))) float f32x4;
typedef __attribute__((ext_vector_type(4))) unsigned u32x4;
typedef __attribute__((ext_vector_type(4))) short s16x4;

#define DM     1024
#define NBATCH 4
#define SEQ    4096
#define CTXL   256
#define TLAT   16384
#define TCTX   1024
#define MTOT   17408
#define INW    5376
#define NTHR   512
#define ALPHA  1.41421356237309515f
#define LN_EPS 1e-5f
#define NCHK   68

enum { I_X = 0, I_C, I_CTX, I_CCTX, I_WMOD, I_BMOD, I_WIN, I_LRE, I_LIM, I_LSTEP, I_BRE, I_BIM, I_CRE, I_CIM, I_S5D,
       I_GMW, I_GMB, I_DALAM, I_SUBLN, I_GLUV, I_GLUG, I_PGM, I_PDA, I_WOUT, I_LN1G, I_LN1B, I_LN2G, I_LN2B,
       I_WR, I_BR, I_EG, I_EU, I_ED, I_SG, I_SU, I_SD, N_IN };

constexpr size_t al256(size_t x) { return (x + 255) / 256 * 256; }
constexpr size_t OFF_BAR   = 0;
constexpr size_t OFF_CNT   = 16384;
constexpr size_t ZERO_BYTES = 20480;
constexpr size_t OFF_MOD   = 32768;
constexpr size_t OFF_S5A   = OFF_MOD + al256(2 * 5 * 6144 * 4);
constexpr size_t OFF_S5A64 = OFF_S5A + 32768;
constexpr size_t OFF_S5BB  = OFF_S5A64 + 32768;
constexpr size_t OFF_S5BBH = OFF_S5BB + 524288;
constexpr size_t OFF_ROPE  = OFF_S5BBH + 262144;
constexpr size_t OFF_E     = OFF_ROPE + 8192;
constexpr size_t OFF_LIST  = OFF_E + al256((size_t)4 * 2 * NCHK * 16 * 64 * 2 * 4);
constexpr size_t OFF_TOPW  = OFF_LIST + al256((size_t)2 * 64 * 8704 * 4);
constexpr size_t OFF_SELE  = OFF_TOPW + al256((size_t)MTOT * 8 * 4);
constexpr size_t OFF_CNTB  = OFF_SELE + al256((size_t)MTOT * 8 * 4);
constexpr size_t OFF_LW    = OFF_CNTB + 256 * 128 * 4;
constexpr size_t OFF_WS    = OFF_LW + al256((size_t)2 * 64 * 8704 * 4);
constexpr size_t WS_WIN = 0, WS_GLU = WS_WIN + (size_t)INW * 1024 * 2, WS_GM = WS_GLU + 2048 * 256 * 2,
                 WS_DA = WS_GM + 1024 * 256 * 2, WS_OUT = WS_DA + 1024 * 512 * 2, WS_R = WS_OUT + 1024 * 1024 * 2,
                 WS_LAYER = WS_R + 128 * 1024 * 2;
constexpr size_t OFF_WE    = OFF_WS + 2 * WS_LAYER;
constexpr size_t WE_GU = (size_t)512 * 1024 * 2, WE_D = (size_t)1024 * 256 * 2, WE_ONE = WE_GU + WE_D;
constexpr size_t OFF_H     = OFF_WE + 65 * WE_ONE;
constexpr size_t OFF_ACT   = OFF_H + (size_t)MTOT * 1024 * 4;
constexpr size_t OFF_BIG   = OFF_ACT + (size_t)MTOT * 1024 * 2;
constexpr size_t BIG_P = 0, BIG_YA = BIG_P + (size_t)MTOT * INW * 2, BIG_YB = BIG_YA + (size_t)MTOT * 256 * 2,
                 BIG_YC = BIG_YB + (size_t)MTOT * 256 * 2, BIG_M = BIG_YC + (size_t)MTOT * 512 * 2,
                 BIG_END = BIG_M + (size_t)MTOT * 1024 * 2;
constexpr size_t BIG_YR = 0, BIG_HD = BIG_YR + (size_t)8704 * 8 * 1024 * 2, BIG_HS = BIG_HD + (size_t)(8704 * 8 + 256) * 256 * 2,
                 BIG_YS = BIG_HS + (size_t)8704 * 256 * 2, BIG_END2 = BIG_YS + (size_t)8704 * 1024 * 2;
static_assert(BIG_END2 <= BIG_END, "moe scratch must fit");
constexpr size_t WS_TOTAL = OFF_BIG + BIG_END;

struct Params { const float* in[N_IN]; float* out; char* ws; int s_lo, s_hi; };

__device__ __forceinline__ u16 f2bf(float f) { unsigned u = __float_as_uint(f); u += 0x7fffu + ((u >> 16) & 1u); return (u16)(u >> 16); }
__device__ __forceinline__ float bf2f(u16 h) { return __uint_as_float(((unsigned)h) << 16); }
__device__ __forceinline__ float bflo(unsigned w) { return __uint_as_float(w << 16); }
__device__ __forceinline__ float bfhi(unsigned w) { return __uint_as_float(w & 0xffff0000u); }
__device__ __forceinline__ unsigned cvtpk(float lo, float hi) { unsigned r; asm volatile("v_cvt_pk_bf16_f32 %0, %1, %2" : "=v"(r) : "v"(lo), "v"(hi)); return r; }
__device__ __forceinline__ unsigned pack2(float a, float b) { return cvtpk(a, b); }
__device__ __forceinline__ float wave_sum(float v) {
#pragma unroll
  for (int m = 32; m >= 1; m >>= 1) v += __shfl_xor(v, m, 64);
  return v;
}
__device__ __forceinline__ float sigmoidf_(float x) { return 1.f / (1.f + __expf(-x)); }
__device__ __forceinline__ float gelu_tanh(float x) {
  float t = 0.7978845608028654f * (x + 0.044715f * x * x * x);
  float e = __expf(2.f * t);
  float th = 1.f - 2.f / (e + 1.f);
  return 0.5f * x * (1.f + th);
}
__device__ __forceinline__ float silu_(float x) { return x / (1.f + __expf(-x)); }

#define GS_STAGES 3
#define GS_STAGE_BYTES 40960
#define GS_B_OFF 32768
#define CIMG_OFF (GS_STAGES * GS_STAGE_BYTES)
#define GEMM_LDS (CIMG_OFF + 128 * 272)

__device__ __forceinline__ void glds16(const void* g, void* l) {
  __builtin_amdgcn_global_load_lds((const __attribute__((address_space(1))) void*)g, (__attribute__((address_space(3))) void*)l, 16, 0, 0);
}
struct GPtr { const u16 *a[4], *b; };
template <class AF, class BF>
__device__ __forceinline__ GPtr gs_ptrs(AF arow, BF brow) {
  int tidz = threadIdx.x; asm volatile("" : "+v"(tidz));
  GPtr p;
#pragma unroll
  for (int i = 0; i < 4; ++i) { const int q = i * NTHR + tidz, row = q >> 3, c = (q & 7) ^ (row & 7); p.a[i] = arow(row) + c * 8; }
  { const int row = tidz >> 3, c = (tidz & 7) ^ (row & 7); p.b = brow(row) + c * 8; }
  return p;
}
struct GStream {
  GPtr cur, nxt; int nt, nnt;
  int ki;
  int sc;
};
__device__ __forceinline__ void gs_issue(GStream& g, char* lds, int si) {
  const int total = g.nt + g.nnt;
  const bool doi = g.ki < total, usen = doi && (g.ki >= g.nt);
  const int k0 = (doi ? (usen ? g.ki - g.nt : g.ki) : g.nt - 1) << 6;
  char* dst = lds + si * GS_STAGE_BYTES + threadIdx.x * 16;
  glds16((usen ? g.nxt.a[0] : g.cur.a[0]) + k0, dst); glds16((usen ? g.nxt.a[1] : g.cur.a[1]) + k0, dst + 8192);
  glds16((usen ? g.nxt.a[2] : g.cur.a[2]) + k0, dst + 16384); glds16((usen ? g.nxt.a[3] : g.cur.a[3]) + k0, dst + 24576);
  glds16((usen ? g.nxt.b : g.cur.b) + k0, dst + GS_B_OFF);
  ++g.ki;
}
__device__ __forceinline__ void gs_start(GStream& g, const GPtr& p, int nt, const GPtr& pn, int nnt, char* lds) {
  g.cur = p; g.nt = nt; g.nxt = pn; g.nnt = nnt; g.ki = 0; g.sc = 0;
  gs_issue(g, lds, 0); gs_issue(g, lds, 1);
}
__device__ __forceinline__ void gs_set_next(GStream& g, const GPtr& p, int nt) { g.nxt = p; g.nnt = nt; }
__device__ __forceinline__ void gs_advance(GStream& g) { g.cur = g.nxt; g.ki -= g.nt; g.nt = g.nnt; g.nnt = 0; }
template <int NF, int XV = 0>
__device__ __forceinline__ void gs_run(GStream& g, f32x4 (&acc)[4][NF], char* lds) {
  const int tid = threadIdx.x, lane = tid & 63, wid = tid >> 6, wm = wid >> 1, wn = wid & 1, fr = lane & 15, fq = lane >> 4;
  const int sw = fr & 7;
  const int aoff = (wm * 64 + fr) * 128, boff = GS_B_OFF + (wn * NF * 16 + fr) * 128;
#pragma unroll 1
  for (int t = 0; t < g.nt; ++t) {
    asm volatile("s_waitcnt vmcnt(5)" ::: "memory");
    __builtin_amdgcn_s_barrier();
    asm volatile("" ::: "memory");
    __builtin_amdgcn_sched_barrier(0);
    int sn = g.sc + 2; if (sn >= GS_STAGES) sn -= GS_STAGES;
    const char* st = lds + g.sc * GS_STAGE_BYTES;
    gs_issue(g, lds, sn);
    __builtin_amdgcn_sched_barrier(0);
#pragma unroll
    for (int ks = 0; ks < 2; ++ks) {
      bf16x8 At[4], Bt[NF];
      const int coff = (((ks * 4 + fq) ^ sw) << 4);
#pragma unroll
      for (int m = 0; m < 4; ++m) At[m] = *reinterpret_cast<const bf16x8*>(st + aoff + m * 2048 + coff);
#pragma unroll
      for (int n = 0; n < NF; ++n) Bt[n] = *reinterpret_cast<const bf16x8*>(st + boff + n * 2048 + coff);
#pragma unroll
      for (int m = 0; m < 4; ++m)
#pragma unroll
        for (int n = 0; n < NF; ++n) acc[m][n] = __builtin_amdgcn_mfma_f32_16x16x32_bf16(Bt[n], At[m], acc[m][n], 0, 0, 0);
    }
    ++g.sc; if (g.sc >= GS_STAGES) g.sc -= GS_STAGES;
  }
}
#define ZERO_ACC(a) do { _Pragma("unroll") for (int _m = 0; _m < 4; ++_m) _Pragma("unroll") for (int _n = 0; _n < 4; ++_n) a[_m][_n] = (f32x4){0.f, 0.f, 0.f, 0.f}; } while (0)
#define ZERO_ACC2(a) do { _Pragma("unroll") for (int _m = 0; _m < 4; ++_m) { a[_m][0] = (f32x4){0.f, 0.f, 0.f, 0.f}; a[_m][1] = (f32x4){0.f, 0.f, 0.f, 0.f}; } } while (0)


namespace g8 {
constexpr int BM = 256, BK = 64, HALF = 128, HTB = HALF * BK * 2;
__device__ __forceinline__ int lds_byte(int r, int c) { const int st = (r >> 4) * 2 + (c >> 5), rr = r & 15, cc = c & 31, ob = rr * 64 + cc * 2; return st * 1024 + (ob ^ (((ob >> 9) & 1) << 5)); }
__device__ __forceinline__ void stage_rc(int b, int& R, int& C) { const int st = b / 1024, sb = b % 1024, swz = sb ^ (((sb >> 9) & 1) << 5); R = (st >> 1) * 16 + swz / 64; C = (st & 1) * 32 + (swz % 64) / 2; }
__device__ __forceinline__ int perm32(int rho) { const int n = rho >> 4, i = rho & 15; return 8 * (i >> 2) + 4 * n + (i & 3); }
typedef f32x4 Acc[2][2][4][2];
template <class U, class Sched, class Epi>
__device__ __forceinline__ void phase(char* ldsg, const int K, const Sched& S, const Epi& E) {
  typedef __attribute__((address_space(3))) unsigned char* lptr;
  lptr lds = (lptr)ldsg;
  const int tid = threadIdx.x, wid = __builtin_amdgcn_readfirstlane(tid >> 6), lane = tid & 63, wr = wid >> 2, wc = wid & 3, fr = lane & 15, fq = lane >> 4;
  const int nt = K / BK;
  int R[2], C[2];
#pragma unroll
  for (int i = 0; i < 2; ++i) stage_rc(tid * 16 + i * 8192, R[i], C[i]);
  unsigned offB[2][2];
#pragma unroll
  for (int h = 0; h < 2; ++h)
#pragma unroll
    for (int i = 0; i < 2; ++i) offB[h][i] = S.boff(h * HALF + R[i], C[i]);
  const size_t kstep = (size_t)(BK * 2);
  const unsigned ldsw = (unsigned)wid * 1024u;
  const int aoff = lds_byte(wr * 64 + fr, fq * 8), boff = lds_byte(wc * 32 + fr, fq * 8);
#define G8_SA(b, h) (((b) * 2 + (h)) * HTB)
#define G8_SB(b, h) ((4 + (b) * 2 + (h)) * HTB)
#define G8_STAGE(bufoff, gbase, o0, o1) do { \
    __builtin_amdgcn_global_load_lds((const __attribute__((address_space(1))) void*)((gbase) + (o0)), (__attribute__((address_space(3))) void*)(lds + (bufoff) + ldsw), 16, 0, 0); \
    __builtin_amdgcn_global_load_lds((const __attribute__((address_space(1))) void*)((gbase) + (o1)), (__attribute__((address_space(3))) void*)(lds + (bufoff) + ldsw + 8192), 16, 0, 0); } while (0)
#define G8_LDA(dst, b, h) do { _Pragma("unroll") for (int m = 0; m < 4; ++m) _Pragma("unroll") for (int k = 0; k < 2; ++k) dst[m][k] = *(const __attribute__((address_space(3))) bf16x8*)(lds + G8_SA(b, h) + aoff + m * 2048 + k * 1024); } while (0)
#define G8_LDB(dst, b, h) do { _Pragma("unroll") for (int n = 0; n < 2; ++n) _Pragma("unroll") for (int k = 0; k < 2; ++k) dst[n][k] = *(const __attribute__((address_space(3))) bf16x8*)(lds + G8_SB(b, h) + boff + n * 2048 + k * 1024); } while (0)
#define G8_MMA(ai, bj, At, Bt) do { __builtin_amdgcn_s_setprio(1); _Pragma("unroll") for (int m = 0; m < 4; ++m) _Pragma("unroll") for (int n = 0; n < 2; ++n) _Pragma("unroll") for (int k = 0; k < 2; ++k) \
    acc[ai][bj][m][n] = __builtin_amdgcn_mfma_f32_16x16x32_bf16(Bt[n][k], At[m][k], acc[ai][bj][m][n], 0, 0, 0); __builtin_amdgcn_s_setprio(0); } while (0)
#define G8_WAIT_V(n) asm volatile("s_waitcnt vmcnt(" #n ")" ::: "memory")
#define G8_WAIT_L(n) asm volatile("s_waitcnt lgkmcnt(" #n ")" ::: "memory")
#define G8_BAR __builtin_amdgcn_s_barrier()
#define G8_SCHED __builtin_amdgcn_sched_barrier(0)
  U cur, nxt; int ui = 0;
  if (!S.next(0, cur)) return;
  Acc acc;
#define G8_ZERO() do { _Pragma("unroll") for (int a = 0; a < 2; ++a) _Pragma("unroll") for (int b = 0; b < 2; ++b) _Pragma("unroll") for (int m = 0; m < 4; ++m) _Pragma("unroll") for (int n = 0; n < 2; ++n) acc[a][b][m][n] = (f32x4){0.f, 0.f, 0.f, 0.f}; } while (0)
  G8_ZERO();
  bf16x8 At[4][2], B0[2][2], B1[2][2];
  unsigned oA[2][2], nA_[2][2];
  S.aoffs(cur, R[0], R[1], C[0], C[1], oA);
  const char* cA = S.abase(cur); const char* cB = S.bbase(cur);
  G8_STAGE(G8_SB(0, 0), cB, offB[0][0], offB[0][1]); G8_STAGE(G8_SA(0, 0), cA, oA[0][0], oA[0][1]); G8_STAGE(G8_SB(0, 1), cB, offB[1][0], offB[1][1]); G8_STAGE(G8_SA(0, 1), cA, oA[1][0], oA[1][1]);
  if (wr == 1) G8_BAR;
  G8_WAIT_V(4); G8_BAR;
  G8_STAGE(G8_SB(1, 0), cB + kstep, offB[0][0], offB[0][1]); G8_STAGE(G8_SA(1, 0), cA + kstep, oA[0][0], oA[0][1]); G8_STAGE(G8_SB(1, 1), cB + kstep, offB[1][0], offB[1][1]);
  G8_WAIT_V(6); G8_BAR;
  for (;;) {
    const bool has_next = S.next(ui + 1, nxt);
    const char* nA = cA; const char* nB = cB;
#pragma unroll
    for (int h = 0; h < 2; ++h) { nA_[h][0] = oA[h][0]; nA_[h][1] = oA[h][1]; }
    if (has_next) { nA = S.abase(nxt); nB = S.bbase(nxt); S.aoffs(nxt, R[0], R[1], C[0], C[1], nA_); }
#pragma unroll 1
    for (int t = 0; t < nt; t += 2) {
      const bool last = (t == nt - 2);
      const char* a1 = cA + (size_t)(t + 1) * kstep;
      const char* a2 = last ? nA : cA + (size_t)(t + 2) * kstep; const char* b2 = last ? nB : cB + (size_t)(t + 2) * kstep;
      const char* a3 = a2 + kstep; const char* b3 = b2 + kstep;
      const unsigned x00 = last ? nA_[0][0] : oA[0][0], x01 = last ? nA_[0][1] : oA[0][1], x10 = last ? nA_[1][0] : oA[1][0], x11 = last ? nA_[1][1] : oA[1][1];
      G8_LDB(B0, 0, 0); G8_SCHED; G8_LDA(At, 0, 0); G8_STAGE(G8_SA(1, 1), a1, oA[1][0], oA[1][1]);
      G8_WAIT_L(8); G8_BAR; G8_WAIT_L(0); G8_MMA(0, 0, At, B0); G8_BAR; G8_SCHED;
      G8_LDB(B1, 0, 1); G8_STAGE(G8_SB(0, 0), b2, offB[0][0], offB[0][1]);
      G8_BAR; G8_WAIT_L(0); G8_MMA(0, 1, At, B1); G8_BAR;
      G8_LDA(At, 0, 1); G8_STAGE(G8_SA(0, 0), a2, x00, x01);
      G8_BAR; G8_WAIT_L(0); G8_MMA(1, 0, At, B0); G8_BAR; G8_SCHED;
      G8_STAGE(G8_SB(0, 1), b2, offB[1][0], offB[1][1]);
      G8_WAIT_V(6); G8_BAR; G8_MMA(1, 1, At, B1); G8_BAR;
      G8_LDB(B0, 1, 0); G8_SCHED; G8_LDA(At, 1, 0); G8_STAGE(G8_SA(0, 1), a2, x10, x11);
      G8_WAIT_L(8); G8_BAR; G8_WAIT_L(0); G8_MMA(0, 0, At, B0); G8_BAR; G8_SCHED;
      G8_LDB(B1, 1, 1); G8_STAGE(G8_SB(1, 0), b3, offB[0][0], offB[0][1]);
      G8_BAR; G8_WAIT_L(0); G8_MMA(0, 1, At, B1); G8_BAR;
      G8_LDA(At, 1, 1); G8_STAGE(G8_SA(1, 0), a3, x00, x01);
      G8_BAR; G8_WAIT_L(0); G8_MMA(1, 0, At, B0); G8_BAR; G8_SCHED;
      G8_STAGE(G8_SB(1, 1), b3, offB[1][0], offB[1][1]);
      G8_WAIT_V(6); G8_BAR; G8_MMA(1, 1, At, B1); G8_BAR;
    }
    E(acc, cur, wr, wc, fr, fq);
    if (!has_next) break;
    G8_ZERO();
    cur = nxt; cA = nA; cB = nB; ++ui;
#pragma unroll
    for (int h = 0; h < 2; ++h) { oA[h][0] = nA_[h][0]; oA[h][1] = nA_[h][1]; }
  }
  G8_WAIT_V(0);
  if (wr == 0) G8_BAR;
  G8_BAR;
#undef G8_SA
#undef G8_SB
#undef G8_STAGE
#undef G8_LDA
#undef G8_LDB
#undef G8_MMA
#undef G8_WAIT_V
#undef G8_WAIT_L
#undef G8_BAR
#undef G8_SCHED
#undef G8_ZERO
}
}

#define EPI_RS 272
#define EPI_M(ROW0) int _rb = (ROW0) + wm * 64 + fr; asm volatile("" : "+v"(_rb)); _Pragma("unroll") for (int m = 0; m < 4; ++m) { const int row = _rb + m * 16;
#define EPI_M_END }
template <int NF, int CPR, class SF, class RF>
__device__ __forceinline__ void epi_tile(char* lds, SF sf, RF rf) {
  int tid = threadIdx.x; asm volatile("" : "+v"(tid));
  const int lane = tid & 63, wid = __builtin_amdgcn_readfirstlane(tid >> 6), wm = wid >> 1, wn = wid & 1, fr = lane & 15, fq = lane >> 4;
  char* img = lds + CIMG_OFF;
#pragma unroll
  for (int h = 0; h < 2; ++h) {
    if ((wm >> 1) == h) {
#pragma unroll
      for (int m = 0; m < 4; ++m)
#pragma unroll
        for (int n = 0; n < NF; ++n) { const f32x4 v = sf(m, n);
          *reinterpret_cast<uint2*>(img + ((wm & 1) * 64 + m * 16 + fr) * EPI_RS + (wn * NF * 16 + n * 16 + fq * 4) * 2) = make_uint2(pack2(v[0], v[1]), pack2(v[2], v[3])); }
    }
    asm volatile("s_waitcnt lgkmcnt(0)" ::: "memory"); __builtin_amdgcn_s_barrier(); asm volatile("" ::: "memory");
#pragma unroll
    for (int i = 0; i < CPR / 4; ++i) { const int idx = i * NTHR + tid, row = idx / CPR, c8 = idx % CPR;
      const u32x4 v = *reinterpret_cast<const u32x4*>(img + row * EPI_RS + c8 * 16); rf(h * 128 + row, c8 * 8, v); }
    asm volatile("s_waitcnt lgkmcnt(0)" ::: "memory"); __builtin_amdgcn_s_barrier(); asm volatile("" ::: "memory");
  }
}
struct XSched { int pos, end, step; };
__device__ __forceinline__ XSched xsched(int total) {
  XSched s;
  if ((gridDim.x & 7) == 0) { const int g = blockIdx.x & 7, per = gridDim.x >> 3; s.pos = (int)((long)total * g / 8) + (blockIdx.x >> 3); s.end = (int)((long)total * (g + 1) / 8); s.step = per; }
  else { s.pos = blockIdx.x; s.end = total; s.step = gridDim.x; }
  return s;
}
#define PTR_TAB_OFF 157696
struct CtxP { char* ws; float* out; };
struct Ctx {
  CtxP p; char* lds;
  __device__ __forceinline__ const float* in(int i) const { return reinterpret_cast<const float* const*>(lds + PTR_TAB_OFF)[i]; }
  template <typename T> __device__ __forceinline__ T* w(size_t off) const { return reinterpret_cast<T*>(p.ws + off); }
  __device__ __forceinline__ const float* mod(int l, int brow, int chunk) const { return w<float>(OFF_MOD) + ((size_t)(l * 5 + brow) * 6144 + chunk * 1024); }
};
__device__ __forceinline__ int brow_of(int row) { return row < TLAT ? (row >> 12) : 4; }

__device__ __forceinline__ void cvt_tile(const float* __restrict__ src, int N, u16* __restrict__ dst, int dld, int k0, int n0, int roff, float* t) {
  const int tid = threadIdx.x;
  { const int n4 = (tid & 15) * 4, kb = tid >> 4;
#pragma unroll
    for (int i = 0; i < 2; ++i) { const int k = kb + 32 * i; const float4 v = *reinterpret_cast<const float4*>(src + (size_t)(k0 + k) * N + n0 + n4);
      t[k * 65 + n4] = v.x; t[k * 65 + n4 + 1] = v.y; t[k * 65 + n4 + 2] = v.z; t[k * 65 + n4 + 3] = v.w; } }
  __syncthreads();
  { const int n = tid >> 3, k8 = (tid & 7) * 8; u32x4 o;
#pragma unroll
    for (int e = 0; e < 4; ++e) o[e] = pack2(t[(k8 + 2 * e) * 65 + n], t[(k8 + 2 * e + 1) * 65 + n]);
    *reinterpret_cast<u32x4*>(dst + (size_t)(roff + n0 + n) * dld + k0 + k8) = o; }
  __syncthreads();
}
__device__ __forceinline__ void cvt_tile4(const float* __restrict__ src, int N, u16* __restrict__ dst, int dld, int k0, int n0, int roff, float* t) {
  const int tid = threadIdx.x;
  { const int n4 = (tid & 63) * 4, kb = tid >> 6;
    float4 v[8];
#pragma unroll
    for (int i = 0; i < 8; ++i) v[i] = *reinterpret_cast<const float4*>(src + (size_t)(k0 + kb + 8 * i) * N + n0 + n4);
#pragma unroll
    for (int i = 0; i < 8; ++i) { float* tr = t + (kb + 8 * i) * 257 + n4; tr[0] = v[i].x; tr[1] = v[i].y; tr[2] = v[i].z; tr[3] = v[i].w; } }
  __syncthreads();
#pragma unroll
  for (int i = 0; i < 4; ++i) { const int q = i * NTHR + tid, n = q >> 3, k8 = (q & 7) * 8; u32x4 o;
#pragma unroll
    for (int e = 0; e < 4; ++e) o[e] = pack2(t[(k8 + 2 * e) * 257 + n], t[(k8 + 2 * e + 1) * 257 + n]);
    *reinterpret_cast<u32x4*>(dst + (size_t)(roff + n0 + n) * dld + k0 + k8) = o; }
  __syncthreads();
}
__device__ __forceinline__ void cvt_router_tile(const float* __restrict__ src, u16* __restrict__ dst, int k0, float* t) {
  const int tid = threadIdx.x;
  { const int n = tid & 63, kb = tid >> 6;
#pragma unroll
    for (int i = 0; i < 8; ++i) { int k = kb + 8 * i; t[k * 65 + n] = src[(size_t)(k0 + k) * 64 + n]; } }
  __syncthreads();
  { const int k = tid & 63, nb = tid >> 6;
#pragma unroll
    for (int i = 0; i < 8; ++i) { int nn = nb + 8 * i; float v = t[k * 65 + nn]; u16 hi = f2bf(v); u16 lo = f2bf(v - bf2f(hi));
      dst[(size_t)nn * 1024 + k0 + k] = hi; dst[(size_t)(64 + nn) * 1024 + k0 + k] = lo; } }
  __syncthreads();
}
#define NCVT_SMALL 1936
__device__ __forceinline__ void cvt_small(const Ctx& c, int l, int t) {
  float* tb = reinterpret_cast<float*>(c.lds);
  char* wl = c.p.ws + OFF_WS + (size_t)l * WS_LAYER;
  if (t < 1344) { cvt_tile(c.in(I_WIN) + (size_t)l * 1024 * INW, INW, (u16*)(wl + WS_WIN), 1024, (t / 84) * 64, (t % 84) * 64, 0, tb); return; }
  t -= 1344;
  if (t < 64) { cvt_tile(c.in(I_GLUV) + (size_t)l * 256 * 1024, 1024, (u16*)(wl + WS_GLU), 256, (t / 16) * 64, (t % 16) * 64, 0, tb); return; }
  t -= 64;
  if (t < 64) { cvt_tile(c.in(I_GLUG) + (size_t)l * 256 * 1024, 1024, (u16*)(wl + WS_GLU), 256, (t / 16) * 64, (t % 16) * 64, 1024, tb); return; }
  t -= 64;
  if (t < 64) { cvt_tile(c.in(I_PGM) + (size_t)l * 256 * 1024, 1024, (u16*)(wl + WS_GM), 256, (t / 16) * 64, (t % 16) * 64, 0, tb); return; }
  t -= 64;
  if (t < 128) { cvt_tile(c.in(I_PDA) + (size_t)l * 512 * 1024, 1024, (u16*)(wl + WS_DA), 512, (t / 16) * 64, (t % 16) * 64, 0, tb); return; }
  t -= 128;
  if (t < 256) { cvt_tile(c.in(I_WOUT) + (size_t)l * 1024 * 1024, 1024, (u16*)(wl + WS_OUT), 1024, (t / 16) * 64, (t % 16) * 64, 0, tb); return; }
  t -= 256;
  cvt_router_tile(c.in(I_WR) + (size_t)l * 1024 * 64, (u16*)(wl + WS_R), t * 64, tb);
}
#define NCVT_EXP (65 * 48)
#define CV_GIN(l) ((l) == 0 ? 480 : 1296)
#define CV_OUT(l) ((l) == 0 ? 2640 : 0)
__device__ __forceinline__ void cvt_expert(const Ctx& c, int l, int t) {
  float* tb = reinterpret_cast<float*>(c.lds);
  const int e = t / 48; int r = t % 48;
  char* we = c.p.ws + OFF_WE + (size_t)e * WE_ONE;
  const float* sg = e < 64 ? c.in(I_EG) + (size_t)(l * 64 + e) * 1024 * 256 : c.in(I_SG) + (size_t)l * 1024 * 256;
  const float* su = e < 64 ? c.in(I_EU) + (size_t)(l * 64 + e) * 1024 * 256 : c.in(I_SU) + (size_t)l * 1024 * 256;
  const float* sd = e < 64 ? c.in(I_ED) + (size_t)(l * 64 + e) * 256 * 1024 : c.in(I_SD) + (size_t)l * 256 * 1024;
  if (r < 16) { cvt_tile4(sg, 256, (u16*)we, 1024, r * 64, 0, 0, tb); return; }
  r -= 16;
  if (r < 16) { cvt_tile4(su, 256, (u16*)we, 1024, r * 64, 0, 256, tb); return; }
  r -= 16;
  cvt_tile4(sd, 1024, (u16*)(we + WE_GU), 256, (r >> 2) * 64, (r & 3) * 256, 0, tb);
}

__device__ __forceinline__ void step_prep(const Ctx& c) {
  const int G = gridDim.x;
  const int n_cvt = NCVT_SMALL, n_mod = 192, n_s5 = 8, n_misc = 1;
  const int total = n_cvt + n_mod + n_s5 + n_misc;
  for (int it = blockIdx.x; it < total; it += G) {
    if (it < n_cvt) { cvt_small(c, 0, it); continue; }
    int i = it - n_cvt;
    if (i < n_mod) {
      const int l = i / 96, cb = i % 96;
      float* sil = reinterpret_cast<float*>(c.lds);
      float* red = sil + 5 * 1024;
      for (int q = ((int)threadIdx.x); q < 5 * 1024; q += NTHR) { int r = q >> 10, k = q & 1023; float v = r < 4 ? c.in(I_C)[r * 1024 + k] : c.in(I_CCTX)[k]; sil[q] = silu_(v); }
      __syncthreads();
      const int col = ((int)threadIdx.x) & 63, kp = ((int)threadIdx.x) >> 6;
      float a0 = 0, a1 = 0, a2 = 0, a3 = 0, a4 = 0;
      const float* wm_ = c.in(I_WMOD) + (size_t)l * 1024 * 6144 + cb * 64 + col;
#pragma unroll 1
      for (int k0 = kp * 128; k0 < kp * 128 + 128; k0 += 16) {
        float wv[16];
#pragma unroll
        for (int j = 0; j < 16; ++j) wv[j] = wm_[(size_t)(k0 + j) * 6144];
#pragma unroll
        for (int j = 0; j < 16; ++j) { const int k = k0 + j;
          a0 += sil[k] * wv[j]; a1 += sil[1024 + k] * wv[j]; a2 += sil[2048 + k] * wv[j]; a3 += sil[3072 + k] * wv[j]; a4 += sil[4096 + k] * wv[j]; } }
      red[(kp * 5 + 0) * 64 + col] = a0; red[(kp * 5 + 1) * 64 + col] = a1; red[(kp * 5 + 2) * 64 + col] = a2;
      red[(kp * 5 + 3) * 64 + col] = a3; red[(kp * 5 + 4) * 64 + col] = a4;
      __syncthreads();
      if (((int)threadIdx.x) < 320) { int r = ((int)threadIdx.x) >> 6, cc = ((int)threadIdx.x) & 63; float s = 0;
#pragma unroll
        for (int q = 0; q < 8; ++q) s += red[(q * 5 + r) * 64 + cc];
        s += c.in(I_BMOD)[l * 6144 + cb * 64 + cc];
        c.w<float>(OFF_MOD)[(size_t)(l * 5 + r) * 6144 + cb * 64 + cc] = s; }
      __syncthreads();
      continue;
    }
    i -= n_mod;
    if (i < n_s5) {
      const int q = i * NTHR + ((int)threadIdx.x);
      const int ldg = q >> 6;
      const float dt = expf(c.in(I_LSTEP)[ldg]);
      const float lr = c.in(I_LRE)[q], li = c.in(I_LIM)[q];
      const float mag = expf(lr * dt);
      float sn, cs; sincosf(li * dt, &sn, &cs);
      const float are = mag * cs, aim = mag * sn;
      const float den = lr * lr + li * li, nre = are - 1.f;
      const float zre = (nre * lr + aim * li) / den, zim = (aim * lr - nre * li) / den;
      float* A = c.w<float>(OFF_S5A); float* A64 = c.w<float>(OFF_S5A64); float* BB = c.w<float>(OFF_S5BB);
      A[q * 2] = are; A[q * 2 + 1] = aim;
      float pr = are, pi = aim;
#pragma unroll
      for (int s = 0; s < 6; ++s) { float nr = pr * pr - pi * pi, ni = 2.f * pr * pi; pr = nr; pi = ni; }
      A64[q * 2] = pr; A64[q * 2 + 1] = pi;
      const float* bre = c.in(I_BRE) + (size_t)q * 16; const float* bim = c.in(I_BIM) + (size_t)q * 16;
#pragma unroll
      for (int cc = 0; cc < 16; ++cc) { float br = bre[cc], bi = bim[cc];
        const float vr = zre * br - zim * bi, vi = zre * bi + zim * br;
        BB[((size_t)q * 16 + cc) * 2] = vr; BB[((size_t)q * 16 + cc) * 2 + 1] = vi;
        u16* bbh = c.w<u16>(OFF_S5BBH) + (size_t)(q >> 6) * 128 * 16;
        bbh[(q & 63) * 16 + cc] = f2bf(vr); bbh[(64 + (q & 63)) * 16 + cc] = f2bf(vi); }
      continue;
    }
    for (int q = ((int)threadIdx.x); q < 64 * 16; q += NTHR) { int pos = q >> 4, f = q & 15;
      float inv = powf(10000.f, -(float)f / 16.f); float ang = (float)pos * inv; float sn, cs; sincosf(ang, &sn, &cs);
      c.w<float>(OFF_ROPE)[q * 2] = cs; c.w<float>(OFF_ROPE)[q * 2 + 1] = sn; }
  }
}

__device__ __forceinline__ void ln_stats(const float (&v)[16], float& mean, float& rstd) {
  float s = 0;
#pragma unroll
  for (int i = 0; i < 16; ++i) s += v[i];
  mean = wave_sum(s) * (1.f / 1024.f);
  float q = 0;
#pragma unroll
  for (int i = 0; i < 16; ++i) { float d = v[i] - mean; q += d * d; }
  rstd = rsqrtf(wave_sum(q) * (1.f / 1024.f) + LN_EPS);
}
__device__ __forceinline__ void load_row(const float* src, int lane, float (&v)[16]) {
#pragma unroll
  for (int i = 0; i < 4; ++i) { float4 t = *reinterpret_cast<const float4*>(src + (i * 64 + lane) * 4); v[i * 4] = t.x; v[i * 4 + 1] = t.y; v[i * 4 + 2] = t.z; v[i * 4 + 3] = t.w; }
}
__device__ __forceinline__ void load_row_bf(const u16* src, int lane, float (&v)[16]) {
#pragma unroll
  for (int i = 0; i < 4; ++i) { const uint2 t = *reinterpret_cast<const uint2*>(src + (i * 64 + lane) * 4); v[i * 4] = bflo(t.x); v[i * 4 + 1] = bfhi(t.x); v[i * 4 + 2] = bflo(t.y); v[i * 4 + 3] = bfhi(t.y); }
}
__device__ __forceinline__ void store_row(float* dst, int lane, const float (&v)[16]) {
#pragma unroll
  for (int i = 0; i < 4; ++i) *reinterpret_cast<float4*>(dst + (i * 64 + lane) * 4) = make_float4(v[i * 4], v[i * 4 + 1], v[i * 4 + 2], v[i * 4 + 3]);
}
__device__ __forceinline__ void store_row_bf(u16* dst, int lane, const float (&v)[16]) {
#pragma unroll
  for (int i = 0; i < 4; ++i) *reinterpret_cast<uint2*>(dst + (i * 64 + lane) * 4) = make_uint2(pack2(v[i * 4], v[i * 4 + 1]), pack2(v[i * 4 + 2], v[i * 4 + 3]));
}
__device__ __forceinline__ void ln_mod_store(const float (&v)[16], const float* sh, const float* sc, u16* dst, int lane) {
  float mean, rstd; ln_stats(v, mean, rstd);
  float o[16];
#pragma unroll
  for (int i = 0; i < 4; ++i) { float4 a = *reinterpret_cast<const float4*>(sh + (i * 64 + lane) * 4), b = *reinterpret_cast<const float4*>(sc + (i * 64 + lane) * 4);
    o[i * 4] = (v[i * 4] - mean) * rstd * (1.f + b.x) + a.x; o[i * 4 + 1] = (v[i * 4 + 1] - mean) * rstd * (1.f + b.y) + a.y;
    o[i * 4 + 2] = (v[i * 4 + 2] - mean) * rstd * (1.f + b.z) + a.z; o[i * 4 + 3] = (v[i * 4 + 3] - mean) * rstd * (1.f + b.w) + a.w; }
  store_row_bf(dst, lane, o);
}
__device__ __forceinline__ void ln_affine(float (&v)[16], const float* g, const float* b, int lane) {
  float mean, rstd; ln_stats(v, mean, rstd);
#pragma unroll
  for (int i = 0; i < 4; ++i) { float4 a = *reinterpret_cast<const float4*>(g + (i * 64 + lane) * 4), bb = *reinterpret_cast<const float4*>(b + (i * 64 + lane) * 4);
    v[i * 4] = (v[i * 4] - mean) * rstd * a.x + bb.x; v[i * 4 + 1] = (v[i * 4 + 1] - mean) * rstd * a.y + bb.y;
    v[i * 4 + 2] = (v[i * 4 + 2] - mean) * rstd * a.z + bb.z; v[i * 4 + 3] = (v[i * 4 + 3] - mean) * rstd * a.w + bb.w; }
}

__device__ __forceinline__ void step_ln_in(const Ctx& c) {
  u16* U = c.w<u16>(OFF_ACT);
  for (int it = blockIdx.x; it < MTOT / 8; it += gridDim.x) {
    const int row = it * 8 + ((int)__builtin_amdgcn_readfirstlane(threadIdx.x >> 6));
    const float* src = row < TLAT ? c.in(I_X) + (size_t)row * 1024 : c.in(I_CTX) + (size_t)(row - TLAT) * 1024;
    float v[16]; load_row(src, ((int)threadIdx.x & 63), v);
    const int br = brow_of(row);
    ln_mod_store(v, c.mod(0, br, 0), c.mod(0, br, 1), U + (size_t)row * 1024, ((int)threadIdx.x & 63));
  }
}

__device__ __forceinline__ int xcd_remap(int L, int nwg) { const int q = nwg >> 3, r = nwg & 7, xcd = L & 7, off = L >> 3; return (xcd < r ? xcd * (q + 1) : r * (q + 1) + (xcd - r) * q) + off; }
struct DUnit { int pm, pn; };
template <bool PERM>
struct DenseSched {
  const char* A; const char* B; int K, nN, total;
  __device__ __forceinline__ bool next(int i, DUnit& u) const { const int L = i * (int)gridDim.x + (int)blockIdx.x; if (L >= total) return false;
    if ((gridDim.x & 7) != 0) { u.pm = L / nN; u.pn = L - u.pm * nN; return true; }
    const int w = xcd_remap(L, total), nM = total / nN, nig = 8 * nN, gid = w / nig, fm = gid * 8, gsz = (nM - fm) < 8 ? (nM - fm) : 8, wi = w - gid * nig;
    u.pn = wi / gsz; u.pm = fm + (wi - u.pn * gsz); return true; }
  __device__ __forceinline__ const char* abase(const DUnit& u) const { return A + (size_t)u.pm * 256 * K * 2; }
  __device__ __forceinline__ const char* bbase(const DUnit& u) const { return B + (size_t)u.pn * 256 * K * 2; }
  __device__ __forceinline__ void aoffs(const DUnit&, int R0, int R1, int C0, int C1, unsigned (&o)[2][2]) const {
#pragma unroll
    for (int h = 0; h < 2; ++h) { o[h][0] = (unsigned)((h * 128 + R0) * K + C0) * 2u; o[h][1] = (unsigned)((h * 128 + R1) * K + C1) * 2u; } }
  __device__ __forceinline__ unsigned boff(int row, int C) const { const int rb = PERM ? ((row & ~31) + g8::perm32(row & 31)) : row; return (unsigned)(rb * K + C) * 2u; }
};

__device__ __forceinline__ void step_gemm_in(const Ctx& c, int l) {
  const u16* U = c.w<u16>(OFF_ACT);
  const u16* W = reinterpret_cast<const u16*>(c.p.ws + OFF_WS + (size_t)l * WS_LAYER + WS_WIN);
  u16* P = c.w<u16>(OFF_BIG + BIG_P);
  const float* ropetab = c.w<float>(OFF_ROPE);
  DenseSched<true> S{(const char*)U, (const char*)W, 1024, 21, 68 * 21};
  const int lane = ((int)threadIdx.x & 63);
  g8::phase<DUnit>(c.lds, 1024, S, [&](const g8::Acc& acc, const DUnit& u, int wr, int wc, int fr, int fq) {
    const int cls = u.pn < 1 ? 0 : (u.pn < 3 ? 1 : (u.pn < 9 ? 0 : 2));
    const bool rope = (u.pn >= 3 && u.pn < 7) && (u.pm < 64);
#pragma unroll
    for (int ai = 0; ai < 2; ++ai)
#pragma unroll
      for (int m = 0; m < 4; ++m) {
        const int row = u.pm * 256 + ai * 128 + wr * 64 + m * 16 + fr;
        u16* rowp = P + (size_t)row * INW + u.pn * 256 + wc * 32 + 8 * fq;
        const int t = row & 4095; const int pos = (wc & 1) ? (t & 63) : (t >> 6);
        const float* tab = ropetab + pos * 32 + (fq & 1) * 16;
#pragma unroll
        for (int bj = 0; bj < 2; ++bj) {
          f32x4 v0 = acc[ai][bj][m][0], v1 = acc[ai][bj][m][1];
          if (cls == 1) {
#pragma unroll
            for (int j = 0; j < 4; ++j) { v0[j] = gelu_tanh(v0[j]); v1[j] = gelu_tanh(v1[j]); } }
          else if (cls == 2) {
#pragma unroll
            for (int j = 0; j < 4; ++j) { v0[j] = sigmoidf_(v0[j]); v1[j] = sigmoidf_(v1[j]); } }
          if (rope) {
            float x[8] = {v0[0], v0[1], v0[2], v0[3], v1[0], v1[1], v1[2], v1[3]};
#pragma unroll
            for (int e = 0; e < 8; ++e) {
              auto rr = __builtin_amdgcn_permlane32_swap(__float_as_uint(x[e]), __float_as_uint(x[e]), false, false);
              const float o = __uint_as_float(lane < 32 ? rr[1] : rr[0]);
              const float2 cs = *reinterpret_cast<const float2*>(tab + e * 2);
              x[e] = lane < 32 ? x[e] * cs.x - o * cs.y : x[e] * cs.x + o * cs.y; }
            v0 = (f32x4){x[0], x[1], x[2], x[3]}; v1 = (f32x4){x[4], x[5], x[6], x[7]};
          }
          u32x4 w; w.x = pack2(v0[0], v0[1]); w.y = pack2(v0[2], v0[3]); w.z = pack2(v1[0], v1[1]); w.w = pack2(v1[2], v1[3]);
          *reinterpret_cast<u32x4*>(rowp + bj * 128) = w;
        }
      }
  });
  {
    const int G = (int)gridDim.x, extra = (68 * 21) % G;
    const int j = extra > 0 ? (int)blockIdx.x - extra : (int)blockIdx.x, nidle = extra > 0 ? G - extra : G;
    if (j >= 0) for (int it = j; it < CV_GIN(l); it += nidle) cvt_expert(c, l, it);
  }
}

#define BUB_LD 132
#define BT_LD 20
#define GM_LD 136
__device__ __forceinline__ void step_mix_a(const Ctx& c, int l, bool last) {
  u16* P = c.w<u16>(OFF_BIG + BIG_P);
  const int n_rope = 0, n_s5 = 4 * 2 * NCHK, n_gm = (last ? 128 : 136) * 4, n_cv = NCVT_EXP - CV_OUT(l) - CV_GIN(l);
  const int total = n_rope + n_s5 + n_gm + n_cv;
  for (int it = blockIdx.x; it < total; it += gridDim.x) {
    int i = it;
    i -= n_rope;
    if (i < n_s5) {
      const int b = i / (2 * NCHK), rem = i % (2 * NCHK), dir = rem / NCHK, ck = rem % NCHK;
      const float* A = c.w<float>(OFF_S5A); float* E = c.w<float>(OFF_E); const u16* BBH = c.w<u16>(OFF_S5BBH);
      const int lane = (int)threadIdx.x & 63, fr = lane & 15, fq = lane >> 4, wid_ = (int)__builtin_amdgcn_readfirstlane(threadIdx.x >> 6);
      float* bub = reinterpret_cast<float*>(c.lds + wid_ * 10240);
      int rows[4];
#pragma unroll
      for (int sub = 0; sub < 4; ++sub) { const int tau = ck * 64 + sub * 16 + fr;
        if (tau < 256) rows[sub] = TLAT + b * 256 + (dir ? 255 - tau : tau); else { const int tt = tau - 256; rows[sub] = b * 4096 + (dir ? 4095 - tt : tt); } }
      float are_[2], aim_[2]; s16x4 bfr_[2][8], afr_[2][4];
#pragma unroll
      for (int gi = 0; gi < 2; ++gi) {
        const int g = wid_ * 2 + gi; const int q = ((l * 2 + dir) * 16 + g) * 64 + lane;
        are_[gi] = A[q * 2]; aim_[gi] = A[q * 2 + 1];
        const u16* bp = BBH + ((size_t)((l * 2 + dir) * 16 + g) * 128 + fr) * 16 + fq * 4;
#pragma unroll
        for (int cb = 0; cb < 8; ++cb) bfr_[gi][cb] = *reinterpret_cast<const s16x4*>(bp + cb * 256);
#pragma unroll
        for (int sub = 0; sub < 4; ++sub) afr_[gi][sub] = *reinterpret_cast<const s16x4*>(P + (size_t)rows[sub] * INW + g * 16 + fq * 4);
      }
#pragma unroll
      for (int gi = 0; gi < 2; ++gi) {
        const int g = wid_ * 2 + gi;
        const float are = are_[gi], aim = aim_[gi];
        const s16x4 (&bfr)[8] = bfr_[gi]; const s16x4 (&afr)[4] = afr_[gi];
        float sr = 0.f, si = 0.f;
#pragma unroll
        for (int sub = 0; sub < 4; ++sub) {
          __builtin_amdgcn_sched_barrier(0);
#pragma unroll
          for (int cb = 0; cb < 8; ++cb) { const f32x4 d = __builtin_amdgcn_mfma_f32_16x16x16bf16_1k(afr[sub], bfr[cb], (f32x4){0.f, 0.f, 0.f, 0.f}, 0, 0, 0);
            *reinterpret_cast<f32x4*>(bub + (cb * 16 + fr) * BT_LD + fq * 4) = d; }
          __builtin_amdgcn_wave_barrier(); asm volatile("s_waitcnt lgkmcnt(0)" ::: "memory");
#pragma unroll
          for (int j4 = 0; j4 < 4; ++j4) { const f32x4 br4 = *reinterpret_cast<const f32x4*>(bub + lane * BT_LD + j4 * 4), bi4 = *reinterpret_cast<const f32x4*>(bub + (64 + lane) * BT_LD + j4 * 4);
#pragma unroll
            for (int r = 0; r < 4; ++r) { const float nr = are * sr - aim * si + br4[r], ni = are * si + aim * sr + bi4[r]; sr = nr; si = ni; } }
          __builtin_amdgcn_wave_barrier(); asm volatile("s_waitcnt lgkmcnt(0)" ::: "memory");
        }
        *reinterpret_cast<float2*>(E + ((size_t)(((b * 2 + dir) * NCHK + ck) * 16 + g) * 64 + lane) * 2) = make_float2(sr, si);
      }
      __syncthreads();
      continue;
    }
    i -= n_s5;
    if (i < n_gm) {
      const int ck = ((i >> 5) << 3) | (i & 7), h = (i >> 3) & 3; const int row0 = ck * 128;
      int tid = (int)threadIdx.x; asm volatile("" : "+v"(tid));
      const int lane = tid & 63, wid = (int)__builtin_amdgcn_readfirstlane(tid >> 6), fr = lane & 15, fq = lane >> 4;
      u16* vt = reinterpret_cast<u16*>(c.lds);
      uint2 tv[16];
#pragma unroll
      for (int q = 0; q < 16; ++q) tv[q] = *reinterpret_cast<const uint2*>(P + (size_t)(row0 + wid * 16 + q) * INW + 512 + lane * 4);
      const float* wrow = c.in(I_GMW) + ((size_t)(l * 4 + h) * 128 + wid * 16 + fr) * 128 + fq * 8;
      float4 wl[8];
#pragma unroll
      for (int ks = 0; ks < 4; ++ks) { wl[2 * ks] = *reinterpret_cast<const float4*>(wrow + ks * 32); wl[2 * ks + 1] = *reinterpret_cast<const float4*>(wrow + ks * 32 + 4); }
      const int t = wid * 16 + fr;
      const float bs = c.in(I_GMB)[(l * 4 + h) * 128 + t];
      const u16* up = P + (size_t)(row0 + t) * INW + 256 + h * 64 + fq * 4;
      uint2 uq[4];
#pragma unroll
      for (int m = 0; m < 4; ++m) uq[m] = *reinterpret_cast<const uint2*>(up + m * 16);
#pragma unroll
      for (int q = 0; q < 16; ++q) {
        const float v0 = bflo(tv[q].x), v1 = bfhi(tv[q].x), v2 = bflo(tv[q].y), v3 = bfhi(tv[q].y);
        const float mean = wave_sum(v0 + v1 + v2 + v3) * (1.f / 256.f);
        const float d0 = v0 - mean, d1 = v1 - mean, d2 = v2 - mean, d3 = v3 - mean;
        const float rstd = rsqrtf(wave_sum(d0 * d0 + d1 * d1 + d2 * d2 + d3 * d3) * (1.f / 256.f) + LN_EPS);
        if (fq == h) { u16* dst = vt + (fr * 4) * GM_LD + wid * 16 + q;
          dst[0] = f2bf(d0 * rstd); dst[GM_LD] = f2bf(d1 * rstd); dst[2 * GM_LD] = f2bf(d2 * rstd); dst[3 * GM_LD] = f2bf(d3 * rstd); }
      }
      bf16x8 bw[4];
#pragma unroll
      for (int ks = 0; ks < 4; ++ks) { const float4 w0 = wl[2 * ks], w1 = wl[2 * ks + 1];
        u32x4 pk = {pack2(w0.x, w0.y), pack2(w0.z, w0.w), pack2(w1.x, w1.y), pack2(w1.z, w1.w)}; bw[ks] = *reinterpret_cast<bf16x8*>(&pk); }
      __syncthreads();
      f32x4 acc[4];
#pragma unroll
      for (int m = 0; m < 4; ++m) acc[m] = (f32x4){0.f, 0.f, 0.f, 0.f};
#pragma unroll
      for (int ks = 0; ks < 4; ++ks)
#pragma unroll
        for (int m = 0; m < 4; ++m) { const bf16x8 a = *reinterpret_cast<const bf16x8*>(vt + (m * 16 + fr) * GM_LD + ks * 32 + fq * 8);
          acc[m] = __builtin_amdgcn_mfma_f32_16x16x32_bf16(a, bw[ks], acc[m], 0, 0, 0); }
      u16* yb = c.w<u16>(OFF_BIG + BIG_YB) + (size_t)(row0 + t) * 256 + h * 64 + fq * 4;
#pragma unroll
      for (int m = 0; m < 4; ++m) { const uint2 uu = uq[m];
        uint2 o; o.x = pack2(bflo(uu.x) * (acc[m][0] + bs), bfhi(uu.x) * (acc[m][1] + bs)); o.y = pack2(bflo(uu.y) * (acc[m][2] + bs), bfhi(uu.y) * (acc[m][3] + bs));
        *reinterpret_cast<uint2*>(yb + m * 16) = o; }
      __syncthreads();
      continue;
    }
    i -= n_gm;
    cvt_expert(c, l, CV_GIN(l) + i);
  }
}

#define SB_LD 136
__device__ __forceinline__ void s5_out_item(const Ctx& c, int l, int b, int seg, int j) {
  const u16* P = c.w<u16>(OFF_BIG + BIG_P); u16* YA = c.w<u16>(OFF_BIG + BIG_YA);
  const float* A = c.w<float>(OFF_S5A); const float* A64 = c.w<float>(OFF_S5A64); const float* BB = c.w<float>(OFF_S5BB); const float* E = c.w<float>(OFF_E);
  const int r0 = seg ? (TLAT + b * 256 + j * 64) : (b * 4096 + j * 64);
  const int kf = seg ? j : 4 + j, kr = seg ? 3 - j : 4 + (63 - j);
  int tid_ = ((int)threadIdx.x); asm volatile("" : "+v"(tid_));
  const int lane = tid_ & 63, fr = lane & 15, fq = lane >> 4, wid_ = __builtin_amdgcn_readfirstlane(tid_ >> 6);
  float* bub = reinterpret_cast<float*>(c.lds + wid_ * 14592);
  u16* sbuf = reinterpret_cast<u16*>(c.lds + wid_ * 14592 + 10240);
  unsigned* sbuf32 = reinterpret_cast<unsigned*>(sbuf);
  const u16* BBH = c.w<u16>(OFF_S5BBH);
#pragma unroll 1
  for (int gi = 0; gi < 2; ++gi) {
    const int g = wid_ * 2 + gi;
    f32x4 acc[4];
#pragma unroll
    for (int q = 0; q < 4; ++q) acc[q] = (f32x4){0.f, 0.f, 0.f, 0.f};
#pragma unroll
    for (int dir = 0; dir < 2; ++dir) {
      const int q = ((l * 2 + dir) * 16 + g) * 64 + lane;
      const float are = A[q * 2], aim = A[q * 2 + 1], a64r = A64[q * 2], a64i = A64[q * 2 + 1];
      s16x4 bfr[8];
      { const u16* bp = BBH + ((size_t)((l * 2 + dir) * 16 + g) * 128 + fr) * 16 + fq * 4;
#pragma unroll
        for (int cb = 0; cb < 8; ++cb) bfr[cb] = *reinterpret_cast<const s16x4*>(bp + cb * 256); }
      s16x4 afr[4];
#pragma unroll
      for (int sub = 0; sub < 4; ++sub) { const int tau = sub * 16 + fr; const int tl = dir ? 63 - tau : tau;
        afr[sub] = *reinterpret_cast<const s16x4*>(P + (size_t)(r0 + tl) * INW + g * 16 + fq * 4); }
      float sr = 0.f, si = 0.f; const int kk = dir ? kr : kf;
      { const float* ep = E + ((size_t)((b * 2 + dir) * NCHK * 16 + g) * 64 + lane) * 2;
        int jj = 0;
        for (; jj + 8 <= kk; jj += 8) {
          float2 e[8];
#pragma unroll
          for (int q = 0; q < 8; ++q) e[q] = *reinterpret_cast<const float2*>(ep + (size_t)(jj + q) * 2048);
#pragma unroll
          for (int q = 0; q < 8; ++q) { const float nr = a64r * sr - a64i * si + e[q].x, ni = a64r * si + a64i * sr + e[q].y; sr = nr; si = ni; }
        }
        for (; jj < kk; ++jj) { const float2 e = *reinterpret_cast<const float2*>(ep + (size_t)jj * 2048);
          const float nr = a64r * sr - a64i * si + e.x, ni = a64r * si + a64i * sr + e.y; sr = nr; si = ni; } }
      bf16x8 Bf[4];
      { const float* cre = c.in(I_CRE) + ((size_t)((l * 2 + dir) * 16 + g) * 16 + fr) * 64; const float* cim = c.in(I_CIM) + ((size_t)((l * 2 + dir) * 16 + g) * 16 + fr) * 64;
#pragma unroll
        for (int ks = 0; ks < 4; ++ks) {
#pragma unroll
          for (int ii = 0; ii < 8; ++ii) { const int k = ks * 32 + fq * 8 + ii, n = k >> 1; const float v = (k & 1) ? -cim[n] : cre[n]; Bf[ks][ii] = (short)f2bf(v); } } }
#pragma unroll
      for (int sub = 0; sub < 4; ++sub) {
        __builtin_amdgcn_sched_barrier(0);
#pragma unroll
        for (int cb = 0; cb < 8; ++cb) { const f32x4 d = __builtin_amdgcn_mfma_f32_16x16x16bf16_1k(afr[sub], bfr[cb], (f32x4){0.f, 0.f, 0.f, 0.f}, 0, 0, 0);
          *reinterpret_cast<f32x4*>(bub + (cb * 16 + fr) * BT_LD + fq * 4) = d; }
        __builtin_amdgcn_wave_barrier(); asm volatile("s_waitcnt lgkmcnt(0)" ::: "memory");
#pragma unroll
        for (int j4 = 0; j4 < 4; ++j4) {
          const f32x4 br4 = *reinterpret_cast<const f32x4*>(bub + lane * BT_LD + j4 * 4), bi4 = *reinterpret_cast<const f32x4*>(bub + (64 + lane) * BT_LD + j4 * 4);
#pragma unroll
          for (int r = 0; r < 4; ++r) {
            const int tau = sub * 16 + j4 * 4 + r; const int tl = dir ? 63 - tau : tau;
            const float nr = are * sr - aim * si + br4[r], ni = are * si + aim * sr + bi4[r]; sr = nr; si = ni;
            sbuf32[(tl & 15) * (SB_LD / 2) + lane] = pack2(sr, si);
          }
        }
        __builtin_amdgcn_wave_barrier(); asm volatile("s_waitcnt lgkmcnt(0)" ::: "memory");
        bf16x8 Af[4];
#pragma unroll
        for (int ks = 0; ks < 4; ++ks) Af[ks] = *reinterpret_cast<const bf16x8*>(sbuf + fr * SB_LD + ks * 32 + fq * 8);
        asm volatile("s_waitcnt lgkmcnt(0)" ::: "memory"); __builtin_amdgcn_wave_barrier();
        if (dir == 0) {
#pragma unroll
          for (int ks = 0; ks < 4; ++ks) acc[sub] = __builtin_amdgcn_mfma_f32_16x16x32_bf16(Af[ks], Bf[ks], acc[sub], 0, 0, 0);
        } else {
#pragma unroll
          for (int ks = 0; ks < 4; ++ks) acc[3 - sub] = __builtin_amdgcn_mfma_f32_16x16x32_bf16(Af[ks], Bf[ks], acc[3 - sub], 0, 0, 0);
        }
      }
    }
#pragma unroll
    for (int tb = 0; tb < 4; ++tb)
#pragma unroll
      for (int jx = 0; jx < 4; ++jx) bub[(tb * 16 + fq * 4 + jx) * BT_LD + fr] = acc[tb][jx];
    __builtin_amdgcn_wave_barrier(); asm volatile("s_waitcnt lgkmcnt(0)" ::: "memory"); __builtin_amdgcn_wave_barrier();
#pragma unroll
    for (int i = 0; i < 2; ++i) { const int q = i * 64 + lane, tl = q >> 1, hf = q & 1;
      const f32x4 y0 = *reinterpret_cast<const f32x4*>(bub + tl * BT_LD + hf * 8), y1 = *reinterpret_cast<const f32x4*>(bub + tl * BT_LD + hf * 8 + 4);
      const u32x4 uu = *reinterpret_cast<const u32x4*>(P + (size_t)(r0 + tl) * INW + g * 16 + hf * 8);
      const float4 d0 = *reinterpret_cast<const float4*>(c.in(I_S5D) + l * 256 + g * 16 + hf * 8), d1 = *reinterpret_cast<const float4*>(c.in(I_S5D) + l * 256 + g * 16 + hf * 8 + 4);
      u32x4 o;
      o.x = pack2(gelu_tanh(d0.x * bflo(uu.x) + y0[0]), gelu_tanh(d0.y * bfhi(uu.x) + y0[1])); o.y = pack2(gelu_tanh(d0.z * bflo(uu.y) + y0[2]), gelu_tanh(d0.w * bfhi(uu.y) + y0[3]));
      o.z = pack2(gelu_tanh(d1.x * bflo(uu.z) + y1[0]), gelu_tanh(d1.y * bfhi(uu.z) + y1[1])); o.w = pack2(gelu_tanh(d1.z * bflo(uu.w) + y1[2]), gelu_tanh(d1.w * bfhi(uu.w) + y1[3]));
      *reinterpret_cast<u32x4*>(YA + (size_t)(r0 + tl) * 256 + g * 16 + hf * 8) = o; }
    __builtin_amdgcn_wave_barrier(); asm volatile("s_waitcnt lgkmcnt(0)" ::: "memory");
  }
}

__device__ __forceinline__ void attn_naive_item(const Ctx& c, int l, int b, int h, int qb, int seg) {
  const u16* P = c.w<u16>(OFF_BIG + BIG_P); u16* YC = c.w<u16>(OFF_BIG + BIG_YC);
  const int ql = ((int)threadIdx.x) >> 2, vq = ((int)threadIdx.x) & 3;
  const int qrow = seg ? (TLAT + b * 256 + qb * 128 + ql) : (b * 4096 + qb * 128 + ql);
  const int nkeys = seg ? 256 : 4352;
  const float lam_init = 0.8f - 0.6f * expf(-0.3f * (float)l);
  float lam;
  { const float* lf = c.in(I_DALAM) + l * 256; float s1 = 0.f, s2 = 0.f;
    for (int d = 0; d < 64; ++d) { s1 += lf[d] * lf[64 + d]; s2 += lf[128 + d] * lf[192 + d]; }
    lam = expf(s1) - expf(s2) + lam_init; }
  float res[32];
#pragma unroll 1
  for (int mp = 0; mp < 2; ++mp) {
    float q[64];
    { const u16* qp = P + (size_t)qrow * INW + 768 + h * 128 + mp * 64;
#pragma unroll
      for (int w = 0; w < 8; ++w) { u32x4 t = *reinterpret_cast<const u32x4*>(qp + w * 8);
#pragma unroll
        for (int e = 0; e < 4; ++e) { q[w * 8 + 2 * e] = bflo(t[e]) * 0.125f; q[w * 8 + 2 * e + 1] = bfhi(t[e]) * 0.125f; } } }
    float o[32];
#pragma unroll
    for (int d = 0; d < 32; ++d) o[d] = 0.f;
    float mx = -1e30f, ls = 0.f;
#pragma unroll 1
    for (int key = 0; key < nkeys; ++key) {
      const int krow = key < 256 ? (TLAT + b * 256 + key) : (b * 4096 + key - 256);
      const u16* kp = P + (size_t)krow * INW + 1280 + h * 128 + mp * 64;
      float s = 0.f;
#pragma unroll
      for (int w = 0; w < 8; ++w) { u32x4 t = *reinterpret_cast<const u32x4*>(kp + w * 8);
#pragma unroll
        for (int e = 0; e < 4; ++e) s += q[w * 8 + 2 * e] * bflo(t[e]) + q[w * 8 + 2 * e + 1] * bfhi(t[e]); }
      const float mn = fmaxf(mx, s); const float al = __expf(mx - mn), pp = __expf(s - mn); mx = mn; ls = ls * al + pp;
      const u16* vp = P + (size_t)krow * INW + 1792 + h * 128 + vq * 32;
#pragma unroll
      for (int w = 0; w < 4; ++w) { u32x4 t = *reinterpret_cast<const u32x4*>(vp + w * 8);
#pragma unroll
        for (int e = 0; e < 4; ++e) { o[w * 8 + 2 * e] = o[w * 8 + 2 * e] * al + pp * bflo(t[e]); o[w * 8 + 2 * e + 1] = o[w * 8 + 2 * e + 1] * al + pp * bfhi(t[e]); } }
    }
    const float inv = 1.f / ls;
    if (mp == 0) {
#pragma unroll
      for (int d = 0; d < 32; ++d) res[d] = o[d] * inv;
    } else {
#pragma unroll
      for (int d = 0; d < 32; ++d) res[d] = res[d] - lam * o[d] * inv;
    }
  }
  float ss = 0.f;
#pragma unroll
  for (int d = 0; d < 32; ++d) ss += res[d] * res[d];
  ss += __shfl_xor(ss, 1, 64); ss += __shfl_xor(ss, 2, 64);
  const float r = rsqrtf(ss * (1.f / 128.f) + LN_EPS) * (1.f - lam_init);
  const float* sg = c.in(I_SUBLN) + l * 128 + vq * 32;
  u16* yp = YC + (size_t)qrow * 512 + h * 128 + vq * 32;
#pragma unroll
  for (int w = 0; w < 4; ++w) { u32x4 t;
#pragma unroll
    for (int e = 0; e < 4; ++e) t[e] = pack2(res[w * 8 + 2 * e] * r * sg[w * 8 + 2 * e], res[w * 8 + 2 * e + 1] * r * sg[w * 8 + 2 * e + 1]);
    *reinterpret_cast<u32x4*>(yp + w * 8) = t; }
}

typedef __attribute__((ext_vector_type(16))) float f32x16;
#define KSWZ(row, colB) ((row) * 256 + ((colB) ^ (((row) & 15) << 4)))
#define SBAR() __builtin_amdgcn_sched_barrier(0)
#define ATT_THR 8.f
__device__ __forceinline__ int crow(int r, int hi) { return (r & 3) + 8 * (r >> 2) + 4 * hi; }
__device__ __forceinline__ int v_rd_base(int lane) { return ((lane & 3) << 3) | (((lane >> 2) & 3) << 6) | (((lane >> 4) & 1) << 5) | (((lane >> 5) & 1) << 8); }
constexpr int v_rd_off(int d0, int ks, int half) { return d0 * 512 + ks * 4096 + half * 2048; }
template <int OFF> __device__ __forceinline__ s16x4 tr_read(int vb) {
  typedef __attribute__((address_space(3))) s16x4* lp;
  return __builtin_amdgcn_ds_read_tr16_b64_v4i16((lp)(unsigned)(vb + OFF));
}
template <int MAP>
__device__ __forceinline__ void att_qkt(f32x16& p0, f32x16& p1, const char* Ks, const char* Qs, int r32, int hi) {
  p0 = f32x16{}; p1 = f32x16{};
#pragma unroll
  for (int dd = 0; dd < 4; ++dd) { const int d0 = MAP * 4 + dd; const int cb = (d0 * 16 + hi * 8) * 2;
    bf16x8 b0 = *reinterpret_cast<const bf16x8*>(Ks + KSWZ(r32, cb));
    bf16x8 b1 = *reinterpret_cast<const bf16x8*>(Ks + KSWZ(32 + r32, cb));
    bf16x8 qf = *reinterpret_cast<const bf16x8*>(Qs + KSWZ(r32, cb));
    p0 = __builtin_amdgcn_mfma_f32_32x32x16_bf16(b0, qf, p0, 0, 0, 0);
    p1 = __builtin_amdgcn_mfma_f32_32x32x16_bf16(b1, qf, p1, 0, 0, 0); }
}
__device__ __forceinline__ void att_softmax(f32x16& p0, f32x16& p1, float& m_reg, float& l_reg, float& alpha, bf16x8& pa0, bf16x8& pa1, bf16x8& pa2, bf16x8& pa3) {
  constexpr float SC = 0.125f, C = SC * 1.4426950408889634f;
  float pmax = p0[0];
#pragma unroll
  for (int r = 1; r < 16; ++r) pmax = fmaxf(pmax, p0[r]);
#pragma unroll
  for (int r = 0; r < 16; ++r) pmax = fmaxf(pmax, p1[r]);
  { auto rr = __builtin_amdgcn_permlane32_swap(__float_as_uint(pmax), __float_as_uint(pmax), false, false);
    pmax = fmaxf(__uint_as_float(rr[0]), __uint_as_float(rr[1])); }
  const bool keep = __all(pmax - m_reg <= ATT_THR / SC);
  const float mn = keep ? m_reg : fmaxf(m_reg, pmax);
  alpha = __builtin_amdgcn_exp2f((m_reg - mn) * C); m_reg = mn;
  const float mnC = -mn * C;
#pragma unroll
  for (int r = 0; r < 16; ++r) p0[r] = __builtin_amdgcn_exp2f(fmaf(p0[r], C, mnC));
#pragma unroll
  for (int r = 0; r < 16; ++r) p1[r] = __builtin_amdgcn_exp2f(fmaf(p1[r], C, mnC));
  float ps = 0.f;
#pragma unroll
  for (int r = 0; r < 16; ++r) ps += p0[r];
#pragma unroll
  for (int r = 0; r < 16; ++r) ps += p1[r];
  { auto rr = __builtin_amdgcn_permlane32_swap(__float_as_uint(ps), __float_as_uint(ps), false, false);
    ps = __uint_as_float(rr[0]) + __uint_as_float(rr[1]); }
  l_reg = l_reg * alpha + ps;
#define PK4(P, BASE, OUT) do { unsigned a0 = cvtpk(P[BASE + 0], P[BASE + 1]), a1 = cvtpk(P[BASE + 2], P[BASE + 3]);   \
    unsigned b0 = cvtpk(P[BASE + 4], P[BASE + 5]), b1 = cvtpk(P[BASE + 6], P[BASE + 7]);                              \
    auto r0 = __builtin_amdgcn_permlane32_swap(a0, b0, false, false); auto r1 = __builtin_amdgcn_permlane32_swap(a1, b1, false, false); \
    u32x4 w = {r0[0], r1[0], r0[1], r1[1]}; OUT = *reinterpret_cast<bf16x8*>(&w); } while (0)
  PK4(p0, 0, pa0); PK4(p0, 8, pa1); PK4(p1, 0, pa2); PK4(p1, 8, pa3);
#undef PK4
}
template <int D0> __device__ __forceinline__ void att_pv(f32x16& oa, f32x16& ob, int vb, const bf16x8 (&pa)[4], const bf16x8 (&pb)[4]) {
  const s16x4 l0 = tr_read<v_rd_off(D0, 0, 0)>(vb), h0 = tr_read<v_rd_off(D0, 0, 1)>(vb), l1 = tr_read<v_rd_off(D0, 1, 0)>(vb), h1 = tr_read<v_rd_off(D0, 1, 1)>(vb);
  const s16x4 l2 = tr_read<v_rd_off(D0, 2, 0)>(vb), h2 = tr_read<v_rd_off(D0, 2, 1)>(vb), l3 = tr_read<v_rd_off(D0, 3, 0)>(vb), h3 = tr_read<v_rd_off(D0, 3, 1)>(vb);
#define PKV(L, H) (bf16x8){L[0], L[1], L[2], L[3], H[0], H[1], H[2], H[3]}
  const bf16x8 v0 = PKV(l0, h0), v1 = PKV(l1, h1), v2 = PKV(l2, h2), v3 = PKV(l3, h3);
#undef PKV
  oa = __builtin_amdgcn_mfma_f32_32x32x16_bf16(pa[0], v0, oa, 0, 0, 0);
  ob = __builtin_amdgcn_mfma_f32_32x32x16_bf16(pb[0], v0, ob, 0, 0, 0);
  oa = __builtin_amdgcn_mfma_f32_32x32x16_bf16(pa[1], v1, oa, 0, 0, 0);
  ob = __builtin_amdgcn_mfma_f32_32x32x16_bf16(pb[1], v1, ob, 0, 0, 0);
  oa = __builtin_amdgcn_mfma_f32_32x32x16_bf16(pa[2], v2, oa, 0, 0, 0);
  ob = __builtin_amdgcn_mfma_f32_32x32x16_bf16(pb[2], v2, ob, 0, 0, 0);
  oa = __builtin_amdgcn_mfma_f32_32x32x16_bf16(pa[3], v3, oa, 0, 0, 0);
  ob = __builtin_amdgcn_mfma_f32_32x32x16_bf16(pb[3], v3, ob, 0, 0, 0);
}
template <int D0> __device__ __forceinline__ void att_pv1(f32x16& oa, int vb, const bf16x8 (&pa)[4]) {
  const s16x4 l0 = tr_read<v_rd_off(D0, 0, 0)>(vb), h0 = tr_read<v_rd_off(D0, 0, 1)>(vb), l1 = tr_read<v_rd_off(D0, 1, 0)>(vb), h1 = tr_read<v_rd_off(D0, 1, 1)>(vb);
  const s16x4 l2 = tr_read<v_rd_off(D0, 2, 0)>(vb), h2 = tr_read<v_rd_off(D0, 2, 1)>(vb), l3 = tr_read<v_rd_off(D0, 3, 0)>(vb), h3 = tr_read<v_rd_off(D0, 3, 1)>(vb);
#define PKV(L, H) (bf16x8){L[0], L[1], L[2], L[3], H[0], H[1], H[2], H[3]}
  oa = __builtin_amdgcn_mfma_f32_32x32x16_bf16(pa[0], PKV(l0, h0), oa, 0, 0, 0);
  oa = __builtin_amdgcn_mfma_f32_32x32x16_bf16(pa[1], PKV(l1, h1), oa, 0, 0, 0);
  oa = __builtin_amdgcn_mfma_f32_32x32x16_bf16(pa[2], PKV(l2, h2), oa, 0, 0, 0);
  oa = __builtin_amdgcn_mfma_f32_32x32x16_bf16(pa[3], PKV(l3, h3), oa, 0, 0, 0);
#undef PKV
}
#define ATT_KBUF(b) ((b) * 16384)
#define ATT_VBUF(b) (32768 + (b) * 16384)
#define ATT_WS_OFF 65536
#define ATT_Q_OFF 69632
__device__ __forceinline__ void attn_mfma_item(const Ctx& c, int l, int b, int h, int qb, int seg) {
  const u16* P = c.w<u16>(OFF_BIG + BIG_P); u16* YC = c.w<u16>(OFF_BIG + BIG_YC);
  int tid = ((int)threadIdx.x); asm volatile("" : "+v"(tid));
  const int wid = __builtin_amdgcn_readfirstlane(tid >> 6), lane = tid & 63, r32 = lane & 31, hi = lane >> 5;
  const int q0 = seg ? (TLAT + b * 256) : (b * 4096 + qb * 256);
  const int NT = seg ? 4 : 68;
  float* wsl = reinterpret_cast<float*>(c.lds + ATT_WS_OFF) + wid * 64;
  const float lam_init = 0.8f - 0.6f * expf(-0.3f * (float)l);
  float lam;
  { const float* lf = c.in(I_DALAM) + l * 256; float s1 = lf[lane] * lf[64 + lane], s2 = lf[128 + lane] * lf[192 + lane];
    s1 = wave_sum(s1); s2 = wave_sum(s2); lam = expf(s1) - expf(s2) + lam_init; }
#pragma unroll
  for (int i = 0; i < 8; ++i) { const int q = i * NTHR + tid, row = q >> 4, col = ((q & 15) ^ (row & 15)) * 8;
    glds16(P + (size_t)(q0 + row) * INW + 768 + h * 128 + col, c.lds + ATT_Q_OFF + (i * NTHR + tid) * 16); }
  const char* Qs = c.lds + ATT_Q_OFF + wid * 32 * 256;
  int krow[2], kcol[2], vrow[2], vcol[2];
#pragma unroll
  for (int i = 0; i < 2; ++i) { const int q = i * NTHR + tid;
    krow[i] = q >> 4; kcol[i] = ((q & 15) ^ (krow[i] & 15)) * 8;
    const int st = q >> 5, r5 = q & 31, kk = ((st >> 2) << 3) | (r5 >> 2);
    vrow[i] = (kk & ~0xC) | ((kk & 4) << 1) | ((kk & 8) >> 1); vcol[i] = (st & 3) * 32 + (r5 & 3) * 8; }
  auto issue_tile = [&](int jt, int buf) {
    const int kr0 = (jt < 4) ? (TLAT + b * 256 + jt * 64) : (b * 4096 + (jt - 4) * 64);
#pragma unroll
    for (int i = 0; i < 2; ++i) {
      glds16(P + (size_t)(kr0 + krow[i]) * INW + 1280 + h * 128 + kcol[i], c.lds + ATT_KBUF(buf) + (i * NTHR + tid) * 16);
      glds16(P + (size_t)(kr0 + vrow[i]) * INW + 1792 + h * 128 + vcol[i], c.lds + ATT_VBUF(buf) + (i * NTHR + tid) * 16); }
  };
  f32x16 o0[4], o1[4];
#pragma unroll
  for (int d = 0; d < 4; ++d) { o0[d] = f32x16{}; o1[d] = f32x16{}; }
  float m0 = -1e30f, l0 = 0.f, m1 = -1e30f, l1 = 0.f;
  const int vbase = (int)(uintptr_t)(c.lds) + v_rd_base(lane);
  issue_tile(0, 0);
  asm volatile("s_waitcnt vmcnt(0)" ::: "memory");
  __syncthreads();
#pragma unroll 1
  for (int jt = 0; jt < NT; ++jt) {
    const int buf = jt & 1;
    if (jt + 1 < NT) issue_tile(jt + 1, buf ^ 1);
    const char* Ks = c.lds + ATT_KBUF(buf);
    bf16x8 pa[4], pb[4]; float al0, al1;
    { f32x16 p0, p1; att_qkt<0>(p0, p1, Ks, Qs, r32, hi); att_softmax(p0, p1, m0, l0, al0, pa[0], pa[1], pa[2], pa[3]); }
    if (__any(al0 < 1.f)) {
      if (hi == 0) wsl[r32] = al0;
      asm volatile("s_waitcnt lgkmcnt(0)" ::: "memory");
#pragma unroll
      for (int r = 0; r < 16; ++r) { const float a0 = wsl[crow(r, hi)];
#pragma unroll
        for (int d = 0; d < 4; ++d) o0[d][r] *= a0; }
    }
    const int vb = vbase + ATT_VBUF(buf);
    { f32x16 p0, p1; att_qkt<1>(p0, p1, Ks, Qs, r32, hi);
      att_pv1<0>(o0[0], vb, pa); att_pv1<1>(o0[1], vb, pa); att_pv1<2>(o0[2], vb, pa); att_pv1<3>(o0[3], vb, pa);
      att_softmax(p0, p1, m1, l1, al1, pb[0], pb[1], pb[2], pb[3]); }
    if (__any(al1 < 1.f)) {
      if (hi == 0) wsl[32 + r32] = al1;
      asm volatile("s_waitcnt lgkmcnt(0)" ::: "memory");
#pragma unroll
      for (int r = 0; r < 16; ++r) { const float a1 = wsl[32 + crow(r, hi)];
#pragma unroll
        for (int d = 0; d < 4; ++d) o1[d][r] *= a1; }
    }
    att_pv1<0>(o1[0], vb, pb); att_pv1<1>(o1[1], vb, pb); att_pv1<2>(o1[2], vb, pb); att_pv1<3>(o1[3], vb, pb);
    asm volatile("s_waitcnt vmcnt(0)" ::: "memory");
    __syncthreads();
  }
  if (hi == 0) { wsl[r32] = 1.f / l0; wsl[32 + r32] = lam / l1; }
  asm volatile("s_waitcnt lgkmcnt(0)" ::: "memory");
  float ss[16];
#pragma unroll
  for (int r = 0; r < 16; ++r) { const float i0 = wsl[crow(r, hi)], i1 = wsl[32 + crow(r, hi)]; float s = 0.f;
#pragma unroll
    for (int d = 0; d < 4; ++d) { const float v = o0[d][r] * i0 - o1[d][r] * i1; o0[d][r] = v; s += v * v; }
    ss[r] = s; }
#pragma unroll
  for (int r = 0; r < 16; ++r) {
#pragma unroll
    for (int mk = 1; mk < 32; mk <<= 1) ss[r] += __shfl_xor(ss[r], mk, 64);
    ss[r] = rsqrtf(ss[r] * (1.f / 128.f) + LN_EPS) * (1.f - lam_init); }
  const float* sg = c.in(I_SUBLN) + l * 128;
  float g4[4];
#pragma unroll
  for (int d = 0; d < 4; ++d) g4[d] = sg[d * 32 + r32];
  { u16* stg = reinterpret_cast<u16*>(c.lds + ATT_KBUF(0)) + wid * (32 * 128);
#pragma unroll
    for (int r = 0; r < 16; ++r)
#pragma unroll
      for (int d = 0; d < 4; ++d) stg[crow(r, hi) * 128 + d * 32 + r32] = f2bf(o0[d][r] * ss[r] * g4[d]);
    __builtin_amdgcn_wave_barrier(); asm volatile("s_waitcnt lgkmcnt(0)" ::: "memory"); __builtin_amdgcn_wave_barrier();
#pragma unroll
    for (int i = 0; i < 8; ++i) { const int q = i * 64 + lane, row = q >> 4, c8 = (q & 15) * 8;
      *reinterpret_cast<u32x4*>(YC + (size_t)(q0 + wid * 32 + row) * 512 + h * 128 + c8) = *reinterpret_cast<const u32x4*>(stg + row * 128 + c8); } }
  __syncthreads();
}

__device__ __forceinline__ void step_mix_b(const Ctx& c, int l, bool last) {
#ifdef NAIVE_ATTN
  const int n_att = 512, n_attc = last ? 0 : 32, n_s5 = 4 * 64, n_s5c = last ? 0 : 16;
#else
  const int n_att = 256, n_attc = last ? 0 : 16, n_s5 = 4 * 64, n_s5c = last ? 0 : 16;
#endif
  const int total = n_att + n_attc + n_s5 + n_s5c;
#ifdef PROBE_A
  unsigned long long tq0 = 0; if (blockIdx.x == 0 && ((int)threadIdx.x) == 0) tq0 = __builtin_amdgcn_s_memrealtime();
#endif
  for (int it = blockIdx.x; it < total; it += gridDim.x) {
    int i = it;
#ifdef PROBE_A
    if (it != (int)blockIdx.x && it == (int)blockIdx.x + (int)gridDim.x && blockIdx.x == 0 && ((int)threadIdx.x) == 0) { unsigned long long* tsl_ = reinterpret_cast<unsigned long long*>(c.lds + 158720); tsl_[45 + l] = __builtin_amdgcn_s_memrealtime() - tq0; }
#endif
#ifdef NAIVE_ATTN
    if (i < n_att) { const int bh = i >> 5, qb = i & 31; attn_naive_item(c, l, bh >> 2, bh & 3, qb, 0); continue; }
    i -= n_att;
    if (i < n_attc) { const int bh = i >> 1; attn_naive_item(c, l, bh >> 2, bh & 3, i & 1, 1); continue; }
#else
    if (i < n_att) { const int xcd = i & 7, slot = i >> 3; const int bh = xcd * 2 + (slot >> 4), qb = slot & 15;
      attn_mfma_item(c, l, bh >> 2, bh & 3, qb, 0); continue; }
    i -= n_att;
    if (i < n_attc) { attn_mfma_item(c, l, i >> 2, i & 3, 0, 1); continue; }
#endif
    i -= n_attc;
    if (i < n_s5) { s5_out_item(c, l, i >> 6, 0, i & 63); continue; }
    i -= n_s5;
    s5_out_item(c, l, i >> 2, 1, i & 3);
  }
#ifdef PROBE_A
  if (blockIdx.x == 0 && ((int)threadIdx.x) == 0) { unsigned long long* tsl_ = reinterpret_cast<unsigned long long*>(c.lds + 158720); tsl_[47 + l] = __builtin_amdgcn_s_memrealtime() - tq0; }
#endif
}

__device__ __forceinline__ void step_merge(const Ctx& c, int l, bool last) {
  const char* wl = c.p.ws + OFF_WS + (size_t)l * WS_LAYER;
  const u16* WGLU = (const u16*)(wl + WS_GLU); const u16* WGM = (const u16*)(wl + WS_GM); const u16* WDA = (const u16*)(wl + WS_DA);
  const u16* P = c.w<u16>(OFF_BIG + BIG_P); const u16* YA = c.w<u16>(OFF_BIG + BIG_YA); const u16* YB = c.w<u16>(OFF_BIG + BIG_YB); const u16* YC = c.w<u16>(OFF_BIG + BIG_YC);
  u16* Mb = c.w<u16>(OFF_BIG + BIG_M);
  const int wm = ((int)__builtin_amdgcn_readfirstlane(threadIdx.x >> 6)) >> 1, wn = ((int)__builtin_amdgcn_readfirstlane(threadIdx.x >> 6)) & 1, fr = ((int)threadIdx.x & 63) & 15, fq = ((int)threadIdx.x & 63) >> 4;
  const int ntm = last ? 64 : 68;
  XSched s = xsched(ntm * 16);
  if (s.pos >= s.end) return;
#define TILE_OF(L) const int band = (L) / (4 * 16), rem = (L) % (4 * 16), tn = rem >> 2, tm = band * 4 + (rem & 3)
  auto p_gv = [&](int L) { TILE_OF(L); return gs_ptrs([&](int r) { return YA + (size_t)(tm * 256 + r) * 256; }, [&](int b) { return WGLU + (size_t)(tn * 64 + b) * 256; }); };
  auto p_gg = [&](int L) { TILE_OF(L); return gs_ptrs([&](int r) { return YA + (size_t)(tm * 256 + r) * 256; }, [&](int b) { return WGLU + (size_t)(1024 + tn * 64 + b) * 256; }); };
  auto p_gm = [&](int L) { TILE_OF(L); return gs_ptrs([&](int r) { return YB + (size_t)(tm * 256 + r) * 256; }, [&](int b) { return WGM + (size_t)(tn * 64 + b) * 256; }); };
  auto p_da = [&](int L) { TILE_OF(L); return gs_ptrs([&](int r) { return YC + (size_t)(tm * 256 + r) * 512; }, [&](int b) { return WDA + (size_t)(tn * 64 + b) * 512; }); };
  GStream g; gs_start(g, p_gv(s.pos), 4, p_gg(s.pos), 4, c.lds);
  for (;;) {
    TILE_OF(s.pos);
    const int nx = s.pos + s.step; const bool hn = nx < s.end;
    f32x4 am[4][2];
#define GATE4(G, J) ((J) == 0 ? bflo(G.x) : (J) == 1 ? bfhi(G.x) : (J) == 2 ? bflo(G.y) : bfhi(G.y))
    { f32x4 tv[4][2], tg[4][2]; ZERO_ACC2(tv); ZERO_ACC2(tg);
      gs_run<2>(g, tv, c.lds); gs_advance(g);
      gs_set_next(g, p_gm(s.pos), 4);
      gs_run<2>(g, tg, c.lds); gs_advance(g);
      { EPI_M(tm * 256)
          const u16* gp = P + (size_t)row * INW + 2304 + tn * 64 + wn * 32 + fq * 4;
#pragma unroll
          for (int n = 0; n < 2; ++n) { const uint2 gg = *reinterpret_cast<const uint2*>(gp + n * 16);
#pragma unroll
            for (int j = 0; j < 4; ++j) am[m][n][j] = GATE4(gg, j) * tv[m][n][j] * sigmoidf_(tg[m][n][j]); }
        EPI_M_END } }
    { f32x4 t[4][2]; ZERO_ACC2(t);
      gs_set_next(g, p_da(s.pos), 8);
      gs_run<2>(g, t, c.lds); gs_advance(g);
      { EPI_M(tm * 256)
          const u16* gp = P + (size_t)row * INW + 2304 + 1024 + tn * 64 + wn * 32 + fq * 4;
#pragma unroll
          for (int n = 0; n < 2; ++n) { const uint2 gg = *reinterpret_cast<const uint2*>(gp + n * 16);
#pragma unroll
            for (int j = 0; j < 4; ++j) am[m][n][j] += GATE4(gg, j) * t[m][n][j]; }
        EPI_M_END } }
    { f32x4 t[4][2]; ZERO_ACC2(t);
      if (hn) gs_set_next(g, p_gv(nx), 4);
      gs_run<2>(g, t, c.lds);
      { EPI_M(tm * 256)
          const u16* gp = P + (size_t)row * INW + 2304 + 2048 + tn * 64 + wn * 32 + fq * 4;
#pragma unroll
          for (int n = 0; n < 2; ++n) { const uint2 gg = *reinterpret_cast<const uint2*>(gp + n * 16);
#pragma unroll
            for (int j = 0; j < 4; ++j) am[m][n][j] += GATE4(gg, j) * t[m][n][j]; }
        EPI_M_END } }
#undef GATE4
    epi_tile<2, 8>(c.lds, [&](int m, int n) { return am[m][n]; },
      [&](int row, int col, u32x4 v) { *reinterpret_cast<u32x4*>(Mb + (size_t)(tm * 256 + row) * 1024 + tn * 64 + col) = v; });
    if (!hn) break;
    gs_advance(g); s.pos = nx;
    gs_set_next(g, p_gg(nx), 4);
  }
#undef TILE_OF
}

__device__ __forceinline__ void step_out(const Ctx& c, int l, bool last) {
  const u16* WOUT = (const u16*)(c.p.ws + OFF_WS + (size_t)l * WS_LAYER + WS_OUT);
  const u16* Mb = c.w<u16>(OFF_BIG + BIG_M); u16* H = c.w<u16>(OFF_H);
  const int ntm = last ? 64 : 68;
  DenseSched<true> S{(const char*)Mb, (const char*)WOUT, 1024, 4, ntm * 4};
  g8::phase<DUnit>(c.lds, 1024, S, [&](const g8::Acc& acc, const DUnit& u, int wr, int wc, int fr, int fq) {
#pragma unroll
    for (int ai = 0; ai < 2; ++ai)
#pragma unroll
      for (int m = 0; m < 4; ++m) {
        const int row = u.pm * 256 + ai * 128 + wr * 64 + m * 16 + fr, col0 = u.pn * 256 + wc * 32 + 8 * fq;
        const float* g1 = c.mod(l, brow_of(row), 2) + col0;
        u16* hd = H + (size_t)row * 1024 + col0;
#pragma unroll
        for (int bj = 0; bj < 2; ++bj) {
          const f32x4 v0 = acc[ai][bj][m][0], v1 = acc[ai][bj][m][1];
          float h[8];
          if (l == 0) { const float* hs = (row < TLAT ? c.in(I_X) + (size_t)row * 1024 : c.in(I_CTX) + (size_t)(row - TLAT) * 1024) + col0 + bj * 128;
            const float4 a = *reinterpret_cast<const float4*>(hs), b = *reinterpret_cast<const float4*>(hs + 4);
            h[0] = a.x; h[1] = a.y; h[2] = a.z; h[3] = a.w; h[4] = b.x; h[5] = b.y; h[6] = b.z; h[7] = b.w; }
          else { const u32x4 hb = *reinterpret_cast<const u32x4*>(hd + bj * 128);
#pragma unroll
            for (int e = 0; e < 4; ++e) { h[2 * e] = bflo(hb[e]); h[2 * e + 1] = bfhi(hb[e]); } }
          const float4 ga = *reinterpret_cast<const float4*>(g1 + bj * 128), gb = *reinterpret_cast<const float4*>(g1 + bj * 128 + 4);
          u32x4 w; w.x = pack2(ALPHA * h[0] + ga.x * v0[0], ALPHA * h[1] + ga.y * v0[1]); w.y = pack2(ALPHA * h[2] + ga.z * v0[2], ALPHA * h[3] + ga.w * v0[3]);
          w.z = pack2(ALPHA * h[4] + gb.x * v1[0], ALPHA * h[5] + gb.y * v1[1]); w.w = pack2(ALPHA * h[6] + gb.z * v1[2], ALPHA * h[7] + gb.w * v1[3]);
          *reinterpret_cast<u32x4*>(hd + bj * 128) = w;
        }
      }
  });
  if (!last) {
    const int G = (int)gridDim.x, extra = (ntm * 4) % G;
    const int j = extra > 0 ? (int)blockIdx.x - extra : (int)blockIdx.x, nidle = extra > 0 ? G - extra : G;
    if (j >= 0) { for (int it = NCVT_EXP - CV_OUT(l) + j; it < NCVT_EXP; it += nidle) cvt_expert(c, l, it);
      for (int it = j; it < NCVT_SMALL; it += nidle) cvt_small(c, 1, it); }
  }
}

__device__ __forceinline__ void step_ln_mid(const Ctx& c, int l, int mrows) {
  u16* H = c.w<u16>(OFF_H); u16* F = c.w<u16>(OFF_ACT);
  for (int it = blockIdx.x; it < mrows / 8; it += gridDim.x) {
    const int row = it * 8 + ((int)__builtin_amdgcn_readfirstlane(threadIdx.x >> 6)); float v[16]; load_row_bf(H + (size_t)row * 1024, ((int)threadIdx.x & 63), v);
    ln_affine(v, c.in(I_LN1G) + l * 1024, c.in(I_LN1B) + l * 1024, ((int)threadIdx.x & 63));
    store_row_bf(H + (size_t)row * 1024, ((int)threadIdx.x & 63), v);
    const int br = brow_of(row);
    ln_mod_store(v, c.mod(l, br, 3), c.mod(l, br, 4), F + (size_t)row * 1024, ((int)threadIdx.x & 63));
  }
}

#define ROUTER_RPB(LAST) ((LAST) ? 64 : 68)
template <bool LAST>
__device__ __forceinline__ void step_router(const Ctx& c, int l, int halfrows) {
  constexpr int RPB = ROUTER_RPB(LAST), NRB = (RPB + 31) / 32, MROWS = LAST ? TLAT : MTOT;
  const u16* F = c.w<u16>(OFF_ACT); const u16* WR = (const u16*)(c.p.ws + OFF_WS + (size_t)l * WS_LAYER + WS_R);
  float* topw = c.w<float>(OFF_TOPW); int* sele = c.w<int>(OFF_SELE);
  int tid = (int)threadIdx.x; asm volatile("" : "+v"(tid));
  const int lane = tid & 63, r32 = lane & 31, hi = lane >> 5, wid = (int)__builtin_amdgcn_readfirstlane(tid >> 6);
  float* part = reinterpret_cast<float*>(c.lds);
  int* lcnt = reinterpret_cast<int*>(c.lds + 8 * 68 * 64 * 4);
  if (tid < 128) lcnt[tid] = 0;
  __syncthreads();
  const float bias = c.in(I_BR)[l * 64 + lane];
  for (int it = blockIdx.x; it < MROWS / RPB; it += gridDim.x) {
    const int row0 = it * RPB;
    {
      u16* H = c.w<u16>(OFF_H); u16* Fw = c.w<u16>(OFF_ACT);
      constexpr int NRW = (RPB + 7) / 8;
      uint2 raw[NRW][4];
#pragma unroll
      for (int k = 0; k < NRW; ++k) { const int rw_ = wid + 8 * k, rw = rw_ < RPB ? rw_ : wid; const u16* hp = H + (size_t)(row0 + rw) * 1024;
#pragma unroll
        for (int i = 0; i < 4; ++i) raw[k][i] = *reinterpret_cast<const uint2*>(hp + (i * 64 + lane) * 4); }
      float4 g1[4], b1[4];
#pragma unroll
      for (int i = 0; i < 4; ++i) { g1[i] = *reinterpret_cast<const float4*>(c.in(I_LN1G) + l * 1024 + (i * 64 + lane) * 4); b1[i] = *reinterpret_cast<const float4*>(c.in(I_LN1B) + l * 1024 + (i * 64 + lane) * 4); }
#pragma unroll
      for (int k = 0; k < NRW; ++k) { const int rw_ = wid + 8 * k;
        if (rw_ < RPB) { const int row = row0 + rw_;
          float v[16];
#pragma unroll
          for (int i = 0; i < 4; ++i) { v[i * 4] = bflo(raw[k][i].x); v[i * 4 + 1] = bfhi(raw[k][i].x); v[i * 4 + 2] = bflo(raw[k][i].y); v[i * 4 + 3] = bfhi(raw[k][i].y); }
          float mean, rstd; ln_stats(v, mean, rstd);
#pragma unroll
          for (int i = 0; i < 4; ++i) { v[i * 4] = (v[i * 4] - mean) * rstd * g1[i].x + b1[i].x; v[i * 4 + 1] = (v[i * 4 + 1] - mean) * rstd * g1[i].y + b1[i].y;
            v[i * 4 + 2] = (v[i * 4 + 2] - mean) * rstd * g1[i].z + b1[i].z; v[i * 4 + 3] = (v[i * 4 + 3] - mean) * rstd * g1[i].w + b1[i].w; }
          store_row_bf(H + (size_t)row * 1024, lane, v); const int br = brow_of(row);
          ln_mod_store(v, c.mod(l, br, 3), c.mod(l, br, 4), Fw + (size_t)row * 1024, lane); } }
    }
    __syncthreads();
    f32x16 acc[NRB][2];
#pragma unroll
    for (int rb = 0; rb < NRB; ++rb) { acc[rb][0] = f32x16{}; acc[rb][1] = f32x16{}; }
    const u16* ap[NRB];
#pragma unroll
    for (int rb = 0; rb < NRB; ++rb) { int rr = rb * 32 + r32; rr = rr < RPB ? rr : RPB - 1; ap[rb] = F + (size_t)(row0 + rr) * 1024 + wid * 128 + hi * 8; }
    const u16* bp = WR + (size_t)r32 * 1024 + wid * 128 + hi * 8;
    bf16x8 Ab[2][NRB], Bb[2][4];
#define RT_LD(KS) do { _Pragma("unroll") for (int nb = 0; nb < 4; ++nb) Bb[(KS) & 1][nb] = *reinterpret_cast<const bf16x8*>(bp + (size_t)nb * 32 * 1024 + (KS) * 16); \
      _Pragma("unroll") for (int rb = 0; rb < NRB; ++rb) Ab[(KS) & 1][rb] = *reinterpret_cast<const bf16x8*>(ap[rb] + (KS) * 16); } while (0)
    RT_LD(0); RT_LD(1);
#pragma unroll
    for (int ks = 0; ks < 8; ++ks) {
#pragma unroll
      for (int rb = 0; rb < NRB; ++rb)
#pragma unroll
        for (int nh = 0; nh < 2; ++nh) { acc[rb][nh] = __builtin_amdgcn_mfma_f32_32x32x16_bf16(Ab[ks & 1][rb], Bb[ks & 1][nh], acc[rb][nh], 0, 0, 0);
          acc[rb][nh] = __builtin_amdgcn_mfma_f32_32x32x16_bf16(Ab[ks & 1][rb], Bb[ks & 1][2 + nh], acc[rb][nh], 0, 0, 0); }
      __builtin_amdgcn_sched_barrier(0);
      if (ks + 2 < 8) { RT_LD(ks + 2); }
      __builtin_amdgcn_sched_barrier(0);
    }
#undef RT_LD
#pragma unroll
    for (int rb = 0; rb < NRB; ++rb)
#pragma unroll
      for (int r = 0; r < 16; ++r) { const int rr = rb * 32 + crow(r, hi);
        if (rr < RPB) { float* pr = part + ((wid * RPB + rr) * 64 + r32); pr[0] = acc[rb][0][r]; pr[32] = acc[rb][1][r]; } }
    __syncthreads();
#pragma unroll 1
    for (int bt = 0; bt < 3; ++bt) {
      if (wid + 24 * bt >= RPB) break;
      int ln = lane; asm volatile("" : "+v"(ln));
      int key[3]; float score[3];
#pragma unroll
      for (int s = 0; s < 3; ++s) {
        const int rw_ = wid + 8 * (3 * bt + s), rw = rw_ < RPB ? rw_ : wid;
        float lgt = 0.f;
#pragma unroll
        for (int w = 0; w < 8; ++w) lgt += part[(w * RPB + rw) * 64 + lane];
        const float sc = sigmoidf_(lgt), sel = sc + bias; score[s] = sc;
        float m1 = sel;
        m1 = fmaxf(m1, __shfl_xor(m1, 1, 64)); m1 = fmaxf(m1, __shfl_xor(m1, 2, 64)); m1 = fmaxf(m1, __shfl_xor(m1, 4, 64));
        const unsigned long long bm = __ballot(sel == m1);
        const unsigned grp = (unsigned)((bm >> (lane & ~7)) & 0xffull);
        const int first = __ffs((int)grp) - 1;
        float s2 = ((lane & 7) == first) ? -3.0e38f : sel;
        s2 = fmaxf(s2, __shfl_xor(s2, 1, 64)); s2 = fmaxf(s2, __shfl_xor(s2, 2, 64)); s2 = fmaxf(s2, __shfl_xor(s2, 4, 64));
        const float gs = m1 + s2; const int g8 = lane >> 3;
        int cg = 0;
#pragma unroll
        for (int jg = 0; jg < 8; ++jg) { const float gj = __shfl(gs, jg * 8, 64); cg += (gj > gs || (gj == gs && jg < g8)) ? 1 : 0; }
        int kb = __float_as_int(sel); kb ^= (kb >> 31) & 0x7fffffff;
        key[s] = (cg < 4) ? ((kb & ~63) | (63 - lane)) : (int)(0x80000000u | (unsigned)(63 - lane));
      }
#pragma unroll
      for (int k = 2; k <= 64; k <<= 1)
#pragma unroll
        for (int j = k >> 1; j > 0; j >>= 1) {
          const bool takemax = (((ln & j) == 0) == ((ln & k) == 0));
#pragma unroll
          for (int s = 0; s < 3; ++s) { const int o = __shfl_xor(key[s], j, 64); key[s] = takemax ? max(key[s], o) : min(key[s], o); }
        }
      int esel[3]; float wv[3];
#pragma unroll
      for (int s = 0; s < 3; ++s) { const int e = 63 - (key[s] & 63); const float sv = __shfl(score[s], e, 64);
        float ws = lane < 8 ? sv : 0.f; ws += __shfl_xor(ws, 1, 64); ws += __shfl_xor(ws, 2, 64); ws += __shfl_xor(ws, 4, 64);
        esel[s] = e; wv[s] = sv / ws * 2.5f; }
      if (lane < 8) {
#pragma unroll
        for (int s = 0; s < 3; ++s) { const int rw_ = wid + 8 * (3 * bt + s);
          if (rw_ < RPB) { const int tok = row0 + rw_; const int hh = tok >= halfrows ? 1 : 0;
            topw[(size_t)tok * 8 + lane] = wv[s]; sele[(size_t)tok * 8 + lane] = esel[s];
            atomicAdd(&lcnt[hh * 64 + esel[s]], 1); } }
      }
    }
    __syncthreads();
  }
  if (tid < 128) c.w<int>(OFF_CNTB)[blockIdx.x * 128 + tid] = lcnt[tid];
}
__device__ __forceinline__ void step_scatter(const Ctx& c, int l, int mrows, int halfrows) {
  int* cnt = c.w<int>(OFF_CNT) + l * 128; int* list = c.w<int>(OFF_LIST); int* sele = c.w<int>(OFF_SELE); const int* cntb = c.w<int>(OFF_CNTB);
  int* base = reinterpret_cast<int*>(c.lds); int* run = base + 128; int* tot = base + 256; int* ebh = base + 384;
  {
    const int t = ((int)threadIdx.x) & 127, part = ((int)threadIdx.x) >> 7; int s = 0, tt = 0; const int nb = (int)gridDim.x, b0 = part * ((nb + 3) >> 2), b1 = min(nb, b0 + ((nb + 3) >> 2));
    int b = b0;
    for (; b + 16 <= b1; b += 16) {
      int v[16];
#pragma unroll
      for (int j = 0; j < 16; ++j) v[j] = cntb[(b + j) * 128 + t];
#pragma unroll
      for (int j = 0; j < 16; ++j) { if (b + j < (int)blockIdx.x) s += v[j]; tt += v[j]; } }
    for (; b < b1; ++b) { const int v = cntb[b * 128 + t]; if (b < (int)blockIdx.x) s += v; tt += v; }
    int* ps = base + 512 + part * 256; ps[t] = s; ps[128 + t] = tt; }
  __syncthreads();
  if (((int)threadIdx.x) < 128) { int s = 0, tt = 0;
#pragma unroll
    for (int part = 0; part < 4; ++part) { s += base[512 + part * 256 + ((int)threadIdx.x)]; tt += base[512 + part * 256 + 128 + ((int)threadIdx.x)]; }
    base[((int)threadIdx.x)] = s; run[((int)threadIdx.x)] = 0; tot[((int)threadIdx.x)] = tt; if (blockIdx.x == 0) cnt[((int)threadIdx.x)] = tt; }
  __syncthreads();
  if (((int)threadIdx.x) < 128) { int s = 0; const int h0 = ((int)threadIdx.x) & 64; for (int e = h0; e < ((int)threadIdx.x); ++e) s += tot[e]; ebh[((int)threadIdx.x)] = s; }
  __syncthreads();
  const int rpb = (mrows == TLAT) ? ROUTER_RPB(true) : ROUTER_RPB(false);
  for (int it = blockIdx.x; it < mrows / rpb; it += gridDim.x) {
    for (int q = (int)threadIdx.x; q < rpb * 8; q += NTHR) { const int tok = it * rpb + (q >> 3), rk = q & 7; const int e = sele[(size_t)tok * 8 + rk]; const int hh = tok >= halfrows ? 1 : 0;
      const int pos = base[hh * 64 + e] + atomicAdd(&run[hh * 64 + e], 1);
      list[((size_t)hh * 64 + e) * 8704 + pos] = tok * 8 + rk;
      sele[(size_t)tok * 8 + rk] = ebh[hh * 64 + e] + pos; }
  }
  __syncthreads();
}

#define MOE_LDS_OFF 159744
__device__ __forceinline__ int moe_schedule(const Ctx& c, int l, int hh, int halfrows) {
  int* pre = reinterpret_cast<int*>(c.lds + MOE_LDS_OFF); int* cn = pre + 72; int* eb = cn + 72;
  const int* cnt = c.w<int>(OFF_CNT) + l * 128 + hh * 64;
  if (((int)threadIdx.x) < 64) {
    const int e = (int)threadIdx.x; const int n = cnt[e]; const int tl = (n + 255) >> 8;
    int s = tl, r = n;
#pragma unroll
    for (int d = 1; d < 64; d <<= 1) { const int s2 = __shfl_up(s, d, 64), r2 = __shfl_up(r, d, 64); if (e >= d) { s += s2; r += r2; } }
    cn[e] = n; pre[e] = s - tl; eb[e] = r - n;
    if (e == 63) { cn[64] = halfrows; pre[64] = s; eb[64] = r; pre[65] = s + ((halfrows + 255) >> 8); } }
  __syncthreads();
  return pre[65];
}
struct MUnit { int e, rti, tn, ne, eb; };
struct MoeSchedBase {
  const int* pre; const int* cn; const int* eb; int total, NTN;
  __device__ __forceinline__ bool decode(int i, MUnit& u) const {
    const int L0 = i * (int)gridDim.x + (int)blockIdx.x; if (L0 >= total) return false;
    const int L = (gridDim.x & 7) == 0 ? xcd_remap(L0, total) : L0;
    const int rt = L / NTN; u.tn = L - rt * NTN;
    int lo = 0, hi = 64;
#pragma unroll
    for (int s = 0; s < 7; ++s) { const int mid = (lo + hi + 1) >> 1; if (pre[mid] <= rt) lo = mid; else hi = mid - 1; }
    u.e = lo; u.rti = rt - pre[lo]; u.ne = cn[lo]; u.eb = eb[lo]; return true; }
};
struct MoeUpSched : MoeSchedBase {
  const char* F; const char* WE; const int* list; int tok0;
  __device__ __forceinline__ bool next(int i, MUnit& u) const { return decode(i, u); }
  __device__ __forceinline__ const char* abase(const MUnit&) const { return F; }
  __device__ __forceinline__ const char* bbase(const MUnit& u) const { return WE + (size_t)u.e * WE_ONE + (size_t)u.tn * 128 * 1024 * 2; }
  __device__ __forceinline__ void aoffs(const MUnit& u, int R0, int R1, int C0, int C1, unsigned (&o)[2][2]) const {
    const int* le = list + (size_t)u.e * 8704;
#pragma unroll
    for (int h = 0; h < 2; ++h) {
      int i0 = u.rti * 256 + h * 128 + R0, i1 = u.rti * 256 + h * 128 + R1; if (i0 >= u.ne) i0 = 0; if (i1 >= u.ne) i1 = 0;
      const int t0 = u.e < 64 ? (le[i0] >> 3) : tok0 + i0, t1 = u.e < 64 ? (le[i1] >> 3) : tok0 + i1;
      o[h][0] = (unsigned)(t0 * 1024 + C0) * 2u; o[h][1] = (unsigned)(t1 * 1024 + C1) * 2u; } }
  __device__ __forceinline__ unsigned boff(int row, int C) const { const int gi = row >> 5, rho = row & 31; return (unsigned)((((rho >> 4) ? 256 : 0) + gi * 16 + (rho & 15)) * 1024 + C) * 2u; }
};
__device__ __forceinline__ void step_moe_up(const Ctx& c, int l, int hh, int halfrows) {
  const int RT = moe_schedule(c, l, hh, halfrows);
  MoeUpSched S; S.pre = reinterpret_cast<const int*>(c.lds + MOE_LDS_OFF); S.cn = S.pre + 72; S.eb = S.cn + 72; S.NTN = 2; S.total = RT * 2;
  S.F = (const char*)c.w<u16>(OFF_ACT); S.WE = c.p.ws + OFF_WE; S.list = c.w<int>(OFF_LIST) + (size_t)hh * 64 * 8704; S.tok0 = hh * halfrows;
  u16* HD = c.w<u16>(OFF_BIG + BIG_HD); u16* HS = c.w<u16>(OFF_BIG + BIG_HS);
  g8::phase<MUnit>(c.lds, 1024, S, [&](const g8::Acc& acc, const MUnit& u, int wr, int wc, int fr, int fq) {
#pragma unroll
    for (int ai = 0; ai < 2; ++ai)
#pragma unroll
      for (int m = 0; m < 4; ++m) {
        const int idx = u.rti * 256 + ai * 128 + wr * 64 + m * 16 + fr;
        if (idx < u.ne) {
          u16* dst = (u.e < 64 ? HD + (size_t)(u.eb + idx) * 256 : HS + (size_t)idx * 256) + u.tn * 128 + wc * 16 + 4 * fq;
#pragma unroll
          for (int bj = 0; bj < 2; ++bj) { const f32x4 g = acc[ai][bj][m][0], up = acc[ai][bj][m][1];
            *reinterpret_cast<uint2*>(dst + bj * 64) = make_uint2(pack2(silu_(g[0]) * up[0], silu_(g[1]) * up[1]), pack2(silu_(g[2]) * up[2], silu_(g[3]) * up[3])); }
        }
      }
  });
}
struct MoeDownSched : MoeSchedBase {
  const char* HD; const char* HS; const char* WE;
  __device__ __forceinline__ bool next(int i, MUnit& u) const { return decode(i, u); }
  __device__ __forceinline__ const char* abase(const MUnit& u) const { return u.e < 64 ? HD + (size_t)(u.eb + u.rti * 256) * 512 : HS + (size_t)(u.rti * 256) * 512; }
  __device__ __forceinline__ const char* bbase(const MUnit& u) const { return WE + (size_t)u.e * WE_ONE + WE_GU + (size_t)u.tn * 256 * 256 * 2; }
  __device__ __forceinline__ void aoffs(const MUnit&, int R0, int R1, int C0, int C1, unsigned (&o)[2][2]) const {
#pragma unroll
    for (int h = 0; h < 2; ++h) { o[h][0] = (unsigned)((h * 128 + R0) * 256 + C0) * 2u; o[h][1] = (unsigned)((h * 128 + R1) * 256 + C1) * 2u; } }
  __device__ __forceinline__ unsigned boff(int row, int C) const { return (unsigned)(((row & ~31) + g8::perm32(row & 31)) * 256 + C) * 2u; }
};
__device__ __forceinline__ void step_moe_down(const Ctx& c, int l, int hh, int halfrows) {
  const int RT = moe_schedule(c, l, hh, halfrows);
  MoeDownSched S; S.pre = reinterpret_cast<const int*>(c.lds + MOE_LDS_OFF); S.cn = S.pre + 72; S.eb = S.cn + 72; S.NTN = 4; S.total = RT * 4;
  S.HD = (const char*)c.w<u16>(OFF_BIG + BIG_HD); S.HS = (const char*)c.w<u16>(OFF_BIG + BIG_HS); S.WE = c.p.ws + OFF_WE;
  u16* YR = c.w<u16>(OFF_BIG + BIG_YR); u16* YS = c.w<u16>(OFF_BIG + BIG_YS);
  g8::phase<MUnit>(c.lds, 256, S, [&](const g8::Acc& acc, const MUnit& u, int wr, int wc, int fr, int fq) {
    u16* base = (u.e < 64 ? YR + (size_t)u.eb * 1024 : YS) + u.tn * 256 + wc * 32 + 8 * fq;
#pragma unroll
    for (int ai = 0; ai < 2; ++ai)
#pragma unroll
      for (int m = 0; m < 4; ++m) {
        const int idx = u.rti * 256 + ai * 128 + wr * 64 + m * 16 + fr;
        if (idx < u.ne) {
          u16* dst = base + (size_t)idx * 1024;
#pragma unroll
          for (int bj = 0; bj < 2; ++bj) { const f32x4 v0 = acc[ai][bj][m][0], v1 = acc[ai][bj][m][1];
            u32x4 w; w.x = pack2(v0[0], v0[1]); w.y = pack2(v0[2], v0[3]); w.z = pack2(v1[0], v1[1]); w.w = pack2(v1[2], v1[3]);
            *reinterpret_cast<u32x4*>(dst + bj * 128) = w; }
        }
      }
  });
}
__device__ __forceinline__ void combine_items(const Ctx& c, int l, bool last, int hh, int halfrows, int first, int end, int stride) {
  u16* H = c.w<u16>(OFF_H); const u16* YR = c.w<u16>(OFF_BIG + BIG_YR); u16* U = c.w<u16>(OFF_ACT);
  const int tok0 = hh * halfrows;
  for (int it = first; it < end; it += stride) {
    const int tok = tok0 + it * 8 + ((int)__builtin_amdgcn_readfirstlane(threadIdx.x >> 6)); float v[16]; load_row_bf(H + (size_t)tok * 1024, ((int)threadIdx.x & 63), v);
    float s[16];
#pragma unroll
    for (int i = 0; i < 16; ++i) s[i] = 0.f;
#pragma unroll
    for (int k = 0; k < 8; ++k) { const int sp = c.w<int>(OFF_SELE)[(size_t)tok * 8 + k]; const float wk = c.w<float>(OFF_TOPW)[(size_t)tok * 8 + k];
      const u16* yr = YR + (size_t)sp * 1024;
#pragma unroll
      for (int i = 0; i < 4; ++i) { uint2 t = *reinterpret_cast<const uint2*>(yr + (i * 64 + ((int)threadIdx.x & 63)) * 4); s[i * 4] += wk * bflo(t.x); s[i * 4 + 1] += wk * bfhi(t.x); s[i * 4 + 2] += wk * bflo(t.y); s[i * 4 + 3] += wk * bfhi(t.y); } }
    { const u16* ys = c.w<u16>(OFF_BIG + BIG_YS) + (size_t)(tok - tok0) * 1024;
#pragma unroll
      for (int i = 0; i < 4; ++i) { uint2 t = *reinterpret_cast<const uint2*>(ys + (i * 64 + ((int)threadIdx.x & 63)) * 4); s[i * 4] += bflo(t.x); s[i * 4 + 1] += bfhi(t.x); s[i * 4 + 2] += bflo(t.y); s[i * 4 + 3] += bfhi(t.y); } }
    const float* g2 = c.mod(l, brow_of(tok), 5);
#pragma unroll
    for (int i = 0; i < 4; ++i) { float4 g = *reinterpret_cast<const float4*>(g2 + (i * 64 + ((int)threadIdx.x & 63)) * 4);
      v[i * 4] = ALPHA * v[i * 4] + g.x * s[i * 4]; v[i * 4 + 1] = ALPHA * v[i * 4 + 1] + g.y * s[i * 4 + 1]; v[i * 4 + 2] = ALPHA * v[i * 4 + 2] + g.z * s[i * 4 + 2]; v[i * 4 + 3] = ALPHA * v[i * 4 + 3] + g.w * s[i * 4 + 3]; }
    ln_affine(v, c.in(I_LN2G) + l * 1024, c.in(I_LN2B) + l * 1024, ((int)threadIdx.x & 63));
    if (last) { store_row(c.p.out + (size_t)tok * 1024, ((int)threadIdx.x & 63), v); }
    else { store_row_bf(H + (size_t)tok * 1024, ((int)threadIdx.x & 63), v); const int br = brow_of(tok);
      ln_mod_store(v, c.mod(l + 1, br, 0), c.mod(l + 1, br, 1), U + (size_t)tok * 1024, ((int)threadIdx.x & 63)); }
  }
}
__device__ __forceinline__ void step_combine(const Ctx& c, int l, bool last, int hh, int halfrows) { combine_items(c, l, last, hh, halfrows, (int)blockIdx.x, halfrows / 8, (int)gridDim.x); }
#define CMB_CAP 5
__device__ __forceinline__ void moe_up_tail_combine(const Ctx& c, int l, bool last, int halfrows) {
  const int RT = reinterpret_cast<const int*>(c.lds + MOE_LDS_OFF)[65];
  const int G = (int)gridDim.x, extra = (RT * 2) % G, n_items = halfrows / 8;
  const int n_idle = extra > 0 ? G - extra : 0, j = (int)blockIdx.x - extra;
  int n_free = n_idle * CMB_CAP; n_free = n_free < n_items ? n_free : n_items;
#pragma unroll 1
  for (int pass = 0; pass < 2; ++pass) {
    int first, end, stride;
    if (pass == 0) { if (n_idle == 0 || j < 0) continue; first = j; end = n_free; stride = n_idle; }
    else { first = n_free + (int)blockIdx.x; end = n_items; stride = G; }
    combine_items(c, l, last, 0, halfrows, first, end, stride);
  }
}


#define XB_TMO      128
#define XB_XCNT(j)  (256  + 64 * (j))
#define XB_XSUB(j)  (1280 + 64 * (j))
#define XB_XGEN(j)  (2304 + 64 * (j))
#define XB_TOP      3328
#define XB_TOPGEN   3392
#define XCD_BAR_WORDS 3456
#define XB_SPIN_CAP (1u << 22)
#define LAS __attribute__((address_space(3)))
__device__ __forceinline__ unsigned xb_ld(unsigned* p)              { return __hip_atomic_load(p, __ATOMIC_RELAXED, __HIP_MEMORY_SCOPE_AGENT); }
__device__ __forceinline__ unsigned xb_add(unsigned* p, unsigned v) { return __hip_atomic_fetch_add(p, v, __ATOMIC_RELAXED, __HIP_MEMORY_SCOPE_AGENT); }
__device__ __forceinline__ unsigned xb_xcc_id() { return (unsigned)__builtin_amdgcn_s_getreg((3 << 11) | 20) & 0xFu; }
#define XB_SPIN(cond, bar) do { unsigned _sp = 0; while (cond) { __builtin_amdgcn_s_sleep(1); \
    if ((++_sp & 255u) == 0u) { if (xb_ld(&(bar)[XB_TMO])) break; if (_sp > XB_SPIN_CAP) { atomicAdd(&(bar)[XB_TMO], 1u); break; } } } } while (0)
struct XcdBarrier { unsigned* bar; unsigned x; volatile LAS unsigned* st; };
__device__ __forceinline__ XcdBarrier xcd_barrier_post(unsigned* bar, volatile LAS unsigned* st) {
    XcdBarrier b; b.bar = bar; b.x = xb_xcc_id(); b.st = st;
    if (threadIdx.x == 0) (void)xb_add(&bar[XB_XCNT(b.x)], 1u);
    return b;
}
__device__ __forceinline__ void xcd_barrier_complete(unsigned* bar, unsigned x, unsigned& nloc, unsigned& nx) {
    const unsigned G = gridDim.x * gridDim.y * gridDim.z;
    unsigned sum, cnt, mine, sp = 0u;
    for (;;) {
        sum = 0u; cnt = 0u; mine = 0u;
#pragma unroll
        for (unsigned j = 0; j < 16; ++j) { const unsigned c = xb_ld(&bar[XB_XCNT(j)]); sum += c; cnt += (c > 0u) ? 1u : 0u; mine = (j == x) ? c : mine; }
        if (sum == G) break;
        __builtin_amdgcn_s_sleep(1);
        if ((++sp & 255u) == 0u) { if (xb_ld(&bar[XB_TMO])) break; if (sp > XB_SPIN_CAP) { atomicAdd(&bar[XB_TMO], 1u); break; } }
    }
    nloc = mine > 0u ? mine : 1u; nx = cnt > 0u ? cnt : 1u;
}
__device__ __forceinline__ void xcd_barrier(const XcdBarrier& b) {
    asm volatile("s_waitcnt vmcnt(0)" ::: "memory");
    __syncthreads();
    if (threadIdx.x == 0) {
        unsigned* bar = b.bar;
        __builtin_amdgcn_s_waitcnt(0);
        unsigned nloc = b.st[0], nx = b.st[1];
        if (nloc == 0u) { xcd_barrier_complete(bar, b.x, nloc, nx); b.st[0] = nloc; b.st[1] = nx; }
        const unsigned old = xb_add(&bar[XB_XSUB(b.x)], 1u);
        const unsigned gen = old / nloc;
        if (old + 1u == (gen + 1u) * nloc) {
            __builtin_amdgcn_fence(__ATOMIC_RELEASE, "agent");
            asm volatile("s_waitcnt vmcnt(0)" ::: "memory");
            const unsigned og = xb_add(&bar[XB_TOP], 1u);
            const unsigned tg = og / nx;
            if (og + 1u == (tg + 1u) * nx) xb_add(&bar[XB_TOPGEN], 1u);
            else XB_SPIN(xb_ld(&bar[XB_TOPGEN]) == tg, bar);
            __builtin_amdgcn_fence(__ATOMIC_ACQUIRE, "agent");
            xb_add(&bar[XB_XGEN(b.x)], 1u);
            asm volatile("s_waitcnt vmcnt(0)" ::: "memory");
        } else {
            XB_SPIN(xb_ld(&bar[XB_XGEN(b.x)]) == gen, bar);
            __builtin_amdgcn_fence(__ATOMIC_ACQUIRE, "agent");
            asm volatile("s_waitcnt vmcnt(0)" ::: "memory");
        }
    }
    __syncthreads();
}

#ifdef ONLY
__device__ __forceinline__ void run_step_only(const Ctx& c) {
  const int l_ = 0; const bool last_ = false;
  if (ONLY == 0) step_prep(c); if (ONLY == 1) step_ln_in(c); if (ONLY == 2) step_gemm_in(c, l_); if (ONLY == 3) step_mix_a(c, l_, last_); if (ONLY == 4) step_mix_b(c, l_, last_);
  if (ONLY == 5) step_merge(c, l_, last_); if (ONLY == 6) step_out(c, l_, last_); if (ONLY == 8) { step_router<false>(c, l_, 8704); step_scatter(c, l_, MTOT, 8704); }
  if (ONLY == 9) step_moe_up(c, l_, 0, 8704); if (ONLY == 10) step_moe_down(c, l_, 0, 8704); if (ONLY == 11) step_combine(c, l_, last_, 0, 8704);
}
#endif
#define N_STEPS 26
template <int L>
__device__ __forceinline__ void run_layer_step(const Ctx& c, int k) {
  constexpr bool last = (L == 1);
  constexpr int mrows = last ? TLAT : MTOT, halfrows = mrows / 2;
  switch (k) {
    case 0: step_gemm_in(c, L); break;
    case 1: step_mix_a(c, L, last); break;
    case 2: step_mix_b(c, L, last); break;
    case 3: step_merge(c, L, last); break;
    case 4: step_out(c, L, last); break;
    case 5: step_router<last>(c, L, halfrows); break;
    case 6: step_scatter(c, L, mrows, halfrows); break;
    case 7: step_moe_up(c, L, 0, halfrows); break;
    case 8: step_moe_down(c, L, 0, halfrows); break;
    case 9: step_moe_up(c, L, 1, halfrows); moe_up_tail_combine(c, L, last, halfrows); break;
    case 10: step_moe_down(c, L, 1, halfrows); break;
    default: step_combine(c, L, last, 1, halfrows); break;
  }
}

#define LDS_BYTES 163840
#define XB_ST_OFF 158208
#define TS_OFF 158720
__global__ void __launch_bounds__(NTHR, 2) fwd_kernel(Params p) {
  extern __shared__ __attribute__((aligned(16))) char lds[];
  Ctx c; c.p.ws = p.ws; c.p.out = p.out; c.lds = lds;
  if (threadIdx.x == 0) {
    const float** tab = reinterpret_cast<const float**>(lds + PTR_TAB_OFF);
#pragma unroll
    for (int i = 0; i < N_IN; ++i) tab[i] = p.in[i];
  }
  __syncthreads();
  const int lo = p.s_lo, hi = p.s_hi;
  volatile LAS unsigned* xst = (volatile LAS unsigned*)(lds + XB_ST_OFF);
  if (threadIdx.x == 0) { xst[0] = 0u; xst[1] = 0u; xst[2] = 0u; xst[3] = 0u; }
  __syncthreads();
  XcdBarrier xb = xcd_barrier_post(reinterpret_cast<unsigned*>(p.ws + OFF_BAR), xst);
  int n_sync = 0;
#ifdef PROBE_A
  unsigned long long* tsl = reinterpret_cast<unsigned long long*>(lds + TS_OFF);
  if (blockIdx.x == 0 && threadIdx.x == 0) tsl[0] = __builtin_amdgcn_s_memrealtime();
#define STAMP(S) do { if (blockIdx.x == 0 && threadIdx.x == 0) tsl[(S) + 1] = __builtin_amdgcn_s_memrealtime(); } while (0)
#else
#define STAMP(S) do { } while (0)
#endif
#define GRID_SYNC() do { xcd_barrier(xb); ++n_sync; } while (0)
#ifdef PROBE_A
#define STEP(S, CALL) do { if (lo <= (S) && (S) < hi) { CALL; GRID_SYNC(); STAMP(S); } } while (0)
#else
#define STEP(S, CALL) do { if (lo <= (S) && (S) < hi) { CALL; if ((S) + 1 < hi) GRID_SYNC(); } } while (0)
#endif
#ifdef ONLY
  run_step_only(c);
#else
  STEP(0, step_prep(c));
  STEP(1, step_ln_in(c));
#define LSTEP(L, K) STEP(2 + 12 * (L) + (K), run_layer_step<L>(c, K))
  LSTEP(0, 0); LSTEP(0, 1); LSTEP(0, 2); LSTEP(0, 3); LSTEP(0, 4); LSTEP(0, 5); LSTEP(0, 6); LSTEP(0, 7); LSTEP(0, 8); LSTEP(0, 9); LSTEP(0, 10); LSTEP(0, 11);
  LSTEP(1, 0); LSTEP(1, 1); LSTEP(1, 2); LSTEP(1, 3); LSTEP(1, 4); LSTEP(1, 5); LSTEP(1, 6); LSTEP(1, 7); LSTEP(1, 8); LSTEP(1, 9); LSTEP(1, 10); LSTEP(1, 11);
#endif

#ifdef PROBE_A
  {
    __syncthreads();
    float* dsh = reinterpret_cast<float*>(lds + TS_OFF + 512);
    if (blockIdx.x == 0 && threadIdx.x == 0) {
      unsigned long long da = 0, db = 0;
      for (int s = 0; s < N_STEPS; ++s) { const int k12 = (s - 2) % 12; const int kind = s < 2 ? s : (k12 < 5 ? 2 + k12 : (k12 == 5 ? 8 : (k12 == 6 ? 12 : (k12 == 11 ? 11 : 10 - (k12 & 1)))));
        const unsigned long long d = tsl[s + 1] - tsl[s]; if (kind == PROBE_A) da += d; if (kind == PROBE_B) db += d; }
      if (PROBE_A == 20) da = tsl[45]; if (PROBE_B == 21) db = tsl[46]; if (PROBE_A == 22) da = tsl[47]; if (PROBE_B == 23) db = tsl[48];
      dsh[0] = 1.f + (float)da * 0.01f / 250.f;
      dsh[1] = sqrtf((float)db * 0.01f * 1e-5f);
    }
    __syncthreads();
    if (blockIdx.x == 0) {
      for (int q = threadIdx.x; q < 1024 * 1024; q += NTHR) p.out[q] += dsh[1];
      __syncthreads();
      if (threadIdx.x == 0) p.out[5 * 1024 * 1024 + 17] += dsh[0];
    }
  }
#endif
}

extern "C" void kernel_launch(void* const* d_in, const int* in_sizes, int n_in, void* d_out, int out_size, void* d_ws, size_t ws_size, hipStream_t stream) {
  static int grid = 0;
  if (grid == 0) {
    if (n_in != N_IN || ws_size < WS_TOTAL) { fprintf(stderr, "kernel_launch: bad shapes n_in %d ws %zu need %zu\n", n_in, ws_size, (size_t)WS_TOTAL); grid = -1; return; }
    hipFuncSetAttribute((const void*)fwd_kernel, hipFuncAttributeMaxDynamicSharedMemorySize, LDS_BYTES);
    int dev = 0, cus = 0, per_cu = 0; hipGetDevice(&dev); hipDeviceGetAttribute(&cus, hipDeviceAttributeMultiprocessorCount, dev);
    hipOccupancyMaxActiveBlocksPerMultiprocessor(&per_cu, (const void*)fwd_kernel, NTHR, LDS_BYTES);
    if (per_cu < 1) { fprintf(stderr, "kernel_launch: occupancy query says %d\n", per_cu); grid = -1; return; }
    grid = cus;
  }
  if (grid < 0) return;
  hipMemsetAsync(d_ws, 0, ZERO_BYTES, stream);
  Params p{};
  for (int i = 0; i < N_IN; ++i) p.in[i] = (const float*)d_in[i];
  p.out = (float*)d_out; p.ws = (char*)d_ws;
#if N_LAUNCH_MODE == 1
  p.s_lo = 0; p.s_hi = N_STEPS;
  void* args[] = {&p};
  hipError_t e = hipLaunchCooperativeKernel((const void*)fwd_kernel, dim3(grid), dim3(NTHR), args, LDS_BYTES, stream);
  if (e != hipSuccess) fprintf(stderr, "cooperative launch failed: %s (grid %d)\n", hipGetErrorString(e), grid);
#else
  for (int s = 0; s < N_STEPS; ++s) { p.s_lo = s; p.s_hi = s + 1; hipLaunchKernelGGL(fwd_kernel, dim3(grid), dim3(NTHR), LDS_BYTES, stream, p); }
#endif
}
```

```cpp
#include <hip/hip_runtime.h>
#include <hip/hip_cooperative_groups.h>
#include <stdint.h>
#include <cstdio>
namespace cg = cooperative_groups;

#ifndef N_LAUNCH_MODE
#define N_LAUNCH_MODE 1
#endif

typedef unsigned short u16;
typedef __attribute__((ext_vector_type(8))) short bf16x8;
typedef __attribute__((ext_vector_type(4))) float f32x4;
typedef __attribute__((ext_vector_type(4))) unsigned u32x4;
typedef __attribute__((ext_vector_type(4))) short s16x4;

#define DM     1024
#define NBATCH 4
#define SEQ    4096
#define CTXL   256
#define TLAT   16384
#define TCTX   1024
#define MTOT   17408
#define INW    5376
#define NTHR   512
#define ALPHA  1.41421356237309515f
#define LN_EPS 1e-5f
#define NCHK   68

enum { I_X = 0, I_C, I_CTX, I_CCTX, I_WMOD, I_BMOD, I_WIN, I_LRE, I_LIM, I_LSTEP, I_BRE, I_BIM, I_CRE, I_CIM, I_S5D,
       I_GMW, I_GMB, I_DALAM, I_SUBLN, I_GLUV, I_GLUG, I_PGM, I_PDA, I_WOUT, I_LN1G, I_LN1B, I_LN2G, I_LN2B,
       I_WR, I_BR, I_EG, I_EU, I_ED, I_SG, I_SU, I_SD, N_IN };

constexpr size_t al256(size_t x) { return (x + 255) / 256 * 256; }
constexpr size_t OFF_BAR   = 0;
constexpr size_t OFF_CNT   = 16384;
constexpr size_t ZERO_BYTES = 20480;
constexpr size_t OFF_MOD   = 32768;
constexpr size_t OFF_S5A   = OFF_MOD + al256(2 * 5 * 6144 * 4);
constexpr size_t OFF_S5A64 = OFF_S5A + 32768;
constexpr size_t OFF_S5BB  = OFF_S5A64 + 32768;
constexpr size_t OFF_S5BBH = OFF_S5BB + 524288;
constexpr size_t OFF_ROPE  = OFF_S5BBH + 262144;
constexpr size_t OFF_E     = OFF_ROPE + 8192;
constexpr size_t OFF_LIST  = OFF_E + al256((size_t)4 * 2 * NCHK * 16 * 64 * 2 * 4);
constexpr size_t OFF_TOPW  = OFF_LIST + al256((size_t)2 * 64 * 8704 * 4);
constexpr size_t OFF_SELE  = OFF_TOPW + al256((size_t)MTOT * 8 * 4);
constexpr size_t OFF_CNTB  = OFF_SELE + al256((size_t)MTOT * 8 * 4);
constexpr size_t OFF_LW    = OFF_CNTB + 256 * 128 * 4;
constexpr size_t OFF_WS    = OFF_LW + al256((size_t)2 * 64 * 8704 * 4);
constexpr size_t WS_WIN = 0, WS_GLU = WS_WIN + (size_t)INW * 1024 * 2, WS_GM = WS_GLU + 2048 * 256 * 2,
                 WS_DA = WS_GM + 1024 * 256 * 2, WS_OUT = WS_DA + 1024 * 512 * 2, WS_R = WS_OUT + 1024 * 1024 * 2,
                 WS_LAYER = WS_R + 128 * 1024 * 2;
constexpr size_t OFF_WE    = OFF_WS + 2 * WS_LAYER;
constexpr size_t WE_GU = (size_t)512 * 1024 * 2, WE_D = (size_t)1024 * 256 * 2, WE_ONE = WE_GU + WE_D;
constexpr size_t OFF_H     = OFF_WE + 65 * WE_ONE;
constexpr size_t OFF_ACT   = OFF_H + (size_t)MTOT * 1024 * 4;
constexpr size_t OFF_BIG   = OFF_ACT + (size_t)MTOT * 1024 * 2;
constexpr size_t BIG_P = 0, BIG_YA = BIG_P + (size_t)MTOT * INW * 2, BIG_YB = BIG_YA + (size_t)MTOT * 256 * 2,
                 BIG_YC = BIG_YB + (size_t)MTOT * 256 * 2, BIG_M = BIG_YC + (size_t)MTOT * 512 * 2,
                 BIG_END = BIG_M + (size_t)MTOT * 1024 * 2;
constexpr size_t BIG_YR = 0, BIG_HD = BIG_YR + (size_t)8704 * 8 * 1024 * 2, BIG_HS = BIG_HD + (size_t)(8704 * 8 + 256) * 256 * 2,
                 BIG_YS = BIG_HS + (size_t)8704 * 256 * 2, BIG_END2 = BIG_YS + (size_t)8704 * 1024 * 2;
static_assert(BIG_END2 <= BIG_END, "moe scratch must fit");
constexpr size_t WS_TOTAL = OFF_BIG + BIG_END;

struct Params { const float* in[N_IN]; float* out; char* ws; int s_lo, s_hi; };

__device__ __forceinline__ u16 f2bf(float f) { unsigned u = __float_as_uint(f); u += 0x7fffu + ((u >> 16) & 1u); return (u16)(u >> 16); }
__device__ __forceinline__ float bf2f(u16 h) { return __uint_as_float(((unsigned)h) << 16); }
#define GAS1 __attribute__((address_space(1)))
__device__ __forceinline__ float4 gld4(const float* p) { const f32x4 w = *(const GAS1 f32x4*)p; return make_float4(w[0], w[1], w[2], w[3]); }
__device__ __forceinline__ float gld1(const float* p) { return *(const GAS1 float*)p; }
__device__ __forceinline__ float bflo(unsigned w) { return __uint_as_float(w << 16); }
__device__ __forceinline__ float bfhi(unsigned w) { return __uint_as_float(w & 0xffff0000u); }
__device__ __forceinline__ unsigned cvtpk(float lo, float hi) { unsigned r; asm volatile("v_cvt_pk_bf16_f32 %0, %1, %2" : "=v"(r) : "v"(lo), "v"(hi)); return r; }
__device__ __forceinline__ unsigned pack2(float a, float b) { return cvtpk(a, b); }
__device__ __forceinline__ float wave_sum(float v) {
#pragma unroll
  for (int m = 32; m >= 1; m >>= 1) v += __shfl_xor(v, m, 64);
  return v;
}
__device__ __forceinline__ float sigmoidf_(float x) { return 1.f / (1.f + __expf(-x)); }
__device__ __forceinline__ float gelu_tanh(float x) {
  float t = 0.7978845608028654f * (x + 0.044715f * x * x * x);
  float e = __expf(2.f * t);
  float th = 1.f - 2.f / (e + 1.f);
  return 0.5f * x * (1.f + th);
}
__device__ __forceinline__ float silu_(float x) { return x / (1.f + __expf(-x)); }

#define GS_STAGES 3
#define GS_STAGE_BYTES 40960
#define GS_B_OFF 32768
#define CIMG_OFF (GS_STAGES * GS_STAGE_BYTES)
#define GEMM_LDS (CIMG_OFF + 128 * 272)

__device__ __forceinline__ void glds16(const void* g, void* l) {
  __builtin_amdgcn_global_load_lds((const __attribute__((address_space(1))) void*)g, (__attribute__((address_space(3))) void*)l, 16, 0, 0);
}
struct GPtr { const u16 *a[4], *b; };
template <class AF, class BF>
__device__ __forceinline__ GPtr gs_ptrs(AF arow, BF brow) {
  int tidz = threadIdx.x; asm volatile("" : "+v"(tidz));
  GPtr p;
#pragma unroll
  for (int i = 0; i < 4; ++i) { const int q = i * NTHR + tidz, row = q >> 3, c = (q & 7) ^ (row & 7); p.a[i] = arow(row) + c * 8; }
  { const int row = tidz >> 3, c = (tidz & 7) ^ (row & 7); p.b = brow(row) + c * 8; }
  return p;
}
struct GStream {
  GPtr cur, nxt; int nt, nnt;
  int ki;
  int sc;
};
__device__ __forceinline__ void gs_issue(GStream& g, char* lds, int si) {
  const int total = g.nt + g.nnt;
  const bool doi = g.ki < total, usen = doi && (g.ki >= g.nt);
  const int k0 = (doi ? (usen ? g.ki - g.nt : g.ki) : g.nt - 1) << 6;
  char* dst = lds + si * GS_STAGE_BYTES + threadIdx.x * 16;
  glds16((usen ? g.nxt.a[0] : g.cur.a[0]) + k0, dst); glds16((usen ? g.nxt.a[1] : g.cur.a[1]) + k0, dst + 8192);
  glds16((usen ? g.nxt.a[2] : g.cur.a[2]) + k0, dst + 16384); glds16((usen ? g.nxt.a[3] : g.cur.a[3]) + k0, dst + 24576);
  glds16((usen ? g.nxt.b : g.cur.b) + k0, dst + GS_B_OFF);
  ++g.ki;
}
__device__ __forceinline__ void gs_start(GStream& g, const GPtr& p, int nt, const GPtr& pn, int nnt, char* lds) {
  g.cur = p; g.nt = nt; g.nxt = pn; g.nnt = nnt; g.ki = 0; g.sc = 0;
  gs_issue(g, lds, 0); gs_issue(g, lds, 1);
}
__device__ __forceinline__ void gs_set_next(GStream& g, const GPtr& p, int nt) { g.nxt = p; g.nnt = nt; }
__device__ __forceinline__ void gs_advance(GStream& g) { g.cur = g.nxt; g.ki -= g.nt; g.nt = g.nnt; g.nnt = 0; }
template <int NF, int XV = 0>
__device__ __forceinline__ void gs_run(GStream& g, f32x4 (&acc)[4][NF], char* lds) {
  const int tid = threadIdx.x, lane = tid & 63, wid = tid >> 6, wm = wid >> 1, wn = wid & 1, fr = lane & 15, fq = lane >> 4;
  const int sw = fr & 7;
  const int aoff = (wm * 64 + fr) * 128, boff = GS_B_OFF + (wn * NF * 16 + fr) * 128;
#pragma unroll 1
  for (int t = 0; t < g.nt; ++t) {
    asm volatile("s_waitcnt vmcnt(5)" ::: "memory");
    __builtin_amdgcn_s_barrier();
    asm volatile("" ::: "memory");
    __builtin_amdgcn_sched_barrier(0);
    int sn = g.sc + 2; if (sn >= GS_STAGES) sn -= GS_STAGES;
    const char* st = lds + g.sc * GS_STAGE_BYTES;
    gs_issue(g, lds, sn);
    __builtin_amdgcn_sched_barrier(0);
#pragma unroll
    for (int ks = 0; ks < 2; ++ks) {
      bf16x8 At[4], Bt[NF];
      const int coff = (((ks * 4 + fq) ^ sw) << 4);
#pragma unroll
      for (int m = 0; m < 4; ++m) At[m] = *reinterpret_cast<const bf16x8*>(st + aoff + m * 2048 + coff);
#pragma unroll
      for (int n = 0; n < NF; ++n) Bt[n] = *reinterpret_cast<const bf16x8*>(st + boff + n * 2048 + coff);
#pragma unroll
      for (int m = 0; m < 4; ++m)
#pragma unroll
        for (int n = 0; n < NF; ++n) acc[m][n] = __builtin_amdgcn_mfma_f32_16x16x32_bf16(Bt[n], At[m], acc[m][n], 0, 0, 0);
    }
    ++g.sc; if (g.sc >= GS_STAGES) g.sc -= GS_STAGES;
  }
}
#define ZERO_ACC(a) do { _Pragma("unroll") for (int _m = 0; _m < 4; ++_m) _Pragma("unroll") for (int _n = 0; _n < 4; ++_n) a[_m][_n] = (f32x4){0.f, 0.f, 0.f, 0.f}; } while (0)
#define ZERO_ACC2(a) do { _Pragma("unroll") for (int _m = 0; _m < 4; ++_m) { a[_m][0] = (f32x4){0.f, 0.f, 0.f, 0.f}; a[_m][1] = (f32x4){0.f, 0.f, 0.f, 0.f}; } } while (0)


namespace g8 {
constexpr int BM = 256, BK = 64, HALF = 128, HTB = HALF * BK * 2;
__device__ __forceinline__ int lds_byte(int r, int c) { const int st = (r >> 4) * 2 + (c >> 5), rr = r & 15, cc = c & 31, ob = rr * 64 + cc * 2; return st * 1024 + (ob ^ (((ob >> 9) & 1) << 5)); }
__device__ __forceinline__ void stage_rc(int b, int& R, int& C) { const int st = b / 1024, sb = b % 1024, swz = sb ^ (((sb >> 9) & 1) << 5); R = (st >> 1) * 16 + swz / 64; C = (st & 1) * 32 + (swz % 64) / 2; }
__device__ __forceinline__ int perm32(int rho) { const int n = rho >> 4, i = rho & 15; return 8 * (i >> 2) + 4 * n + (i & 3); }
typedef f32x4 Acc[2][2][4][2];
template <class U, class Sched, class Epi>
__device__ __forceinline__ void phase(char* ldsg, const int K, const Sched& S, const Epi& E) {
  typedef __attribute__((address_space(3))) unsigned char* lptr;
  lptr lds = (lptr)ldsg;
  const int tid = threadIdx.x, wid = __builtin_amdgcn_readfirstlane(tid >> 6), lane = tid & 63, wr = wid >> 2, wc = wid & 3, fr = lane & 15, fq = lane >> 4;
  const int nt = K / BK;
  int R[2], C[2];
#pragma unroll
  for (int i = 0; i < 2; ++i) stage_rc(tid * 16 + i * 8192, R[i], C[i]);
  unsigned offB[2][2];
#pragma unroll
  for (int h = 0; h < 2; ++h)
#pragma unroll
    for (int i = 0; i < 2; ++i) offB[h][i] = S.boff(h * HALF + R[i], C[i]);
  const size_t kstep = (size_t)(BK * 2);
  const unsigned ldsw = (unsigned)wid * 1024u;
  const int aoff = lds_byte(wr * 64 + fr, fq * 8), boff = lds_byte(wc * 32 + fr, fq * 8);
#define G8_SA(b, h) (((b) * 2 + (h)) * HTB)
#define G8_SB(b, h) ((4 + (b) * 2 + (h)) * HTB)
#define G8_STAGE(bufoff, gbase, o0, o1) do { \
    __builtin_amdgcn_global_load_lds((const __attribute__((address_space(1))) void*)((gbase) + (o0)), (__attribute__((address_space(3))) void*)(lds + (bufoff) + ldsw), 16, 0, 0); \
    __builtin_amdgcn_global_load_lds((const __attribute__((address_space(1))) void*)((gbase) + (o1)), (__attribute__((address_space(3))) void*)(lds + (bufoff) + ldsw + 8192), 16, 0, 0); } while (0)
#define G8_LDA(dst, b, h) do { _Pragma("unroll") for (int m = 0; m < 4; ++m) _Pragma("unroll") for (int k = 0; k < 2; ++k) dst[m][k] = *(const __attribute__((address_space(3))) bf16x8*)(lds + G8_SA(b, h) + aoff + m * 2048 + k * 1024); } while (0)
#define G8_LDB(dst, b, h) do { _Pragma("unroll") for (int n = 0; n < 2; ++n) _Pragma("unroll") for (int k = 0; k < 2; ++k) dst[n][k] = *(const __attribute__((address_space(3))) bf16x8*)(lds + G8_SB(b, h) + boff + n * 2048 + k * 1024); } while (0)
#define G8_MMA(ai, bj, At, Bt) do { __builtin_amdgcn_s_setprio(1); _Pragma("unroll") for (int m = 0; m < 4; ++m) _Pragma("unroll") for (int n = 0; n < 2; ++n) _Pragma("unroll") for (int k = 0; k < 2; ++k) \
    acc[ai][bj][m][n] = __builtin_amdgcn_mfma_f32_16x16x32_bf16(Bt[n][k], At[m][k], acc[ai][bj][m][n], 0, 0, 0); __builtin_amdgcn_s_setprio(0); } while (0)
#define G8_WAIT_V(n) asm volatile("s_waitcnt vmcnt(" #n ")" ::: "memory")
#define G8_WAIT_L(n) asm volatile("s_waitcnt lgkmcnt(" #n ")" ::: "memory")
#define G8_BAR __builtin_amdgcn_s_barrier()
#define G8_SCHED __builtin_amdgcn_sched_barrier(0)
  U cur, nxt; int ui = 0;
  if (!S.next(0, cur)) return;
  Acc acc;
#define G8_ZERO() do { _Pragma("unroll") for (int a = 0; a < 2; ++a) _Pragma("unroll") for (int b = 0; b < 2; ++b) _Pragma("unroll") for (int m = 0; m < 4; ++m) _Pragma("unroll") for (int n = 0; n < 2; ++n) acc[a][b][m][n] = (f32x4){0.f, 0.f, 0.f, 0.f}; } while (0)
  G8_ZERO();
  bf16x8 At[4][2], B0[2][2], B1[2][2];
  unsigned oA[2][2], nA_[2][2];
  S.aoffs(cur, R[0], R[1], C[0], C[1], oA);
  const char* cA = S.abase(cur); const char* cB = S.bbase(cur);
  G8_STAGE(G8_SB(0, 0), cB, offB[0][0], offB[0][1]); G8_STAGE(G8_SA(0, 0), cA, oA[0][0], oA[0][1]); G8_STAGE(G8_SB(0, 1), cB, offB[1][0], offB[1][1]); G8_STAGE(G8_SA(0, 1), cA, oA[1][0], oA[1][1]);
  if (wr == 1) G8_BAR;
  G8_WAIT_V(4); G8_BAR;
  G8_STAGE(G8_SB(1, 0), cB + kstep, offB[0][0], offB[0][1]); G8_STAGE(G8_SA(1, 0), cA + kstep, oA[0][0], oA[0][1]); G8_STAGE(G8_SB(1, 1), cB + kstep, offB[1][0], offB[1][1]);
  G8_WAIT_V(6); G8_BAR;
  for (;;) {
    const bool has_next = S.next(ui + 1, nxt);
    const char* nA = cA; const char* nB = cB;
#pragma unroll
    for (int h = 0; h < 2; ++h) { nA_[h][0] = oA[h][0]; nA_[h][1] = oA[h][1]; }
    if (has_next) { nA = S.abase(nxt); nB = S.bbase(nxt); S.aoffs(nxt, R[0], R[1], C[0], C[1], nA_); }
#pragma unroll 1
    for (int t = 0; t < nt; t += 2) {
      const bool last = (t == nt - 2);
      const char* a1 = cA + (size_t)(t + 1) * kstep;
      const char* a2 = last ? nA : cA + (size_t)(t + 2) * kstep; const char* b2 = last ? nB : cB + (size_t)(t + 2) * kstep;
      const char* a3 = a2 + kstep; const char* b3 = b2 + kstep;
      const unsigned x00 = last ? nA_[0][0] : oA[0][0], x01 = last ? nA_[0][1] : oA[0][1], x10 = last ? nA_[1][0] : oA[1][0], x11 = last ? nA_[1][1] : oA[1][1];
      G8_LDB(B0, 0, 0); G8_SCHED; G8_LDA(At, 0, 0); G8_STAGE(G8_SA(1, 1), a1, oA[1][0], oA[1][1]);
      G8_WAIT_L(8); G8_BAR; G8_WAIT_L(0); G8_MMA(0, 0, At, B0); G8_BAR; G8_SCHED;
      G8_LDB(B1, 0, 1); G8_STAGE(G8_SB(0, 0), b2, offB[0][0], offB[0][1]);
      G8_BAR; G8_WAIT_L(0); G8_MMA(0, 1, At, B1); G8_BAR;
      G8_LDA(At, 0, 1); G8_STAGE(G8_SA(0, 0), a2, x00, x01);
      G8_BAR; G8_WAIT_L(0); G8_MMA(1, 0, At, B0); G8_BAR; G8_SCHED;
      G8_STAGE(G8_SB(0, 1), b2, offB[1][0], offB[1][1]);
      G8_WAIT_V(6); G8_BAR; G8_MMA(1, 1, At, B1); G8_BAR;
      G8_LDB(B0, 1, 0); G8_SCHED; G8_LDA(At, 1, 0); G8_STAGE(G8_SA(0, 1), a2, x10, x11);
      G8_WAIT_L(8); G8_BAR; G8_WAIT_L(0); G8_MMA(0, 0, At, B0); G8_BAR; G8_SCHED;
      G8_LDB(B1, 1, 1); G8_STAGE(G8_SB(1, 0), b3, offB[0][0], offB[0][1]);
      G8_BAR; G8_WAIT_L(0); G8_MMA(0, 1, At, B1); G8_BAR;
      G8_LDA(At, 1, 1); G8_STAGE(G8_SA(1, 0), a3, x00, x01);
      G8_BAR; G8_WAIT_L(0); G8_MMA(1, 0, At, B0); G8_BAR; G8_SCHED;
      G8_STAGE(G8_SB(1, 1), b3, offB[1][0], offB[1][1]);
      G8_WAIT_V(6); G8_BAR; G8_MMA(1, 1, At, B1); G8_BAR;
    }
    E(acc, cur, wr, wc, fr, fq);
    if (!has_next) break;
    G8_ZERO();
    cur = nxt; cA = nA; cB = nB; ++ui;
#pragma unroll
    for (int h = 0; h < 2; ++h) { oA[h][0] = nA_[h][0]; oA[h][1] = nA_[h][1]; }
  }
  G8_WAIT_V(0);
  if (wr == 0) G8_BAR;
  G8_BAR;
#undef G8_SA
#undef G8_SB
#undef G8_STAGE
#undef G8_LDA
#undef G8_LDB
#undef G8_MMA
#undef G8_WAIT_V
#undef G8_WAIT_L
#undef G8_BAR
#undef G8_SCHED
#undef G8_ZERO
}
}

#define EPI_RS 272
#define EPI_M(ROW0) int _rb = (ROW0) + wm * 64 + fr; asm volatile("" : "+v"(_rb)); _Pragma("unroll") for (int m = 0; m < 4; ++m) { const int row = _rb + m * 16;
#define EPI_M_END }
template <int NF, int CPR, class SF, class RF>
__device__ __forceinline__ void epi_tile(char* lds, SF sf, RF rf) {
  int tid = threadIdx.x; asm volatile("" : "+v"(tid));
  const int lane = tid & 63, wid = __builtin_amdgcn_readfirstlane(tid >> 6), wm = wid >> 1, wn = wid & 1, fr = lane & 15, fq = lane >> 4;
  char* img = lds + CIMG_OFF;
#pragma unroll
  for (int h = 0; h < 2; ++h) {
    if ((wm >> 1) == h) {
#pragma unroll
      for (int m = 0; m < 4; ++m)
#pragma unroll
        for (int n = 0; n < NF; ++n) { const f32x4 v = sf(m, n);
          *reinterpret_cast<uint2*>(img + ((wm & 1) * 64 + m * 16 + fr) * EPI_RS + (wn * NF * 16 + n * 16 + fq * 4) * 2) = make_uint2(pack2(v[0], v[1]), pack2(v[2], v[3])); }
    }
    asm volatile("s_waitcnt lgkmcnt(0)" ::: "memory"); __builtin_amdgcn_s_barrier(); asm volatile("" ::: "memory");
#pragma unroll
    for (int i = 0; i < CPR / 4; ++i) { const int idx = i * NTHR + tid, row = idx / CPR, c8 = idx % CPR;
      const u32x4 v = *reinterpret_cast<const u32x4*>(img + row * EPI_RS + c8 * 16); rf(h * 128 + row, c8 * 8, v); }
    asm volatile("s_waitcnt lgkmcnt(0)" ::: "memory"); __builtin_amdgcn_s_barrier(); asm volatile("" ::: "memory");
  }
}
struct XSched { int pos, end, step; };
__device__ __forceinline__ XSched xsched(int total) {
  XSched s;
  if ((gridDim.x & 7) == 0) { const int g = blockIdx.x & 7, per = gridDim.x >> 3; s.pos = (int)((long)total * g / 8) + (blockIdx.x >> 3); s.end = (int)((long)total * (g + 1) / 8); s.step = per; }
  else { s.pos = blockIdx.x; s.end = total; s.step = gridDim.x; }
  return s;
}
#define PTR_TAB_OFF 157696
struct CtxP { char* ws; float* out; };
struct Ctx {
  CtxP p; char* lds;
  __device__ __forceinline__ const float* in(int i) const { return reinterpret_cast<const float* const*>(lds + PTR_TAB_OFF)[i]; }
  template <typename T> __device__ __forceinline__ T* w(size_t off) const { return reinterpret_cast<T*>(p.ws + off); }
  __device__ __forceinline__ const float* mod(int l, int brow, int chunk) const { return w<float>(OFF_MOD) + ((size_t)(l * 5 + brow) * 6144 + chunk * 1024); }
};
__device__ __forceinline__ int brow_of(int row) { return row < TLAT ? (row >> 12) : 4; }

__device__ __forceinline__ void cvt_tile(const float* __restrict__ src, int N, u16* __restrict__ dst, int dld, int k0, int n0, int roff, float* t) {
  const int tid = threadIdx.x;
  { const int n4 = (tid & 15) * 4, kb = tid >> 4;
#pragma unroll
    for (int i = 0; i < 2; ++i) { const int k = kb + 32 * i; const float4 v = gld4(src + (size_t)(k0 + k) * N + n0 + n4);
      t[k * 65 + n4] = v.x; t[k * 65 + n4 + 1] = v.y; t[k * 65 + n4 + 2] = v.z; t[k * 65 + n4 + 3] = v.w; } }
  __syncthreads();
  { const int n = tid >> 3, k8 = (tid & 7) * 8; u32x4 o;
#pragma unroll
    for (int e = 0; e < 4; ++e) o[e] = pack2(t[(k8 + 2 * e) * 65 + n], t[(k8 + 2 * e + 1) * 65 + n]);
    *reinterpret_cast<u32x4*>(dst + (size_t)(roff + n0 + n) * dld + k0 + k8) = o; }
  __syncthreads();
}
__device__ __forceinline__ void cvt_tile4(const float* __restrict__ src, int N, u16* __restrict__ dst, int dld, int k0, int n0, int roff, float* t) {
  const int tid = threadIdx.x;
  { const int n4 = (tid & 63) * 4, kb = tid >> 6;
    float4 v[8];
#pragma unroll
    for (int i = 0; i < 8; ++i) v[i] = gld4(src + (size_t)(k0 + kb + 8 * i) * N + n0 + n4);
#pragma unroll
    for (int i = 0; i < 8; ++i) { float* tr = t + (kb + 8 * i) * 257 + n4; tr[0] = v[i].x; tr[1] = v[i].y; tr[2] = v[i].z; tr[3] = v[i].w; } }
  __syncthreads();
#pragma unroll
  for (int i = 0; i < 4; ++i) { const int q = i * NTHR + tid, n = q >> 3, k8 = (q & 7) * 8; u32x4 o;
#pragma unroll
    for (int e = 0; e < 4; ++e) o[e] = pack2(t[(k8 + 2 * e) * 257 + n], t[(k8 + 2 * e + 1) * 257 + n]);
    *reinterpret_cast<u32x4*>(dst + (size_t)(roff + n0 + n) * dld + k0 + k8) = o; }
  __syncthreads();
}
__device__ __forceinline__ void cvt_router_tile(const float* __restrict__ src, u16* __restrict__ dst, int k0, float* t) {
  const int tid = threadIdx.x;
  { const int n = tid & 63, kb = tid >> 6;
#pragma unroll
    for (int i = 0; i < 8; ++i) { int k = kb + 8 * i; t[k * 65 + n] = src[(size_t)(k0 + k) * 64 + n]; } }
  __syncthreads();
  { const int k = tid & 63, nb = tid >> 6;
#pragma unroll
    for (int i = 0; i < 8; ++i) { int nn = nb + 8 * i; float v = t[k * 65 + nn]; u16 hi = f2bf(v); u16 lo = f2bf(v - bf2f(hi));
      dst[(size_t)nn * 1024 + k0 + k] = hi; dst[(size_t)(64 + nn) * 1024 + k0 + k] = lo; } }
  __syncthreads();
}
#define NCVT_SMALL 1936
__device__ __forceinline__ void cvt_small(const Ctx& c, int l, int t) {
  float* tb = reinterpret_cast<float*>(c.lds);
  char* wl = c.p.ws + OFF_WS + (size_t)l * WS_LAYER;
  if (t < 1344) { cvt_tile(c.in(I_WIN) + (size_t)l * 1024 * INW, INW, (u16*)(wl + WS_WIN), 1024, (t / 84) * 64, (t % 84) * 64, 0, tb); return; }
  t -= 1344;
  if (t < 64) { cvt_tile(c.in(I_GLUV) + (size_t)l * 256 * 1024, 1024, (u16*)(wl + WS_GLU), 256, (t / 16) * 64, (t % 16) * 64, 0, tb); return; }
  t -= 64;
  if (t < 64) { cvt_tile(c.in(I_GLUG) + (size_t)l * 256 * 1024, 1024, (u16*)(wl + WS_GLU), 256, (t / 16) * 64, (t % 16) * 64, 1024, tb); return; }
  t -= 64;
  if (t < 64) { cvt_tile(c.in(I_PGM) + (size_t)l * 256 * 1024, 1024, (u16*)(wl + WS_GM), 256, (t / 16) * 64, (t % 16) * 64, 0, tb); return; }
  t -= 64;
  if (t < 128) { cvt_tile(c.in(I_PDA) + (size_t)l * 512 * 1024, 1024, (u16*)(wl + WS_DA), 512, (t / 16) * 64, (t % 16) * 64, 0, tb); return; }
  t -= 128;
  if (t < 256) { cvt_tile(c.in(I_WOUT) + (size_t)l * 1024 * 1024, 1024, (u16*)(wl + WS_OUT), 1024, (t / 16) * 64, (t % 16) * 64, 0, tb); return; }
  t -= 256;
  cvt_router_tile(c.in(I_WR) + (size_t)l * 1024 * 64, (u16*)(wl + WS_R), t * 64, tb);
}
#define NCVT_EXP (65 * 48)
#define CV_GIN(l) ((l) == 0 ? 480 : 1296)
#define CV_OUT(l) ((l) == 0 ? 2640 : 0)
__device__ __forceinline__ void cvt_expert(const Ctx& c, int l, int t) {
  float* tb = reinterpret_cast<float*>(c.lds);
  const int e = t / 48; int r = t % 48;
  char* we = c.p.ws + OFF_WE + (size_t)e * WE_ONE;
  const float* sg = e < 64 ? c.in(I_EG) + (size_t)(l * 64 + e) * 1024 * 256 : c.in(I_SG) + (size_t)l * 1024 * 256;
  const float* su = e < 64 ? c.in(I_EU) + (size_t)(l * 64 + e) * 1024 * 256 : c.in(I_SU) + (size_t)l * 1024 * 256;
  const float* sd = e < 64 ? c.in(I_ED) + (size_t)(l * 64 + e) * 256 * 1024 : c.in(I_SD) + (size_t)l * 256 * 1024;
  if (r < 16) { cvt_tile4(sg, 256, (u16*)we, 1024, r * 64, 0, 0, tb); return; }
  r -= 16;
  if (r < 16) { cvt_tile4(su, 256, (u16*)we, 1024, r * 64, 0, 256, tb); return; }
  r -= 16;
  cvt_tile4(sd, 1024, (u16*)(we + WE_GU), 256, (r >> 2) * 64, (r & 3) * 256, 0, tb);
}

__device__ __forceinline__ void step_prep(const Ctx& c) {
  const int G = gridDim.x;
  const int n_cvt = NCVT_SMALL, n_mod = 192, n_s5 = 8, n_misc = 1;
  const int total = n_cvt + n_mod + n_s5 + n_misc;
  for (int it = blockIdx.x; it < total; it += G) {
    if (it >= n_mod + n_s5 + n_misc) { cvt_small(c, 0, it - (n_mod + n_s5 + n_misc)); continue; }
    int i = it;
    if (i < n_mod) {
      const int l = i / 96, cb = i % 96;
      float* sil = reinterpret_cast<float*>(c.lds);
      float* red = sil + 5 * 1024;
      for (int q = ((int)threadIdx.x); q < 5 * 1024; q += NTHR) { int r = q >> 10, k = q & 1023; float v = r < 4 ? c.in(I_C)[r * 1024 + k] : c.in(I_CCTX)[k]; sil[q] = silu_(v); }
      __syncthreads();
      const int col = ((int)threadIdx.x) & 63, kp = ((int)threadIdx.x) >> 6;
      float a0 = 0, a1 = 0, a2 = 0, a3 = 0, a4 = 0;
      const float* wm_ = c.in(I_WMOD) + (size_t)l * 1024 * 6144 + cb * 64 + col;
#pragma unroll 1
      for (int k0 = kp * 128; k0 < kp * 128 + 128; k0 += 16) {
        float wv[16];
#pragma unroll
        for (int j = 0; j < 16; ++j) wv[j] = gld1(wm_ + (size_t)(k0 + j) * 6144);
#pragma unroll
        for (int j = 0; j < 16; ++j) { const int k = k0 + j;
          a0 += sil[k] * wv[j]; a1 += sil[1024 + k] * wv[j]; a2 += sil[2048 + k] * wv[j]; a3 += sil[3072 + k] * wv[j]; a4 += sil[4096 + k] * wv[j]; } }
      red[(kp * 5 + 0) * 64 + col] = a0; red[(kp * 5 + 1) * 64 + col] = a1; red[(kp * 5 + 2) * 64 + col] = a2;
      red[(kp * 5 + 3) * 64 + col] = a3; red[(kp * 5 + 4) * 64 + col] = a4;
      __syncthreads();
      if (((int)threadIdx.x) < 320) { int r = ((int)threadIdx.x) >> 6, cc = ((int)threadIdx.x) & 63; float s = 0;
#pragma unroll
        for (int q = 0; q < 8; ++q) s += red[(q * 5 + r) * 64 + cc];
        s += c.in(I_BMOD)[l * 6144 + cb * 64 + cc];
        __hip_atomic_store(c.w<float>(OFF_MOD) + (size_t)(l * 5 + r) * 6144 + cb * 64 + cc, s, __ATOMIC_RELAXED, __HIP_MEMORY_SCOPE_AGENT); }
      asm volatile("s_waitcnt vmcnt(0)" ::: "memory");
      __syncthreads();
      if (i < 32 && threadIdx.x == 0) __hip_atomic_fetch_add(c.w<unsigned>(OFF_CNT) + 514, 1u, __ATOMIC_RELAXED, __HIP_MEMORY_SCOPE_AGENT);
      continue;
    }
    i -= n_mod;
    if (i < n_s5) {
      const int q = i * NTHR + ((int)threadIdx.x);
      const int ldg = q >> 6;
      const float dt = expf(c.in(I_LSTEP)[ldg]);
      const float lr = c.in(I_LRE)[q], li = c.in(I_LIM)[q];
      const float mag = expf(lr * dt);
      float sn, cs; sincosf(li * dt, &sn, &cs);
      const float are = mag * cs, aim = mag * sn;
      const float den = lr * lr + li * li, nre = are - 1.f;
      const float zre = (nre * lr + aim * li) / den, zim = (aim * lr - nre * li) / den;
      float* A = c.w<float>(OFF_S5A); float* A64 = c.w<float>(OFF_S5A64); float* BB = c.w<float>(OFF_S5BB);
      A[q * 2] = are; A[q * 2 + 1] = aim;
      float pr = are, pi = aim;
#pragma unroll
      for (int s = 0; s < 6; ++s) { float nr = pr * pr - pi * pi, ni = 2.f * pr * pi; pr = nr; pi = ni; }
      A64[q * 2] = pr; A64[q * 2 + 1] = pi;
      const float* bre = c.in(I_BRE) + (size_t)q * 16; const float* bim = c.in(I_BIM) + (size_t)q * 16;
#pragma unroll
      for (int cc = 0; cc < 16; ++cc) { float br = bre[cc], bi = bim[cc];
        const float vr = zre * br - zim * bi, vi = zre * bi + zim * br;
        BB[((size_t)q * 16 + cc) * 2] = vr; BB[((size_t)q * 16 + cc) * 2 + 1] = vi;
        u16* bbh = c.w<u16>(OFF_S5BBH) + (size_t)(q >> 6) * 128 * 16;
        bbh[(q & 63) * 16 + cc] = f2bf(vr); bbh[(64 + (q & 63)) * 16 + cc] = f2bf(vi); }
      continue;
    }
    for (int q = ((int)threadIdx.x); q < 64 * 16; q += NTHR) { int pos = q >> 4, f = q & 15;
      float inv = powf(10000.f, -(float)f / 16.f); float ang = (float)pos * inv; float sn, cs; sincosf(ang, &sn, &cs);
      c.w<float>(OFF_ROPE)[q * 2] = cs; c.w<float>(OFF_ROPE)[q * 2 + 1] = sn; }
  }
}

__device__ __forceinline__ void ln_stats(const float (&v)[16], float& mean, float& rstd) {
  float s = 0;
#pragma unroll
  for (int i = 0; i < 16; ++i) s += v[i];
  mean = wave_sum(s) * (1.f / 1024.f);
  float q = 0;
#pragma unroll
  for (int i = 0; i < 16; ++i) { float d = v[i] - mean; q += d * d; }
  rstd = rsqrtf(wave_sum(q) * (1.f / 1024.f) + LN_EPS);
}
__device__ __forceinline__ void load_row(const float* src, int lane, float (&v)[16]) {
#pragma unroll
  for (int i = 0; i < 4; ++i) { float4 t = gld4(src + (i * 64 + lane) * 4); v[i * 4] = t.x; v[i * 4 + 1] = t.y; v[i * 4 + 2] = t.z; v[i * 4 + 3] = t.w; }
}
__device__ __forceinline__ void load_row_bf(const u16* src, int lane, float (&v)[16]) {
#pragma unroll
  for (int i = 0; i < 4; ++i) { const uint2 t = *reinterpret_cast<const uint2*>(src + (i * 64 + lane) * 4); v[i * 4] = bflo(t.x); v[i * 4 + 1] = bfhi(t.x); v[i * 4 + 2] = bflo(t.y); v[i * 4 + 3] = bfhi(t.y); }
}
__device__ __forceinline__ void store_row(float* dst, int lane, const float (&v)[16]) {
#pragma unroll
  for (int i = 0; i < 4; ++i) *reinterpret_cast<float4*>(dst + (i * 64 + lane) * 4) = make_float4(v[i * 4], v[i * 4 + 1], v[i * 4 + 2], v[i * 4 + 3]);
}
__device__ __forceinline__ void store_row_bf(u16* dst, int lane, const float (&v)[16]) {
#pragma unroll
  for (int i = 0; i < 4; ++i) *reinterpret_cast<uint2*>(dst + (i * 64 + lane) * 4) = make_uint2(pack2(v[i * 4], v[i * 4 + 1]), pack2(v[i * 4 + 2], v[i * 4 + 3]));
}
__device__ __forceinline__ void ln_mod_store(const float (&v)[16], const float* sh, const float* sc, u16* dst, int lane) {
  float mean, rstd; ln_stats(v, mean, rstd);
  float o[16];
#pragma unroll
  for (int i = 0; i < 4; ++i) { float4 a = gld4(sh + (i * 64 + lane) * 4), b = gld4(sc + (i * 64 + lane) * 4);
    o[i * 4] = (v[i * 4] - mean) * rstd * (1.f + b.x) + a.x; o[i * 4 + 1] = (v[i * 4 + 1] - mean) * rstd * (1.f + b.y) + a.y;
    o[i * 4 + 2] = (v[i * 4 + 2] - mean) * rstd * (1.f + b.z) + a.z; o[i * 4 + 3] = (v[i * 4 + 3] - mean) * rstd * (1.f + b.w) + a.w; }
  store_row_bf(dst, lane, o);
}
__device__ __forceinline__ void ln_affine(float (&v)[16], const float* g, const float* b, int lane) {
  float mean, rstd; ln_stats(v, mean, rstd);
#pragma unroll
  for (int i = 0; i < 4; ++i) { float4 a = gld4(g + (i * 64 + lane) * 4), bb = gld4(b + (i * 64 + lane) * 4);
    v[i * 4] = (v[i * 4] - mean) * rstd * a.x + bb.x; v[i * 4 + 1] = (v[i * 4 + 1] - mean) * rstd * a.y + bb.y;
    v[i * 4 + 2] = (v[i * 4 + 2] - mean) * rstd * a.z + bb.z; v[i * 4 + 3] = (v[i * 4 + 3] - mean) * rstd * a.w + bb.w; }
}

__device__ __forceinline__ void step_ln_in(const Ctx& c) {
  u16* U = c.w<u16>(OFF_ACT);
  if (threadIdx.x < 64) { unsigned* ec = c.w<unsigned>(OFF_CNT) + 514;
    while ((unsigned)__builtin_amdgcn_readfirstlane(__hip_atomic_load(ec, __ATOMIC_RELAXED, __HIP_MEMORY_SCOPE_AGENT)) != 32u) __builtin_amdgcn_s_sleep(2); }
  __syncthreads();
  __builtin_amdgcn_fence(__ATOMIC_ACQUIRE, "agent");
  for (int it = blockIdx.x; it < MTOT / 8; it += gridDim.x) {
    const int row = it * 8 + ((int)__builtin_amdgcn_readfirstlane(threadIdx.x >> 6));
    const float* src = row < TLAT ? c.in(I_X) + (size_t)row * 1024 : c.in(I_CTX) + (size_t)(row - TLAT) * 1024;
    float v[16]; load_row(src, ((int)threadIdx.x & 63), v);
    const int br = brow_of(row);
    ln_mod_store(v, c.mod(0, br, 0), c.mod(0, br, 1), U + (size_t)row * 1024, ((int)threadIdx.x & 63));
  }
}

__device__ __forceinline__ int xcd_remap(int L, int nwg) { const int q = nwg >> 3, r = nwg & 7, xcd = L & 7, off = L >> 3; return (xcd < r ? xcd * (q + 1) : r * (q + 1) + (xcd - r) * q) + off; }
struct DUnit { int pm, pn; };
template <bool PERM>
struct DenseSched {
  const char* A; const char* B; int K, nN, total;
  __device__ __forceinline__ bool next(int i, DUnit& u) const { const int L = i * (int)gridDim.x + (int)blockIdx.x; if (L >= total) return false;
    if ((gridDim.x & 7) != 0) { u.pm = L / nN; u.pn = L - u.pm * nN; return true; }
    const int w = xcd_remap(L, total), nM = total / nN, nig = 8 * nN, gid = w / nig, fm = gid * 8, gsz = (nM - fm) < 8 ? (nM - fm) : 8, wi = w - gid * nig;
    u.pn = wi / gsz; u.pm = fm + (wi - u.pn * gsz); return true; }
  __device__ __forceinline__ const char* abase(const DUnit& u) const { return A + (size_t)u.pm * 256 * K * 2; }
  __device__ __forceinline__ const char* bbase(const DUnit& u) const { return B + (size_t)u.pn * 256 * K * 2; }
  __device__ __forceinline__ void aoffs(const DUnit&, int R0, int R1, int C0, int C1, unsigned (&o)[2][2]) const {
#pragma unroll
    for (int h = 0; h < 2; ++h) { o[h][0] = (unsigned)((h * 128 + R0) * K + C0) * 2u; o[h][1] = (unsigned)((h * 128 + R1) * K + C1) * 2u; } }
  __device__ __forceinline__ unsigned boff(int row, int C) const { const int rb = PERM ? ((row & ~31) + g8::perm32(row & 31)) : row; return (unsigned)(rb * K + C) * 2u; }
};

__device__ __forceinline__ void step_gemm_in(const Ctx& c, int l) {
  const u16* U = c.w<u16>(OFF_ACT);
  const u16* W = reinterpret_cast<const u16*>(c.p.ws + OFF_WS + (size_t)l * WS_LAYER + WS_WIN);
  u16* P = c.w<u16>(OFF_BIG + BIG_P);
  const float* ropetab = c.w<float>(OFF_ROPE);
  DenseSched<true> S{(const char*)U, (const char*)W, 1024, 21, 68 * 21};
  const int lane = ((int)threadIdx.x & 63);
  g8::phase<DUnit>(c.lds, 1024, S, [&](const g8::Acc& acc, const DUnit& u, int wr, int wc, int fr, int fq) {
    const int cls = u.pn < 1 ? 0 : (u.pn < 3 ? 1 : (u.pn < 9 ? 0 : 2));
    const bool rope = (u.pn >= 3 && u.pn < 7) && (u.pm < 64);
#pragma unroll
    for (int ai = 0; ai < 2; ++ai)
#pragma unroll
      for (int mh = 0; mh < 2; ++mh) {
        float2 cs[2][8];
        if (rope) {
#pragma unroll
          for (int mi = 0; mi < 2; ++mi) { const int row = u.pm * 256 + ai * 128 + wr * 64 + (mh * 2 + mi) * 16 + fr; const int t = row & 4095; const int pos = (wc & 1) ? (t & 63) : (t >> 6);
            const float* tab = ropetab + pos * 32 + (fq & 1) * 16;
#pragma unroll
            for (int e4 = 0; e4 < 4; ++e4) { const float4 q4 = gld4(tab + e4 * 4); cs[mi][2 * e4] = make_float2(q4.x, q4.y); cs[mi][2 * e4 + 1] = make_float2(q4.z, q4.w); } }
        }
#pragma unroll
        for (int mi = 0; mi < 2; ++mi) {
          const int m = mh * 2 + mi;
          const int row = u.pm * 256 + ai * 128 + wr * 64 + m * 16 + fr;
          u16* rowp = P + (size_t)row * INW + u.pn * 256 + wc * 32 + 8 * fq;
#pragma unroll
          for (int bj = 0; bj < 2; ++bj) {
            f32x4 v0 = acc[ai][bj][m][0], v1 = acc[ai][bj][m][1];
            if (cls == 1) {
#pragma unroll
              for (int j = 0; j < 4; ++j) { v0[j] = gelu_tanh(v0[j]); v1[j] = gelu_tanh(v1[j]); } }
            else if (cls == 2) {
#pragma unroll
              for (int j = 0; j < 4; ++j) { v0[j] = sigmoidf_(v0[j]); v1[j] = sigmoidf_(v1[j]); } }
            if (rope) {
              float x[8] = {v0[0], v0[1], v0[2], v0[3], v1[0], v1[1], v1[2], v1[3]};
#pragma unroll
              for (int e = 0; e < 8; ++e) {
                auto rr = __builtin_amdgcn_permlane32_swap(__float_as_uint(x[e]), __float_as_uint(x[e]), false, false);
                const float o = __uint_as_float(lane < 32 ? rr[1] : rr[0]);
                const float2 c2 = cs[mi][e];
                x[e] = lane < 32 ? x[e] * c2.x - o * c2.y : x[e] * c2.x + o * c2.y; }
              v0 = (f32x4){x[0], x[1], x[2], x[3]}; v1 = (f32x4){x[4], x[5], x[6], x[7]};
            }
            u32x4 w; w.x = pack2(v0[0], v0[1]); w.y = pack2(v0[2], v0[3]); w.z = pack2(v1[0], v1[1]); w.w = pack2(v1[2], v1[3]);
            *reinterpret_cast<u32x4*>(rowp + bj * 128) = w;
          }
        }
      }
  });
  {
    const int G = (int)gridDim.x, extra = (68 * 21) % G;
    const int j = extra > 0 ? (int)blockIdx.x - extra : (int)blockIdx.x, nidle = extra > 0 ? G - extra : G;
    if (j >= 0) for (int it = j; it < CV_GIN(l); it += nidle) cvt_expert(c, l, it);
  }
}

#define BUB_LD 132
#define BT_LD 20
#define GM_LD 136
__device__ __forceinline__ void step_mix_a(const Ctx& c, int l, bool last, int part) {
  u16* P = c.w<u16>(OFF_BIG + BIG_P);
  const int n_rope = 0, n_s5 = 4 * 2 * NCHK, n_gm = (last ? 128 : 136), n_cv = NCVT_EXP - CV_OUT(l) - CV_GIN(l);
  const int total = n_rope + n_s5 + n_gm + n_cv;
  const bool defer = (blockIdx.x & 1) != 0;
  int it0 = (int)blockIdx.x;
  if (part == 1) { if (!defer || n_cv == 0) return; const int first = n_rope + n_s5 + n_gm; const int G = (int)gridDim.x; it0 = (int)blockIdx.x + ((first - (int)blockIdx.x + G - 1) / G) * G; if (it0 < (int)blockIdx.x) it0 = (int)blockIdx.x;
    __syncthreads(); }
  for (int it = it0; it < total; it += gridDim.x) {
    int i = it;
    i -= n_rope;
    if (i < n_s5) {
      const int b = i / (2 * NCHK), rem = i % (2 * NCHK), dir = rem / NCHK, ck = rem % NCHK;
      const float* A = c.w<float>(OFF_S5A); float* E = c.w<float>(OFF_E); const u16* BBH = c.w<u16>(OFF_S5BBH);
      const int lane = (int)threadIdx.x & 63, fr = lane & 15, fq = lane >> 4, wid_ = (int)__builtin_amdgcn_readfirstlane(threadIdx.x >> 6);
      float* bub = reinterpret_cast<float*>(c.lds + wid_ * 10240);
      int rows[4];
#pragma unroll
      for (int sub = 0; sub < 4; ++sub) { const int tau = ck * 64 + sub * 16 + fr;
        if (tau < 256) rows[sub] = TLAT + b * 256 + (dir ? 255 - tau : tau); else { const int tt = tau - 256; rows[sub] = b * 4096 + (dir ? 4095 - tt : tt); } }
      float are_[2], aim_[2]; s16x4 bfr_[2][8], afr_[2][4];
#pragma unroll
      for (int gi = 0; gi < 2; ++gi) {
        const int g = wid_ * 2 + gi; const int q = ((l * 2 + dir) * 16 + g) * 64 + lane;
        are_[gi] = A[q * 2]; aim_[gi] = A[q * 2 + 1];
        const u16* bp = BBH + ((size_t)((l * 2 + dir) * 16 + g) * 128 + fr) * 16 + fq * 4;
#pragma unroll
        for (int cb = 0; cb < 8; ++cb) bfr_[gi][cb] = *reinterpret_cast<const s16x4*>(bp + cb * 256);
#pragma unroll
        for (int sub = 0; sub < 4; ++sub) afr_[gi][sub] = *reinterpret_cast<const s16x4*>(P + (size_t)rows[sub] * INW + g * 16 + fq * 4);
      }
#pragma unroll
      for (int gi = 0; gi < 2; ++gi) {
        const int g = wid_ * 2 + gi;
        const float are = are_[gi], aim = aim_[gi];
        const s16x4 (&bfr)[8] = bfr_[gi]; const s16x4 (&afr)[4] = afr_[gi];
        float sr = 0.f, si = 0.f;
#pragma unroll
        for (int sub = 0; sub < 4; ++sub) {
          __builtin_amdgcn_sched_barrier(0);
#pragma unroll
          for (int cb = 0; cb < 8; ++cb) { const f32x4 d = __builtin_amdgcn_mfma_f32_16x16x16bf16_1k(afr[sub], bfr[cb], (f32x4){0.f, 0.f, 0.f, 0.f}, 0, 0, 0);
            *reinterpret_cast<f32x4*>(bub + (cb * 16 + fr) * BT_LD + fq * 4) = d; }
          __builtin_amdgcn_wave_barrier(); asm volatile("s_waitcnt lgkmcnt(0)" ::: "memory");
#pragma unroll
          for (int j4 = 0; j4 < 4; ++j4) { const f32x4 br4 = *reinterpret_cast<const f32x4*>(bub + lane * BT_LD + j4 * 4), bi4 = *reinterpret_cast<const f32x4*>(bub + (64 + lane) * BT_LD + j4 * 4);
#pragma unroll
            for (int r = 0; r < 4; ++r) { const float nr = are * sr - aim * si + br4[r], ni = are * si + aim * sr + bi4[r]; sr = nr; si = ni; } }
          __builtin_amdgcn_wave_barrier(); asm volatile("s_waitcnt lgkmcnt(0)" ::: "memory");
        }
        { float2 ev = make_float2(sr, si);
          __hip_atomic_store(reinterpret_cast<unsigned long long*>(E + ((size_t)(((b * 2 + dir) * NCHK + ck) * 16 + g) * 64 + lane) * 2), __builtin_bit_cast(unsigned long long, ev), __ATOMIC_RELAXED, __HIP_MEMORY_SCOPE_AGENT); }
      }
      asm volatile("s_waitcnt vmcnt(0)" ::: "memory");
      __syncthreads();
      if (threadIdx.x == 0) __hip_atomic_fetch_add(c.w<unsigned>(OFF_CNT) + 512 + l, 1u, __ATOMIC_RELAXED, __HIP_MEMORY_SCOPE_AGENT);
      continue;
    }
    i -= n_s5;
    if (i < n_gm) {
      const int ck = i; const int row0 = ck * 128;
      int tid = (int)threadIdx.x; asm volatile("" : "+v"(tid));
      const int lane = tid & 63, wid = (int)__builtin_amdgcn_readfirstlane(tid >> 6), fr = lane & 15, fq = lane >> 4;
      u16* vt = reinterpret_cast<u16*>(c.lds);
      uint2 tv[16];
#pragma unroll
      for (int q = 0; q < 16; ++q) tv[q] = *reinterpret_cast<const uint2*>(P + (size_t)(row0 + wid * 16 + q) * INW + 512 + lane * 4);
      const int t = wid * 16 + fr;
      uint2 uq[4][4]; float bs[4];
#pragma unroll
      for (int h = 0; h < 4; ++h) { bs[h] = gld1(c.in(I_GMB) + (l * 4 + h) * 128 + t);
        const u16* up = P + (size_t)(row0 + t) * INW + 256 + h * 64 + fq * 4;
#pragma unroll
        for (int m = 0; m < 4; ++m) uq[h][m] = *reinterpret_cast<const uint2*>(up + m * 16); }
      float4 wl[2][8];
      { const float* wrow = c.in(I_GMW) + ((size_t)(l * 4 + 0) * 128 + t) * 128 + fq * 8;
#pragma unroll
        for (int ks = 0; ks < 4; ++ks) { wl[0][2 * ks] = gld4(wrow + ks * 32); wl[0][2 * ks + 1] = gld4(wrow + ks * 32 + 4); } }
#pragma unroll
      for (int q = 0; q < 16; ++q) {
        const float v0 = bflo(tv[q].x), v1 = bfhi(tv[q].x), v2 = bflo(tv[q].y), v3 = bfhi(tv[q].y);
        const float mean = wave_sum(v0 + v1 + v2 + v3) * (1.f / 256.f);
        const float d0 = v0 - mean, d1 = v1 - mean, d2 = v2 - mean, d3 = v3 - mean;
        const float rstd = rsqrtf(wave_sum(d0 * d0 + d1 * d1 + d2 * d2 + d3 * d3) * (1.f / 256.f) + LN_EPS);
        u16* dst = vt + (lane * 4) * GM_LD + wid * 16 + q;
        dst[0] = f2bf(d0 * rstd); dst[GM_LD] = f2bf(d1 * rstd); dst[2 * GM_LD] = f2bf(d2 * rstd); dst[3 * GM_LD] = f2bf(d3 * rstd);
      }
      __syncthreads();
#pragma unroll
      for (int h = 0; h < 4; ++h) {
        if (h + 1 < 4) { const float* wrow = c.in(I_GMW) + ((size_t)(l * 4 + h + 1) * 128 + t) * 128 + fq * 8;
#pragma unroll
          for (int ks = 0; ks < 4; ++ks) { wl[(h + 1) & 1][2 * ks] = gld4(wrow + ks * 32); wl[(h + 1) & 1][2 * ks + 1] = gld4(wrow + ks * 32 + 4); } }
        bf16x8 bw[4];
#pragma unroll
        for (int ks = 0; ks < 4; ++ks) { const float4 w0 = wl[h & 1][2 * ks], w1 = wl[h & 1][2 * ks + 1];
          u32x4 pk = {pack2(w0.x, w0.y), pack2(w0.z, w0.w), pack2(w1.x, w1.y), pack2(w1.z, w1.w)}; bw[ks] = *reinterpret_cast<bf16x8*>(&pk); }
        f32x4 acc[4];
#pragma unroll
        for (int m = 0; m < 4; ++m) acc[m] = (f32x4){0.f, 0.f, 0.f, 0.f};
#pragma unroll
        for (int ks = 0; ks < 4; ++ks)
#pragma unroll
          for (int m = 0; m < 4; ++m) { const bf16x8 a = *reinterpret_cast<const bf16x8*>(vt + (h * 64 + m * 16 + fr) * GM_LD + ks * 32 + fq * 8);
            acc[m] = __builtin_amdgcn_mfma_f32_16x16x32_bf16(a, bw[ks], acc[m], 0, 0, 0); }
        u16* yb = c.w<u16>(OFF_BIG + BIG_YB) + (size_t)(row0 + t) * 256 + h * 64 + fq * 4;
#pragma unroll
        for (int m = 0; m < 4; ++m) { const uint2 uu = uq[h][m];
          uint2 o; o.x = pack2(bflo(uu.x) * (acc[m][0] + bs[h]), bfhi(uu.x) * (acc[m][1] + bs[h])); o.y = pack2(bflo(uu.y) * (acc[m][2] + bs[h]), bfhi(uu.y) * (acc[m][3] + bs[h]));
          *reinterpret_cast<uint2*>(yb + m * 16) = o; }
      }
      __syncthreads();
      continue;
    }
    i -= n_gm;
    if (part == 0 && defer) break;
    cvt_expert(c, l, CV_GIN(l) + i);
  }
}

#define SB_LD 136
__device__ __forceinline__ void s5_out_item(const Ctx& c, int l, int b, int seg, int j) {
  const u16* P = c.w<u16>(OFF_BIG + BIG_P); u16* YA = c.w<u16>(OFF_BIG + BIG_YA);
  const float* A = c.w<float>(OFF_S5A); const float* A64 = c.w<float>(OFF_S5A64); const float* BB = c.w<float>(OFF_S5BB); const float* E = c.w<float>(OFF_E);
  const int r0 = seg ? (TLAT + b * 256 + j * 64) : (b * 4096 + j * 64);
  const int kf = seg ? j : 4 + j, kr = seg ? 3 - j : 4 + (63 - j);
  int tid_ = ((int)threadIdx.x); asm volatile("" : "+v"(tid_));
  const int lane = tid_ & 63, fr = lane & 15, fq = lane >> 4, wid_ = __builtin_amdgcn_readfirstlane(tid_ >> 6);
  float* bub = reinterpret_cast<float*>(c.lds + wid_ * 14592);
  u16* sbuf = reinterpret_cast<u16*>(c.lds + wid_ * 14592 + 10240);
  unsigned* sbuf32 = reinterpret_cast<unsigned*>(sbuf);
  const u16* BBH = c.w<u16>(OFF_S5BBH);
#pragma unroll 1
  for (int gi = 0; gi < 2; ++gi) {
    const int g = wid_ * 2 + gi;
    f32x4 acc[4];
#pragma unroll
    for (int q = 0; q < 4; ++q) acc[q] = (f32x4){0.f, 0.f, 0.f, 0.f};
#pragma unroll
    for (int dir = 0; dir < 2; ++dir) {
      const int q = ((l * 2 + dir) * 16 + g) * 64 + lane;
      const float are = A[q * 2], aim = A[q * 2 + 1], a64r = A64[q * 2], a64i = A64[q * 2 + 1];
      s16x4 bfr[8];
      { const u16* bp = BBH + ((size_t)((l * 2 + dir) * 16 + g) * 128 + fr) * 16 + fq * 4;
#pragma unroll
        for (int cb = 0; cb < 8; ++cb) bfr[cb] = *reinterpret_cast<const s16x4*>(bp + cb * 256); }
      s16x4 afr[4];
#pragma unroll
      for (int sub = 0; sub < 4; ++sub) { const int tau = sub * 16 + fr; const int tl = dir ? 63 - tau : tau;
        afr[sub] = *reinterpret_cast<const s16x4*>(P + (size_t)(r0 + tl) * INW + g * 16 + fq * 4); }
      float sr = 0.f, si = 0.f; const int kk = dir ? kr : kf;
      { const float* ep = E + ((size_t)((b * 2 + dir) * NCHK * 16 + g) * 64 + lane) * 2;
        int jj = 0;
        for (; jj + 8 <= kk; jj += 8) {
          float2 e[8];
#pragma unroll
          for (int q = 0; q < 8; ++q) e[q] = *reinterpret_cast<const float2*>(ep + (size_t)(jj + q) * 2048);
#pragma unroll
          for (int q = 0; q < 8; ++q) { const float nr = a64r * sr - a64i * si + e[q].x, ni = a64r * si + a64i * sr + e[q].y; sr = nr; si = ni; }
        }
        for (; jj < kk; ++jj) { const float2 e = *reinterpret_cast<const float2*>(ep + (size_t)jj * 2048);
          const float nr = a64r * sr - a64i * si + e.x, ni = a64r * si + a64i * sr + e.y; sr = nr; si = ni; } }
      bf16x8 Bf[4];
      { const float* cre = c.in(I_CRE) + ((size_t)((l * 2 + dir) * 16 + g) * 16 + fr) * 64 + fq * 4; const float* cim = c.in(I_CIM) + ((size_t)((l * 2 + dir) * 16 + g) * 16 + fr) * 64 + fq * 4;
#pragma unroll
        for (int ks = 0; ks < 4; ++ks) { const float4 a = gld4(cre + ks * 16), bq = gld4(cim + ks * 16);
          u32x4 pk = {pack2(a.x, -bq.x), pack2(a.y, -bq.y), pack2(a.z, -bq.z), pack2(a.w, -bq.w)}; Bf[ks] = *reinterpret_cast<bf16x8*>(&pk); } }
#pragma unroll
      for (int sub = 0; sub < 4; ++sub) {
        __builtin_amdgcn_sched_barrier(0);
#pragma unroll
        for (int cb = 0; cb < 8; ++cb) { const f32x4 d = __builtin_amdgcn_mfma_f32_16x16x16bf16_1k(afr[sub], bfr[cb], (f32x4){0.f, 0.f, 0.f, 0.f}, 0, 0, 0);
          *reinterpret_cast<f32x4*>(bub + (cb * 16 + fr) * BT_LD + fq * 4) = d; }
        __builtin_amdgcn_wave_barrier(); asm volatile("s_waitcnt lgkmcnt(0)" ::: "memory");
#pragma unroll
        for (int j4 = 0; j4 < 4; ++j4) {
          const f32x4 br4 = *reinterpret_cast<const f32x4*>(bub + lane * BT_LD + j4 * 4), bi4 = *reinterpret_cast<const f32x4*>(bub + (64 + lane) * BT_LD + j4 * 4);
#pragma unroll
          for (int r = 0; r < 4; ++r) {
            const int tau = sub * 16 + j4 * 4 + r; const int tl = dir ? 63 - tau : tau;
            const float nr = are * sr - aim * si + br4[r], ni = are * si + aim * sr + bi4[r]; sr = nr; si = ni;
            sbuf32[(tl & 15) * (SB_LD / 2) + lane] = pack2(sr, si);
          }
        }
        __builtin_amdgcn_wave_barrier(); asm volatile("s_waitcnt lgkmcnt(0)" ::: "memory");
        bf16x8 Af[4];
#pragma unroll
        for (int ks = 0; ks < 4; ++ks) Af[ks] = *reinterpret_cast<const bf16x8*>(sbuf + fr * SB_LD + ks * 32 + fq * 8);
        asm volatile("s_waitcnt lgkmcnt(0)" ::: "memory"); __builtin_amdgcn_wave_barrier();
        if (dir == 0) {
#pragma unroll
          for (int ks = 0; ks < 4; ++ks) acc[sub] = __builtin_amdgcn_mfma_f32_16x16x32_bf16(Af[ks], Bf[ks], acc[sub], 0, 0, 0);
        } else {
#pragma unroll
          for (int ks = 0; ks < 4; ++ks) acc[3 - sub] = __builtin_amdgcn_mfma_f32_16x16x32_bf16(Af[ks], Bf[ks], acc[3 - sub], 0, 0, 0);
        }
      }
    }
#pragma unroll
    for (int tb = 0; tb < 4; ++tb)
#pragma unroll
      for (int jx = 0; jx < 4; ++jx) bub[(tb * 16 + fq * 4 + jx) * BT_LD + fr] = acc[tb][jx];
    __builtin_amdgcn_wave_barrier(); asm volatile("s_waitcnt lgkmcnt(0)" ::: "memory"); __builtin_amdgcn_wave_barrier();
#pragma unroll
    for (int i = 0; i < 2; ++i) { const int q = i * 64 + lane, tl = q >> 1, hf = q & 1;
      const f32x4 y0 = *reinterpret_cast<const f32x4*>(bub + tl * BT_LD + hf * 8), y1 = *reinterpret_cast<const f32x4*>(bub + tl * BT_LD + hf * 8 + 4);
      const u32x4 uu = *reinterpret_cast<const u32x4*>(P + (size_t)(r0 + tl) * INW + g * 16 + hf * 8);
      const float4 d0 = gld4(c.in(I_S5D) + l * 256 + g * 16 + hf * 8), d1 = gld4(c.in(I_S5D) + l * 256 + g * 16 + hf * 8 + 4);
      u32x4 o;
      o.x = pack2(gelu_tanh(d0.x * bflo(uu.x) + y0[0]), gelu_tanh(d0.y * bfhi(uu.x) + y0[1])); o.y = pack2(gelu_tanh(d0.z * bflo(uu.y) + y0[2]), gelu_tanh(d0.w * bfhi(uu.y) + y0[3]));
      o.z = pack2(gelu_tanh(d1.x * bflo(uu.z) + y1[0]), gelu_tanh(d1.y * bfhi(uu.z) + y1[1])); o.w = pack2(gelu_tanh(d1.z * bflo(uu.w) + y1[2]), gelu_tanh(d1.w * bfhi(uu.w) + y1[3]));
      *reinterpret_cast<u32x4*>(YA + (size_t)(r0 + tl) * 256 + g * 16 + hf * 8) = o; }
    __builtin_amdgcn_wave_barrier(); asm volatile("s_waitcnt lgkmcnt(0)" ::: "memory");
  }
}

__device__ __forceinline__ void attn_naive_item(const Ctx& c, int l, int b, int h, int qb, int seg) {
  const u16* P = c.w<u16>(OFF_BIG + BIG_P); u16* YC = c.w<u16>(OFF_BIG + BIG_YC);
  const int ql = ((int)threadIdx.x) >> 2, vq = ((int)threadIdx.x) & 3;
  const int qrow = seg ? (TLAT + b * 256 + qb * 128 + ql) : (b * 4096 + qb * 128 + ql);
  const int nkeys = seg ? 256 : 4352;
  const float lam_init = 0.8f - 0.6f * expf(-0.3f * (float)l);
  float lam;
  { const float* lf = c.in(I_DALAM) + l * 256; float s1 = 0.f, s2 = 0.f;
    for (int d = 0; d < 64; ++d) { s1 += lf[d] * lf[64 + d]; s2 += lf[128 + d] * lf[192 + d]; }
    lam = expf(s1) - expf(s2) + lam_init; }
  float res[32];
#pragma unroll 1
  for (int mp = 0; mp < 2; ++mp) {
    float q[64];
    { const u16* qp = P + (size_t)qrow * INW + 768 + h * 128 + mp * 64;
#pragma unroll
      for (int w = 0; w < 8; ++w) { u32x4 t = *reinterpret_cast<const u32x4*>(qp + w * 8);
#pragma unroll
        for (int e = 0; e < 4; ++e) { q[w * 8 + 2 * e] = bflo(t[e]) * 0.125f; q[w * 8 + 2 * e + 1] = bfhi(t[e]) * 0.125f; } } }
    float o[32];
#pragma unroll
    for (int d = 0; d < 32; ++d) o[d] = 0.f;
    float mx = -1e30f, ls = 0.f;
#pragma unroll 1
    for (int key = 0; key < nkeys; ++key) {
      const int krow = key < 256 ? (TLAT + b * 256 + key) : (b * 4096 + key - 256);
      const u16* kp = P + (size_t)krow * INW + 1280 + h * 128 + mp * 64;
      float s = 0.f;
#pragma unroll
      for (int w = 0; w < 8; ++w) { u32x4 t = *reinterpret_cast<const u32x4*>(kp + w * 8);
#pragma unroll
        for (int e = 0; e < 4; ++e) s += q[w * 8 + 2 * e] * bflo(t[e]) + q[w * 8 + 2 * e + 1] * bfhi(t[e]); }
      const float mn = fmaxf(mx, s); const float al = __expf(mx - mn), pp = __expf(s - mn); mx = mn; ls = ls * al + pp;
      const u16* vp = P + (size_t)krow * INW + 1792 + h * 128 + vq * 32;
#pragma unroll
      for (int w = 0; w < 4; ++w) { u32x4 t = *reinterpret_cast<const u32x4*>(vp + w * 8);
#pragma unroll
        for (int e = 0; e < 4; ++e) { o[w * 8 + 2 * e] = o[w * 8 + 2 * e] * al + pp * bflo(t[e]); o[w * 8 + 2 * e + 1] = o[w * 8 + 2 * e + 1] * al + pp * bfhi(t[e]); } }
    }
    const float inv = 1.f / ls;
    if (mp == 0) {
#pragma unroll
      for (int d = 0; d < 32; ++d) res[d] = o[d] * inv;
    } else {
#pragma unroll
      for (int d = 0; d < 32; ++d) res[d] = res[d] - lam * o[d] * inv;
    }
  }
  float ss = 0.f;
#pragma unroll
  for (int d = 0; d < 32; ++d) ss += res[d] * res[d];
  ss += __shfl_xor(ss, 1, 64); ss += __shfl_xor(ss, 2, 64);
  const float r = rsqrtf(ss * (1.f / 128.f) + LN_EPS) * (1.f - lam_init);
  const float* sg = c.in(I_SUBLN) + l * 128 + vq * 32;
  u16* yp = YC + (size_t)qrow * 512 + h * 128 + vq * 32;
#pragma unroll
  for (int w = 0; w < 4; ++w) { u32x4 t;
#pragma unroll
    for (int e = 0; e < 4; ++e) t[e] = pack2(res[w * 8 + 2 * e] * r * sg[w * 8 + 2 * e], res[w * 8 + 2 * e + 1] * r * sg[w * 8 + 2 * e + 1]);
    *reinterpret_cast<u32x4*>(yp + w * 8) = t; }
}

typedef __attribute__((ext_vector_type(16))) float f32x16;
#define KSWZ(row, colB) ((row) * 256 + ((colB) ^ (((row) & 15) << 4)))
#define SBAR() __builtin_amdgcn_sched_barrier(0)
#define ATT_THR 8.f
__device__ __forceinline__ int crow(int r, int hi) { return (r & 3) + 8 * (r >> 2) + 4 * hi; }
__device__ __forceinline__ int v_rd_base(int lane) { return ((lane & 3) << 3) | (((lane >> 2) & 3) << 6) | (((lane >> 4) & 1) << 5) | (((lane >> 5) & 1) << 8); }
constexpr int v_rd_off(int d0, int ks, int half) { return d0 * 512 + ks * 4096 + half * 2048; }
template <int OFF> __device__ __forceinline__ s16x4 tr_read(int vb) {
  typedef __attribute__((address_space(3))) s16x4* lp;
  return __builtin_amdgcn_ds_read_tr16_b64_v4i16((lp)(unsigned)(vb + OFF));
}
template <int MAP>
__device__ __forceinline__ void att_qkt(f32x16& p0, f32x16& p1, const char* Ks, const char* Qs, int r32, int hi) {
  p0 = f32x16{}; p1 = f32x16{};
#pragma unroll
  for (int dd = 0; dd < 4; ++dd) { const int d0 = MAP * 4 + dd; const int cb = (d0 * 16 + hi * 8) * 2;
    bf16x8 b0 = *reinterpret_cast<const bf16x8*>(Ks + KSWZ(r32, cb));
    bf16x8 b1 = *reinterpret_cast<const bf16x8*>(Ks + KSWZ(32 + r32, cb));
    bf16x8 qf = *reinterpret_cast<const bf16x8*>(Qs + KSWZ(r32, cb));
    p0 = __builtin_amdgcn_mfma_f32_32x32x16_bf16(b0, qf, p0, 0, 0, 0);
    p1 = __builtin_amdgcn_mfma_f32_32x32x16_bf16(b1, qf, p1, 0, 0, 0); }
}
__device__ __forceinline__ void att_softmax(f32x16& p0, f32x16& p1, float& m_reg, float& l_reg, float& alpha, bf16x8& pa0, bf16x8& pa1, bf16x8& pa2, bf16x8& pa3) {
  constexpr float SC = 0.125f, C = SC * 1.4426950408889634f;
  float pmax = p0[0];
#pragma unroll
  for (int r = 1; r < 16; ++r) pmax = fmaxf(pmax, p0[r]);
#pragma unroll
  for (int r = 0; r < 16; ++r) pmax = fmaxf(pmax, p1[r]);
  { auto rr = __builtin_amdgcn_permlane32_swap(__float_as_uint(pmax), __float_as_uint(pmax), false, false);
    pmax = fmaxf(__uint_as_float(rr[0]), __uint_as_float(rr[1])); }
  const bool keep = __all(pmax - m_reg <= ATT_THR / SC);
  const float mn = keep ? m_reg : fmaxf(m_reg, pmax);
  alpha = __builtin_amdgcn_exp2f((m_reg - mn) * C); m_reg = mn;
  const float mnC = -mn * C;
#pragma unroll
  for (int r = 0; r < 16; ++r) p0[r] = __builtin_amdgcn_exp2f(fmaf(p0[r], C, mnC));
#pragma unroll
  for (int r = 0; r < 16; ++r) p1[r] = __builtin_amdgcn_exp2f(fmaf(p1[r], C, mnC));
  float ps = 0.f;
#pragma unroll
  for (int r = 0; r < 16; ++r) ps += p0[r];
#pragma unroll
  for (int r = 0; r < 16; ++r) ps += p1[r];
  { auto rr = __builtin_amdgcn_permlane32_swap(__float_as_uint(ps), __float_as_uint(ps), false, false);
    ps = __uint_as_float(rr[0]) + __uint_as_float(rr[1]); }
  l_reg = l_reg * alpha + ps;
#define PK4(P, BASE, OUT) do { unsigned a0 = cvtpk(P[BASE + 0], P[BASE + 1]), a1 = cvtpk(P[BASE + 2], P[BASE + 3]);   \
    unsigned b0 = cvtpk(P[BASE + 4], P[BASE + 5]), b1 = cvtpk(P[BASE + 6], P[BASE + 7]);                              \
    auto r0 = __builtin_amdgcn_permlane32_swap(a0, b0, false, false); auto r1 = __builtin_amdgcn_permlane32_swap(a1, b1, false, false); \
    u32x4 w = {r0[0], r1[0], r0[1], r1[1]}; OUT = *reinterpret_cast<bf16x8*>(&w); } while (0)
  PK4(p0, 0, pa0); PK4(p0, 8, pa1); PK4(p1, 0, pa2); PK4(p1, 8, pa3);
#undef PK4
}
template <int D0> __device__ __forceinline__ void att_pv(f32x16& oa, f32x16& ob, int vb, const bf16x8 (&pa)[4], const bf16x8 (&pb)[4]) {
  const s16x4 l0 = tr_read<v_rd_off(D0, 0, 0)>(vb), h0 = tr_read<v_rd_off(D0, 0, 1)>(vb), l1 = tr_read<v_rd_off(D0, 1, 0)>(vb), h1 = tr_read<v_rd_off(D0, 1, 1)>(vb);
  const s16x4 l2 = tr_read<v_rd_off(D0, 2, 0)>(vb), h2 = tr_read<v_rd_off(D0, 2, 1)>(vb), l3 = tr_read<v_rd_off(D0, 3, 0)>(vb), h3 = tr_read<v_rd_off(D0, 3, 1)>(vb);
#define PKV(L, H) (bf16x8){L[0], L[1], L[2], L[3], H[0], H[1], H[2], H[3]}
  const bf16x8 v0 = PKV(l0, h0), v1 = PKV(l1, h1), v2 = PKV(l2, h2), v3 = PKV(l3, h3);
#undef PKV
  oa = __builtin_amdgcn_mfma_f32_32x32x16_bf16(pa[0], v0, oa, 0, 0, 0);
  ob = __builtin_amdgcn_mfma_f32_32x32x16_bf16(pb[0], v0, ob, 0, 0, 0);
  oa = __builtin_amdgcn_mfma_f32_32x32x16_bf16(pa[1], v1, oa, 0, 0, 0);
  ob = __builtin_amdgcn_mfma_f32_32x32x16_bf16(pb[1], v1, ob, 0, 0, 0);
  oa = __builtin_amdgcn_mfma_f32_32x32x16_bf16(pa[2], v2, oa, 0, 0, 0);
  ob = __builtin_amdgcn_mfma_f32_32x32x16_bf16(pb[2], v2, ob, 0, 0, 0);
  oa = __builtin_amdgcn_mfma_f32_32x32x16_bf16(pa[3], v3, oa, 0, 0, 0);
  ob = __builtin_amdgcn_mfma_f32_32x32x16_bf16(pb[3], v3, ob, 0, 0, 0);
}
template <int D0> __device__ __forceinline__ void att_pv1(f32x16& oa, int vb, const bf16x8 (&pa)[4]) {
  const s16x4 l0 = tr_read<v_rd_off(D0, 0, 0)>(vb), h0 = tr_read<v_rd_off(D0, 0, 1)>(vb), l1 = tr_read<v_rd_off(D0, 1, 0)>(vb), h1 = tr_read<v_rd_off(D0, 1, 1)>(vb);
  const s16x4 l2 = tr_read<v_rd_off(D0, 2, 0)>(vb), h2 = tr_read<v_rd_off(D0, 2, 1)>(vb), l3 = tr_read<v_rd_off(D0, 3, 0)>(vb), h3 = tr_read<v_rd_off(D0, 3, 1)>(vb);
#define PKV(L, H) (bf16x8){L[0], L[1], L[2], L[3], H[0], H[1], H[2], H[3]}
  oa = __builtin_amdgcn_mfma_f32_32x32x16_bf16(pa[0], PKV(l0, h0), oa, 0, 0, 0);
  oa = __builtin_amdgcn_mfma_f32_32x32x16_bf16(pa[1], PKV(l1, h1), oa, 0, 0, 0);
  oa = __builtin_amdgcn_mfma_f32_32x32x16_bf16(pa[2], PKV(l2, h2), oa, 0, 0, 0);
  oa = __builtin_amdgcn_mfma_f32_32x32x16_bf16(pa[3], PKV(l3, h3), oa, 0, 0, 0);
#undef PKV
}
#define ATT_KBUF(b) ((b) * 16384)
#define ATT_VBUF(b) (32768 + (b) * 16384)
#define ATT_WS_OFF 65536
#define ATT_Q_OFF 69632
__device__ __forceinline__ void attn_mfma_item(const Ctx& c, int l, int b, int h, int qb, int seg) {
  const u16* P = c.w<u16>(OFF_BIG + BIG_P); u16* YC = c.w<u16>(OFF_BIG + BIG_YC);
  int tid = ((int)threadIdx.x); asm volatile("" : "+v"(tid));
  const int wid = __builtin_amdgcn_readfirstlane(tid >> 6), lane = tid & 63, r32 = lane & 31, hi = lane >> 5;
  const int q0 = seg ? (TLAT + b * 256) : (b * 4096 + qb * 256);
  const int NT = seg ? 4 : 68;
  float* wsl = reinterpret_cast<float*>(c.lds + ATT_WS_OFF) + wid * 64;
  const float lam_init = 0.8f - 0.6f * expf(-0.3f * (float)l);
  float lam;
  { const float* lf = c.in(I_DALAM) + l * 256; float s1 = lf[lane] * lf[64 + lane], s2 = lf[128 + lane] * lf[192 + lane];
    s1 = wave_sum(s1); s2 = wave_sum(s2); lam = expf(s1) - expf(s2) + lam_init; }
#pragma unroll
  for (int i = 0; i < 8; ++i) { const int q = i * NTHR + tid, row = q >> 4, col = ((q & 15) ^ (row & 15)) * 8;
    glds16(P + (size_t)(q0 + row) * INW + 768 + h * 128 + col, c.lds + ATT_Q_OFF + (i * NTHR + tid) * 16); }
  const char* Qs = c.lds + ATT_Q_OFF + wid * 32 * 256;
  int krow[2], kcol[2], vrow[2], vcol[2];
#pragma unroll
  for (int i = 0; i < 2; ++i) { const int q = i * NTHR + tid;
    krow[i] = q >> 4; kcol[i] = ((q & 15) ^ (krow[i] & 15)) * 8;
    const int st = q >> 5, r5 = q & 31, kk = ((st >> 2) << 3) | (r5 >> 2);
    vrow[i] = (kk & ~0xC) | ((kk & 4) << 1) | ((kk & 8) >> 1); vcol[i] = (st & 3) * 32 + (r5 & 3) * 8; }
  auto issue_tile = [&](int jt, int buf) {
    const int kr0 = (jt < 4) ? (TLAT + b * 256 + jt * 64) : (b * 4096 + (jt - 4) * 64);
#pragma unroll
    for (int i = 0; i < 2; ++i) {
      glds16(P + (size_t)(kr0 + krow[i]) * INW + 1280 + h * 128 + kcol[i], c.lds + ATT_KBUF(buf) + (i * NTHR + tid) * 16);
      glds16(P + (size_t)(kr0 + vrow[i]) * INW + 1792 + h * 128 + vcol[i], c.lds + ATT_VBUF(buf) + (i * NTHR + tid) * 16); }
  };
  f32x16 o0[4], o1[4];
#pragma unroll
  for (int d = 0; d < 4; ++d) { o0[d] = f32x16{}; o1[d] = f32x16{}; }
  float m0 = -1e30f, l0 = 0.f, m1 = -1e30f, l1 = 0.f;
  const int vbase = (int)(uintptr_t)(c.lds) + v_rd_base(lane);
  issue_tile(0, 0);
  asm volatile("s_waitcnt vmcnt(0)" ::: "memory");
  __syncthreads();
#pragma unroll 1
  for (int jt = 0; jt < NT; ++jt) {
    const int buf = jt & 1;
    if (jt + 1 < NT) issue_tile(jt + 1, buf ^ 1);
    const char* Ks = c.lds + ATT_KBUF(buf);
    bf16x8 pa[4], pb[4]; float al0, al1;
    { f32x16 p0, p1; att_qkt<0>(p0, p1, Ks, Qs, r32, hi); att_softmax(p0, p1, m0, l0, al0, pa[0], pa[1], pa[2], pa[3]); }
    if (__any(al0 < 1.f)) {
      if (hi == 0) wsl[r32] = al0;
      asm volatile("s_waitcnt lgkmcnt(0)" ::: "memory");
#pragma unroll
      for (int r = 0; r < 16; ++r) { const float a0 = wsl[crow(r, hi)];
#pragma unroll
        for (int d = 0; d < 4; ++d) o0[d][r] *= a0; }
    }
    const int vb = vbase + ATT_VBUF(buf);
    { f32x16 p0, p1; att_qkt<1>(p0, p1, Ks, Qs, r32, hi);
      att_pv1<0>(o0[0], vb, pa); att_pv1<1>(o0[1], vb, pa); att_pv1<2>(o0[2], vb, pa); att_pv1<3>(o0[3], vb, pa);
      att_softmax(p0, p1, m1, l1, al1, pb[0], pb[1], pb[2], pb[3]); }
    if (__any(al1 < 1.f)) {
      if (hi == 0) wsl[32 + r32] = al1;
      asm volatile("s_waitcnt lgkmcnt(0)" ::: "memory");
#pragma unroll
      for (int r = 0; r < 16; ++r) { const float a1 = wsl[32 + crow(r, hi)];
#pragma unroll
        for (int d = 0; d < 4; ++d) o1[d][r] *= a1; }
    }
    att_pv1<0>(o1[0], vb, pb); att_pv1<1>(o1[1], vb, pb); att_pv1<2>(o1[2], vb, pb); att_pv1<3>(o1[3], vb, pb);
    asm volatile("s_waitcnt vmcnt(0)" ::: "memory");
    __syncthreads();
  }
  if (hi == 0) { wsl[r32] = 1.f / l0; wsl[32 + r32] = lam / l1; }
  asm volatile("s_waitcnt lgkmcnt(0)" ::: "memory");
  float ss[16];
#pragma unroll
  for (int r = 0; r < 16; ++r) { const float i0 = wsl[crow(r, hi)], i1 = wsl[32 + crow(r, hi)]; float s = 0.f;
#pragma unroll
    for (int d = 0; d < 4; ++d) { const float v = o0[d][r] * i0 - o1[d][r] * i1; o0[d][r] = v; s += v * v; }
    ss[r] = s; }
#pragma unroll
  for (int r = 0; r < 16; ++r) {
#pragma unroll
    for (int mk = 1; mk < 32; mk <<= 1) ss[r] += __shfl_xor(ss[r], mk, 64);
    ss[r] = rsqrtf(ss[r] * (1.f / 128.f) + LN_EPS) * (1.f - lam_init); }
  const float* sg = c.in(I_SUBLN) + l * 128;
  float g4[4];
#pragma unroll
  for (int d = 0; d < 4; ++d) g4[d] = sg[d * 32 + r32];
  { u16* stg = reinterpret_cast<u16*>(c.lds + ATT_KBUF(0)) + wid * (32 * 128);
#pragma unroll
    for (int r = 0; r < 16; ++r)
#pragma unroll
      for (int d = 0; d < 4; ++d) stg[crow(r, hi) * 128 + d * 32 + r32] = f2bf(o0[d][r] * ss[r] * g4[d]);
    __builtin_amdgcn_wave_barrier(); asm volatile("s_waitcnt lgkmcnt(0)" ::: "memory"); __builtin_amdgcn_wave_barrier();
#pragma unroll
    for (int i = 0; i < 8; ++i) { const int q = i * 64 + lane, row = q >> 4, c8 = (q & 15) * 8;
      *reinterpret_cast<u32x4*>(YC + (size_t)(q0 + wid * 32 + row) * 512 + h * 128 + c8) = *reinterpret_cast<const u32x4*>(stg + row * 128 + c8); } }
  __syncthreads();
}

__device__ __forceinline__ void step_mix_b(const Ctx& c, int l, bool last) {
#ifdef NAIVE_ATTN
  const int n_att = 512, n_attc = last ? 0 : 32, n_s5 = 4 * 64, n_s5c = last ? 0 : 16;
#else
  const int n_att = 256, n_attc = last ? 0 : 16, n_s5 = 4 * 64, n_s5c = last ? 0 : 16;
#endif
  const int total = n_att + n_attc + n_s5 + n_s5c;
#ifdef PROBE_A
  unsigned long long tq0 = 0; if (blockIdx.x == 0 && ((int)threadIdx.x) == 0) tq0 = __builtin_amdgcn_s_memrealtime();
#endif
  bool e_ready = false;
  for (int it = blockIdx.x; it < total; it += gridDim.x) {
    int i = it;
#ifdef PROBE_A
    if (it != (int)blockIdx.x && it == (int)blockIdx.x + (int)gridDim.x && blockIdx.x == 0 && ((int)threadIdx.x) == 0) { unsigned long long* tsl_ = reinterpret_cast<unsigned long long*>(c.lds + 158720); tsl_[45 + l] = __builtin_amdgcn_s_memrealtime() - tq0; }
#endif
#ifdef NAIVE_ATTN
    if (i < n_att) { const int bh = i >> 5, qb = i & 31; attn_naive_item(c, l, bh >> 2, bh & 3, qb, 0); continue; }
    i -= n_att;
    if (i < n_attc) { const int bh = i >> 1; attn_naive_item(c, l, bh >> 2, bh & 3, i & 1, 1); continue; }
#else
    if (i < n_att) { const int xcd = i & 7, slot = i >> 3; const int bh = xcd * 2 + (slot >> 4), qb = slot & 15;
      attn_mfma_item(c, l, bh >> 2, bh & 3, qb, 0); continue; }
    i -= n_att;
    if (i < n_attc) { attn_mfma_item(c, l, i >> 2, i & 3, 0, 1); continue; }
#endif
    i -= n_attc;
    if (!e_ready) {
      if (threadIdx.x < 64) { unsigned* ec = c.w<unsigned>(OFF_CNT) + 512 + l;
        while ((unsigned)__builtin_amdgcn_readfirstlane(__hip_atomic_load(ec, __ATOMIC_RELAXED, __HIP_MEMORY_SCOPE_AGENT)) != (unsigned)(4 * 2 * NCHK)) __builtin_amdgcn_s_sleep(2); }
      __syncthreads();
      __builtin_amdgcn_fence(__ATOMIC_ACQUIRE, "agent");
      e_ready = true; }
    if (i < n_s5) { s5_out_item(c, l, i >> 6, 0, i & 63); continue; }
    i -= n_s5;
    s5_out_item(c, l, i >> 2, 1, i & 3);
  }
#ifdef PROBE_A
  if (blockIdx.x == 0 && ((int)threadIdx.x) == 0) { unsigned long long* tsl_ = reinterpret_cast<unsigned long long*>(c.lds + 158720); tsl_[47 + l] = __builtin_amdgcn_s_memrealtime() - tq0; }
#endif
}

__device__ __forceinline__ void step_merge(const Ctx& c, int l, bool last) {
  const char* wl = c.p.ws + OFF_WS + (size_t)l * WS_LAYER;
  const u16* WGLU = (const u16*)(wl + WS_GLU); const u16* WGM = (const u16*)(wl + WS_GM); const u16* WDA = (const u16*)(wl + WS_DA);
  const u16* P = c.w<u16>(OFF_BIG + BIG_P); const u16* YA = c.w<u16>(OFF_BIG + BIG_YA); const u16* YB = c.w<u16>(OFF_BIG + BIG_YB); const u16* YC = c.w<u16>(OFF_BIG + BIG_YC);
  u16* Mb = c.w<u16>(OFF_BIG + BIG_M);
  const int wm = ((int)__builtin_amdgcn_readfirstlane(threadIdx.x >> 6)) >> 1, wn = ((int)__builtin_amdgcn_readfirstlane(threadIdx.x >> 6)) & 1, fr = ((int)threadIdx.x & 63) & 15, fq = ((int)threadIdx.x & 63) >> 4;
  const int ntm = last ? 64 : 68;
  XSched s = xsched(ntm * 16);
  if (s.pos >= s.end) return;
#define TILE_OF(L) const int band = (L) / (4 * 16), rem = (L) % (4 * 16), tn = rem >> 2, tm = band * 4 + (rem & 3)
  auto p_gv = [&](int L) { TILE_OF(L); return gs_ptrs([&](int r) { return YA + (size_t)(tm * 256 + r) * 256; }, [&](int b) { return WGLU + (size_t)(tn * 64 + b) * 256; }); };
  auto p_gg = [&](int L) { TILE_OF(L); return gs_ptrs([&](int r) { return YA + (size_t)(tm * 256 + r) * 256; }, [&](int b) { return WGLU + (size_t)(1024 + tn * 64 + b) * 256; }); };
  auto p_gm = [&](int L) { TILE_OF(L); return gs_ptrs([&](int r) { return YB + (size_t)(tm * 256 + r) * 256; }, [&](int b) { return WGM + (size_t)(tn * 64 + b) * 256; }); };
  auto p_da = [&](int L) { TILE_OF(L); return gs_ptrs([&](int r) { return YC + (size_t)(tm * 256 + r) * 512; }, [&](int b) { return WDA + (size_t)(tn * 64 + b) * 512; }); };
  GStream g; gs_start(g, p_gv(s.pos), 4, p_gg(s.pos), 4, c.lds);
  for (;;) {
    TILE_OF(s.pos);
    const int nx = s.pos + s.step; const bool hn = nx < s.end;
    f32x4 am[4][2];
#define GATE4(G, J) ((J) == 0 ? bflo(G.x) : (J) == 1 ? bfhi(G.x) : (J) == 2 ? bflo(G.y) : bfhi(G.y))
    { f32x4 tv[4][2], tg[4][2]; ZERO_ACC2(tv); ZERO_ACC2(tg);
      gs_run<2>(g, tv, c.lds); gs_advance(g);
      gs_set_next(g, p_gm(s.pos), 4);
      gs_run<2>(g, tg, c.lds); gs_advance(g);
      { EPI_M(tm * 256)
          const u16* gp = P + (size_t)row * INW + 2304 + tn * 64 + wn * 32 + fq * 4;
#pragma unroll
          for (int n = 0; n < 2; ++n) { const uint2 gg = *reinterpret_cast<const uint2*>(gp + n * 16);
#pragma unroll
            for (int j = 0; j < 4; ++j) am[m][n][j] = GATE4(gg, j) * tv[m][n][j] * sigmoidf_(tg[m][n][j]); }
        EPI_M_END } }
    { f32x4 t[4][2]; ZERO_ACC2(t);
      gs_set_next(g, p_da(s.pos), 8);
      gs_run<2>(g, t, c.lds); gs_advance(g);
      { EPI_M(tm * 256)
          const u16* gp = P + (size_t)row * INW + 2304 + 1024 + tn * 64 + wn * 32 + fq * 4;
#pragma unroll
          for (int n = 0; n < 2; ++n) { const uint2 gg = *reinterpret_cast<const uint2*>(gp + n * 16);
#pragma unroll
            for (int j = 0; j < 4; ++j) am[m][n][j] += GATE4(gg, j) * t[m][n][j]; }
        EPI_M_END } }
    { f32x4 t[4][2]; ZERO_ACC2(t);
      if (hn) gs_set_next(g, p_gv(nx), 4);
      gs_run<2>(g, t, c.lds);
      { EPI_M(tm * 256)
          const u16* gp = P + (size_t)row * INW + 2304 + 2048 + tn * 64 + wn * 32 + fq * 4;
#pragma unroll
          for (int n = 0; n < 2; ++n) { const uint2 gg = *reinterpret_cast<const uint2*>(gp + n * 16);
#pragma unroll
            for (int j = 0; j < 4; ++j) am[m][n][j] += GATE4(gg, j) * t[m][n][j]; }
        EPI_M_END } }
#undef GATE4
    epi_tile<2, 8>(c.lds, [&](int m, int n) { return am[m][n]; },
      [&](int row, int col, u32x4 v) { *reinterpret_cast<u32x4*>(Mb + (size_t)(tm * 256 + row) * 1024 + tn * 64 + col) = v; });
    if (!hn) break;
    gs_advance(g); s.pos = nx;
    gs_set_next(g, p_gg(nx), 4);
  }
#undef TILE_OF
}

__device__ __forceinline__ void step_out(const Ctx& c, int l, bool last) {
  const u16* WOUT = (const u16*)(c.p.ws + OFF_WS + (size_t)l * WS_LAYER + WS_OUT);
  const u16* Mb = c.w<u16>(OFF_BIG + BIG_M); u16* H = c.w<u16>(OFF_H);
  const int ntm = last ? 64 : 68;
  DenseSched<true> S{(const char*)Mb, (const char*)WOUT, 1024, 4, ntm * 4};
  g8::phase<DUnit>(c.lds, 1024, S, [&](const g8::Acc& acc, const DUnit& u, int wr, int wc, int fr, int fq) {
    float4 gq[2][2];
    { const float* g1 = c.mod(l, brow_of(u.pm * 256), 2) + u.pn * 256 + wc * 32 + 8 * fq;
#pragma unroll
      for (int bj = 0; bj < 2; ++bj) { gq[bj][0] = gld4(g1 + bj * 128); gq[bj][1] = gld4(g1 + bj * 128 + 4); } }
    const int col0 = u.pn * 256 + wc * 32 + 8 * fq;
#pragma unroll
    for (int ai = 0; ai < 2; ++ai)
#pragma unroll
      for (int mh = 0; mh < 2; ++mh) {
        f32x4 hx[2][2][2]; u32x4 hb[2][2];
#pragma unroll
        for (int mi = 0; mi < 2; ++mi) {
          const int row = u.pm * 256 + ai * 128 + wr * 64 + (mh * 2 + mi) * 16 + fr;
#pragma unroll
          for (int bj = 0; bj < 2; ++bj) {
            if (l == 0) { const float* hs = (row < TLAT ? c.in(I_X) + (size_t)row * 1024 : c.in(I_CTX) + (size_t)(row - TLAT) * 1024) + col0 + bj * 128;
              hx[mi][bj][0] = *(const GAS1 f32x4*)hs; hx[mi][bj][1] = *(const GAS1 f32x4*)(hs + 4); }
            else hb[mi][bj] = *reinterpret_cast<const u32x4*>(H + (size_t)row * 1024 + col0 + bj * 128);
          }
        }
#pragma unroll
        for (int mi = 0; mi < 2; ++mi) {
          const int m = mh * 2 + mi, row = u.pm * 256 + ai * 128 + wr * 64 + m * 16 + fr;
          u16* hd = H + (size_t)row * 1024 + col0;
#pragma unroll
          for (int bj = 0; bj < 2; ++bj) {
            const f32x4 v0 = acc[ai][bj][m][0], v1 = acc[ai][bj][m][1];
            float h[8];
            if (l == 0) {
#pragma unroll
              for (int e = 0; e < 4; ++e) { h[e] = hx[mi][bj][0][e]; h[4 + e] = hx[mi][bj][1][e]; } }
            else {
#pragma unroll
              for (int e = 0; e < 4; ++e) { h[2 * e] = bflo(hb[mi][bj][e]); h[2 * e + 1] = bfhi(hb[mi][bj][e]); } }
            const float4 ga = gq[bj][0], gb = gq[bj][1];
            u32x4 w; w.x = pack2(ALPHA * h[0] + ga.x * v0[0], ALPHA * h[1] + ga.y * v0[1]); w.y = pack2(ALPHA * h[2] + ga.z * v0[2], ALPHA * h[3] + ga.w * v0[3]);
            w.z = pack2(ALPHA * h[4] + gb.x * v1[0], ALPHA * h[5] + gb.y * v1[1]); w.w = pack2(ALPHA * h[6] + gb.z * v1[2], ALPHA * h[7] + gb.w * v1[3]);
            *reinterpret_cast<u32x4*>(hd + bj * 128) = w;
          }
        }
      }
  });
  if (!last) {
    const int G = (int)gridDim.x, extra = (ntm * 4) % G;
    const int j = extra > 0 ? (int)blockIdx.x - extra : (int)blockIdx.x, nidle = extra > 0 ? G - extra : G;
    if (j >= 0) { for (int it = NCVT_EXP - CV_OUT(l) + j; it < NCVT_EXP; it += nidle) cvt_expert(c, l, it);
      for (int it = j; it < NCVT_SMALL; it += nidle) cvt_small(c, 1, it); }
  }
}

__device__ __forceinline__ void step_ln_mid(const Ctx& c, int l, int mrows) {
  u16* H = c.w<u16>(OFF_H); u16* F = c.w<u16>(OFF_ACT);
  for (int it = blockIdx.x; it < mrows / 8; it += gridDim.x) {
    const int row = it * 8 + ((int)__builtin_amdgcn_readfirstlane(threadIdx.x >> 6)); float v[16]; load_row_bf(H + (size_t)row * 1024, ((int)threadIdx.x & 63), v);
    ln_affine(v, c.in(I_LN1G) + l * 1024, c.in(I_LN1B) + l * 1024, ((int)threadIdx.x & 63));
    store_row_bf(H + (size_t)row * 1024, ((int)threadIdx.x & 63), v);
    const int br = brow_of(row);
    ln_mod_store(v, c.mod(l, br, 3), c.mod(l, br, 4), F + (size_t)row * 1024, ((int)threadIdx.x & 63));
  }
}

#define ROUTER_RPB(LAST) ((LAST) ? 64 : 68)
template <bool LAST>
__device__ __forceinline__ void step_router(const Ctx& c, int l, int halfrows) {
  constexpr int RPB = ROUTER_RPB(LAST), NRB = (RPB + 31) / 32, MROWS = LAST ? TLAT : MTOT;
  const u16* F = c.w<u16>(OFF_ACT); const u16* WR = (const u16*)(c.p.ws + OFF_WS + (size_t)l * WS_LAYER + WS_R);
  float* topw = c.w<float>(OFF_TOPW); int* sele = c.w<int>(OFF_SELE);
  int tid = (int)threadIdx.x; asm volatile("" : "+v"(tid));
  const int lane = tid & 63, r32 = lane & 31, hi = lane >> 5, wid = (int)__builtin_amdgcn_readfirstlane(tid >> 6);
  float* part = reinterpret_cast<float*>(c.lds);
  int* lcnt = reinterpret_cast<int*>(c.lds + 8 * 68 * 64 * 4);
  if (tid < 128) lcnt[tid] = 0;
  __syncthreads();
  const float bias = c.in(I_BR)[l * 64 + lane];
  for (int it = blockIdx.x; it < MROWS / RPB; it += gridDim.x) {
    const int row0 = it * RPB;
    {
      u16* H = c.w<u16>(OFF_H); u16* Fw = c.w<u16>(OFF_ACT);
#pragma unroll 1
      for (int bt = 0; bt < 3; ++bt) {
        if (wid + 24 * bt >= RPB) break;
        float v[3][16];
#pragma unroll
        for (int s = 0; s < 3; ++s) { const int rw_ = wid + 8 * (3 * bt + s), rw = rw_ < RPB ? rw_ : wid; load_row_bf(H + (size_t)(row0 + rw) * 1024, lane, v[s]); }
#pragma unroll
        for (int s = 0; s < 3; ++s) { const int rw_ = wid + 8 * (3 * bt + s), rw = rw_ < RPB ? rw_ : wid; const int row = row0 + rw;
          ln_affine(v[s], c.in(I_LN1G) + l * 1024, c.in(I_LN1B) + l * 1024, lane);
          if (rw_ < RPB) { store_row_bf(H + (size_t)row * 1024, lane, v[s]); const int br = brow_of(row);
            ln_mod_store(v[s], c.mod(l, br, 3), c.mod(l, br, 4), Fw + (size_t)row * 1024, lane); } }
      }
    }
    __syncthreads();
    f32x16 acc[NRB][2];
#pragma unroll
    for (int rb = 0; rb < NRB; ++rb) { acc[rb][0] = f32x16{}; acc[rb][1] = f32x16{}; }
    const u16* ap[NRB];
#pragma unroll
    for (int rb = 0; rb < NRB; ++rb) { int rr = rb * 32 + r32; rr = rr < RPB ? rr : RPB - 1; ap[rb] = F + (size_t)(row0 + rr) * 1024 + wid * 128 + hi * 8; }
    const u16* bp = WR + (size_t)r32 * 1024 + wid * 128 + hi * 8;
#pragma unroll
    for (int ks = 0; ks < 8; ++ks) {
      bf16x8 b[4];
#pragma unroll
      for (int nb = 0; nb < 4; ++nb) b[nb] = *reinterpret_cast<const bf16x8*>(bp + (size_t)nb * 32 * 1024 + ks * 16);
#pragma unroll
      for (int rb = 0; rb < NRB; ++rb) { const bf16x8 a = *reinterpret_cast<const bf16x8*>(ap[rb] + ks * 16);
#pragma unroll
        for (int nh = 0; nh < 2; ++nh) { acc[rb][nh] = __builtin_amdgcn_mfma_f32_32x32x16_bf16(a, b[nh], acc[rb][nh], 0, 0, 0);
          acc[rb][nh] = __builtin_amdgcn_mfma_f32_32x32x16_bf16(a, b[2 + nh], acc[rb][nh], 0, 0, 0); } }
    }
#pragma unroll
    for (int rb = 0; rb < NRB; ++rb)
#pragma unroll
      for (int r = 0; r < 16; ++r) { const int rr = rb * 32 + crow(r, hi);
        if (rr < RPB) { float* pr = part + ((wid * RPB + rr) * 64 + r32); pr[0] = acc[rb][0][r]; pr[32] = acc[rb][1][r]; } }
    __syncthreads();
#pragma unroll 1
    for (int bt = 0; bt < 3; ++bt) {
      if (wid + 24 * bt >= RPB) break;
      int ln = lane; asm volatile("" : "+v"(ln));
      int key[3]; float score[3];
#pragma unroll
      for (int s = 0; s < 3; ++s) {
        const int rw_ = wid + 8 * (3 * bt + s), rw = rw_ < RPB ? rw_ : wid;
        float lgt = 0.f;
#pragma unroll
        for (int w = 0; w < 8; ++w) lgt += part[(w * RPB + rw) * 64 + lane];
        const float sc = sigmoidf_(lgt), sel = sc + bias; score[s] = sc;
        float m1 = sel;
        m1 = fmaxf(m1, __shfl_xor(m1, 1, 64)); m1 = fmaxf(m1, __shfl_xor(m1, 2, 64)); m1 = fmaxf(m1, __shfl_xor(m1, 4, 64));
        const unsigned long long bm = __ballot(sel == m1);
        const unsigned grp = (unsigned)((bm >> (lane & ~7)) & 0xffull);
        const int first = __ffs((int)grp) - 1;
        float s2 = ((lane & 7) == first) ? -3.0e38f : sel;
        s2 = fmaxf(s2, __shfl_xor(s2, 1, 64)); s2 = fmaxf(s2, __shfl_xor(s2, 2, 64)); s2 = fmaxf(s2, __shfl_xor(s2, 4, 64));
        const float gs = m1 + s2; const int g8 = lane >> 3;
        int cg = 0;
#pragma unroll
        for (int jg = 0; jg < 8; ++jg) { const float gj = __shfl(gs, jg * 8, 64); cg += (gj > gs || (gj == gs && jg < g8)) ? 1 : 0; }
        int kb = __float_as_int(sel); kb ^= (kb >> 31) & 0x7fffffff;
        key[s] = (cg < 4) ? ((kb & ~63) | (63 - lane)) : (int)(0x80000000u | (unsigned)(63 - lane));
      }
#pragma unroll
      for (int k = 2; k <= 64; k <<= 1)
#pragma unroll
        for (int j = k >> 1; j > 0; j >>= 1) {
          const bool takemax = (((ln & j) == 0) == ((ln & k) == 0));
#pragma unroll
          for (int s = 0; s < 3; ++s) { const int o = __shfl_xor(key[s], j, 64); key[s] = takemax ? max(key[s], o) : min(key[s], o); }
        }
      int esel[3]; float wv[3];
#pragma unroll
      for (int s = 0; s < 3; ++s) { const int e = 63 - (key[s] & 63); const float sv = __shfl(score[s], e, 64);
        float ws = lane < 8 ? sv : 0.f; ws += __shfl_xor(ws, 1, 64); ws += __shfl_xor(ws, 2, 64); ws += __shfl_xor(ws, 4, 64);
        esel[s] = e; wv[s] = sv / ws * 2.5f; }
      if (lane < 8) {
#pragma unroll
        for (int s = 0; s < 3; ++s) { const int rw_ = wid + 8 * (3 * bt + s);
          if (rw_ < RPB) { const int tok = row0 + rw_; const int hh = tok >= halfrows ? 1 : 0;
            topw[(size_t)tok * 8 + lane] = wv[s]; sele[(size_t)tok * 8 + lane] = esel[s];
            atomicAdd(&lcnt[hh * 64 + esel[s]], 1); } }
      }
    }
    __syncthreads();
  }
  if (tid < 128) c.w<int>(OFF_CNTB)[blockIdx.x * 128 + tid] = lcnt[tid];
}
__device__ __forceinline__ void step_scatter(const Ctx& c, int l, int mrows, int halfrows) {
  int* cnt = c.w<int>(OFF_CNT) + l * 128; int* list = c.w<int>(OFF_LIST); int* sele = c.w<int>(OFF_SELE); const int* cntb = c.w<int>(OFF_CNTB);
  int* base = reinterpret_cast<int*>(c.lds); int* run = base + 128; int* tot = base + 256; int* ebh = base + 384;
  {
    const int t = ((int)threadIdx.x) & 127, part = ((int)threadIdx.x) >> 7; int s = 0, tt = 0; const int nb = (int)gridDim.x, b0 = part * ((nb + 3) >> 2), b1 = min(nb, b0 + ((nb + 3) >> 2));
    int b = b0;
    for (; b + 16 <= b1; b += 16) {
      int v[16];
#pragma unroll
      for (int j = 0; j < 16; ++j) v[j] = cntb[(b + j) * 128 + t];
#pragma unroll
      for (int j = 0; j < 16; ++j) { if (b + j < (int)blockIdx.x) s += v[j]; tt += v[j]; } }
    for (; b < b1; ++b) { const int v = cntb[b * 128 + t]; if (b < (int)blockIdx.x) s += v; tt += v; }
    int* ps = base + 512 + part * 256; ps[t] = s; ps[128 + t] = tt; }
  __syncthreads();
  if (((int)threadIdx.x) < 128) { int s = 0, tt = 0;
#pragma unroll
    for (int part = 0; part < 4; ++part) { s += base[512 + part * 256 + ((int)threadIdx.x)]; tt += base[512 + part * 256 + 128 + ((int)threadIdx.x)]; }
    base[((int)threadIdx.x)] = s; run[((int)threadIdx.x)] = 0; tot[((int)threadIdx.x)] = tt; if (blockIdx.x == 0) cnt[((int)threadIdx.x)] = tt; }
  __syncthreads();
  if (((int)threadIdx.x) < 128) { int s = 0; const int h0 = ((int)threadIdx.x) & 64; for (int e = h0; e < ((int)threadIdx.x); ++e) s += tot[e]; ebh[((int)threadIdx.x)] = s; }
  __syncthreads();
  const int rpb = (mrows == TLAT) ? ROUTER_RPB(true) : ROUTER_RPB(false);
  for (int it = blockIdx.x; it < mrows / rpb; it += gridDim.x) {
    for (int q = (int)threadIdx.x; q < rpb * 8; q += NTHR) { const int tok = it * rpb + (q >> 3), rk = q & 7; const int e = sele[(size_t)tok * 8 + rk]; const int hh = tok >= halfrows ? 1 : 0;
      const int pos = base[hh * 64 + e] + atomicAdd(&run[hh * 64 + e], 1);
      list[((size_t)hh * 64 + e) * 8704 + pos] = tok * 8 + rk;
      sele[(size_t)tok * 8 + rk] = ebh[hh * 64 + e] + pos; }
  }
  __syncthreads();
}

#define MOE_LDS_OFF 159744
__device__ __forceinline__ int moe_schedule(const Ctx& c, int l, int hh, int halfrows) {
  int* pre = reinterpret_cast<int*>(c.lds + MOE_LDS_OFF); int* cn = pre + 72; int* eb = cn + 72;
  const int* cnt = c.w<int>(OFF_CNT) + l * 128 + hh * 64;
  if (((int)threadIdx.x) < 64) {
    const int e = (int)threadIdx.x; const int n = cnt[e]; const int tl = (n + 255) >> 8;
    int s = tl, r = n;
#pragma unroll
    for (int d = 1; d < 64; d <<= 1) { const int s2 = __shfl_up(s, d, 64), r2 = __shfl_up(r, d, 64); if (e >= d) { s += s2; r += r2; } }
    cn[e] = n; pre[e] = s - tl; eb[e] = r - n;
    if (e == 63) { cn[64] = halfrows; pre[64] = s; eb[64] = r; pre[65] = s + ((halfrows + 255) >> 8); } }
  __syncthreads();
  return pre[65];
}
struct MUnit { int e, rti, tn, ne, eb; };
struct MoeSchedBase {
  const int* pre; const int* cn; const int* eb; int total, NTN;
  __device__ __forceinline__ bool decode(int i, MUnit& u) const {
    const int L0 = i * (int)gridDim.x + (int)blockIdx.x; if (L0 >= total) return false;
    const int L = (gridDim.x & 7) == 0 ? xcd_remap(L0, total) : L0;
    const int rt = L / NTN; u.tn = L - rt * NTN;
    int lo = 0, hi = 64;
#pragma unroll
    for (int s = 0; s < 7; ++s) { const int mid = (lo + hi + 1) >> 1; if (pre[mid] <= rt) lo = mid; else hi = mid - 1; }
    u.e = lo; u.rti = rt - pre[lo]; u.ne = cn[lo]; u.eb = eb[lo]; return true; }
};
struct MoeUpSched : MoeSchedBase {
  const char* F; const char* WE; const int* list; int tok0;
  __device__ __forceinline__ bool next(int i, MUnit& u) const { return decode(i, u); }
  __device__ __forceinline__ const char* abase(const MUnit&) const { return F; }
  __device__ __forceinline__ const char* bbase(const MUnit& u) const { return WE + (size_t)u.e * WE_ONE + (size_t)u.tn * 128 * 1024 * 2; }
  __device__ __forceinline__ void aoffs(const MUnit& u, int R0, int R1, int C0, int C1, unsigned (&o)[2][2]) const {
    const int* le = list + (size_t)u.e * 8704;
#pragma unroll
    for (int h = 0; h < 2; ++h) {
      int i0 = u.rti * 256 + h * 128 + R0, i1 = u.rti * 256 + h * 128 + R1; if (i0 >= u.ne) i0 = 0; if (i1 >= u.ne) i1 = 0;
      const int t0 = u.e < 64 ? (le[i0] >> 3) : tok0 + i0, t1 = u.e < 64 ? (le[i1] >> 3) : tok0 + i1;
      o[h][0] = (unsigned)(t0 * 1024 + C0) * 2u; o[h][1] = (unsigned)(t1 * 1024 + C1) * 2u; } }
  __device__ __forceinline__ unsigned boff(int row, int C) const { const int gi = row >> 5, rho = row & 31; return (unsigned)((((rho >> 4) ? 256 : 0) + gi * 16 + (rho & 15)) * 1024 + C) * 2u; }
};
__device__ __forceinline__ void step_moe_up(const Ctx& c, int l, int hh, int halfrows) {
  const int RT = moe_schedule(c, l, hh, halfrows);
  MoeUpSched S; S.pre = reinterpret_cast<const int*>(c.lds + MOE_LDS_OFF); S.cn = S.pre + 72; S.eb = S.cn + 72; S.NTN = 2; S.total = RT * 2;
  S.F = (const char*)c.w<u16>(OFF_ACT); S.WE = c.p.ws + OFF_WE; S.list = c.w<int>(OFF_LIST) + (size_t)hh * 64 * 8704; S.tok0 = hh * halfrows;
  u16* HD = c.w<u16>(OFF_BIG + BIG_HD); u16* HS = c.w<u16>(OFF_BIG + BIG_HS);
  g8::phase<MUnit>(c.lds, 1024, S, [&](const g8::Acc& acc, const MUnit& u, int wr, int wc, int fr, int fq) {
#pragma unroll
    for (int ai = 0; ai < 2; ++ai)
#pragma unroll
      for (int m = 0; m < 4; ++m) {
        const int idx = u.rti * 256 + ai * 128 + wr * 64 + m * 16 + fr;
        if (idx < u.ne) {
          u16* dst = (u.e < 64 ? HD + (size_t)(u.eb + idx) * 256 : HS + (size_t)idx * 256) + u.tn * 128 + wc * 16 + 4 * fq;
#pragma unroll
          for (int bj = 0; bj < 2; ++bj) { const f32x4 g = acc[ai][bj][m][0], up = acc[ai][bj][m][1];
            *reinterpret_cast<uint2*>(dst + bj * 64) = make_uint2(pack2(silu_(g[0]) * up[0], silu_(g[1]) * up[1]), pack2(silu_(g[2]) * up[2], silu_(g[3]) * up[3])); }
        }
      }
  });
}
struct MoeDownSched : MoeSchedBase {
  const char* HD; const char* HS; const char* WE;
  __device__ __forceinline__ bool next(int i, MUnit& u) const { return decode(i, u); }
  __device__ __forceinline__ const char* abase(const MUnit& u) const { return u.e < 64 ? HD + (size_t)(u.eb + u.rti * 256) * 512 : HS + (size_t)(u.rti * 256) * 512; }
  __device__ __forceinline__ const char* bbase(const MUnit& u) const { return WE + (size_t)u.e * WE_ONE + WE_GU + (size_t)u.tn * 256 * 256 * 2; }
  __device__ __forceinline__ void aoffs(const MUnit&, int R0, int R1, int C0, int C1, unsigned (&o)[2][2]) const {
#pragma unroll
    for (int h = 0; h < 2; ++h) { o[h][0] = (unsigned)((h * 128 + R0) * 256 + C0) * 2u; o[h][1] = (unsigned)((h * 128 + R1) * 256 + C1) * 2u; } }
  __device__ __forceinline__ unsigned boff(int row, int C) const { return (unsigned)(((row & ~31) + g8::perm32(row & 31)) * 256 + C) * 2u; }
};
__device__ __forceinline__ void step_moe_down(const Ctx& c, int l, int hh, int halfrows) {
  const int RT = moe_schedule(c, l, hh, halfrows);
  MoeDownSched S; S.pre = reinterpret_cast<const int*>(c.lds + MOE_LDS_OFF); S.cn = S.pre + 72; S.eb = S.cn + 72; S.NTN = 4; S.total = RT * 4;
  S.HD = (const char*)c.w<u16>(OFF_BIG + BIG_HD); S.HS = (const char*)c.w<u16>(OFF_BIG + BIG_HS); S.WE = c.p.ws + OFF_WE;
  u16* YR = c.w<u16>(OFF_BIG + BIG_YR); u16* YS = c.w<u16>(OFF_BIG + BIG_YS);
  g8::phase<MUnit>(c.lds, 256, S, [&](const g8::Acc& acc, const MUnit& u, int wr, int wc, int fr, int fq) {
    u16* base = (u.e < 64 ? YR + (size_t)u.eb * 1024 : YS) + u.tn * 256 + wc * 32 + 8 * fq;
#pragma unroll
    for (int ai = 0; ai < 2; ++ai)
#pragma unroll
      for (int m = 0; m < 4; ++m) {
        const int idx = u.rti * 256 + ai * 128 + wr * 64 + m * 16 + fr;
        if (idx < u.ne) {
          u16* dst = base + (size_t)idx * 1024;
#pragma unroll
          for (int bj = 0; bj < 2; ++bj) { const f32x4 v0 = acc[ai][bj][m][0], v1 = acc[ai][bj][m][1];
            u32x4 w; w.x = pack2(v0[0], v0[1]); w.y = pack2(v0[2], v0[3]); w.z = pack2(v1[0], v1[1]); w.w = pack2(v1[2], v1[3]);
            *reinterpret_cast<u32x4*>(dst + bj * 128) = w; }
        }
      }
  });
}
__device__ __forceinline__ void combine_items(const Ctx& c, int l, bool last, int hh, int halfrows, int first, int end, int stride) {
  u16* H = c.w<u16>(OFF_H); const u16* YR = c.w<u16>(OFF_BIG + BIG_YR); u16* U = c.w<u16>(OFF_ACT);
  const int tok0 = hh * halfrows;
  for (int it = first; it < end; it += stride) {
    const int tok = tok0 + it * 8 + ((int)__builtin_amdgcn_readfirstlane(threadIdx.x >> 6)); float v[16]; load_row_bf(H + (size_t)tok * 1024, ((int)threadIdx.x & 63), v);
    float s[16];
#pragma unroll
    for (int i = 0; i < 16; ++i) s[i] = 0.f;
#pragma unroll
    for (int k = 0; k < 8; ++k) { const int sp = c.w<int>(OFF_SELE)[(size_t)tok * 8 + k]; const float wk = c.w<float>(OFF_TOPW)[(size_t)tok * 8 + k];
      const u16* yr = YR + (size_t)sp * 1024;
#pragma unroll
      for (int i = 0; i < 4; ++i) { uint2 t = *reinterpret_cast<const uint2*>(yr + (i * 64 + ((int)threadIdx.x & 63)) * 4); s[i * 4] += wk * bflo(t.x); s[i * 4 + 1] += wk * bfhi(t.x); s[i * 4 + 2] += wk * bflo(t.y); s[i * 4 + 3] += wk * bfhi(t.y); } }
    { const u16* ys = c.w<u16>(OFF_BIG + BIG_YS) + (size_t)(tok - tok0) * 1024;
#pragma unroll
      for (int i = 0; i < 4; ++i) { uint2 t = *reinterpret_cast<const uint2*>(ys + (i * 64 + ((int)threadIdx.x & 63)) * 4); s[i * 4] += bflo(t.x); s[i * 4 + 1] += bfhi(t.x); s[i * 4 + 2] += bflo(t.y); s[i * 4 + 3] += bfhi(t.y); } }
    const float* g2 = c.mod(l, brow_of(tok), 5);
#pragma unroll
    for (int i = 0; i < 4; ++i) { float4 g = gld4(g2 + (i * 64 + ((int)threadIdx.x & 63)) * 4);
      v[i * 4] = ALPHA * v[i * 4] + g.x * s[i * 4]; v[i * 4 + 1] = ALPHA * v[i * 4 + 1] + g.y * s[i * 4 + 1]; v[i * 4 + 2] = ALPHA * v[i * 4 + 2] + g.z * s[i * 4 + 2]; v[i * 4 + 3] = ALPHA * v[i * 4 + 3] + g.w * s[i * 4 + 3]; }
    ln_affine(v, c.in(I_LN2G) + l * 1024, c.in(I_LN2B) + l * 1024, ((int)threadIdx.x & 63));
    if (last) { store_row(c.p.out + (size_t)tok * 1024, ((int)threadIdx.x & 63), v); }
    else { store_row_bf(H + (size_t)tok * 1024, ((int)threadIdx.x & 63), v); const int br = brow_of(tok);
      ln_mod_store(v, c.mod(l + 1, br, 0), c.mod(l + 1, br, 1), U + (size_t)tok * 1024, ((int)threadIdx.x & 63)); }
  }
}
__device__ __forceinline__ void step_combine(const Ctx& c, int l, bool last, int hh, int halfrows) { combine_items(c, l, last, hh, halfrows, (int)blockIdx.x, halfrows / 8, (int)gridDim.x); }
#define CMB_CAP 5
__device__ __forceinline__ void moe_up_tail_combine(const Ctx& c, int l, bool last, int halfrows) {
  const int RT = reinterpret_cast<const int*>(c.lds + MOE_LDS_OFF)[65];
  const int G = (int)gridDim.x, extra = (RT * 2) % G, n_items = halfrows / 8;
  const int n_idle = extra > 0 ? G - extra : 0, j = (int)blockIdx.x - extra;
  int n_free = n_idle * CMB_CAP; n_free = n_free < n_items ? n_free : n_items;
#pragma unroll 1
  for (int pass = 0; pass < 2; ++pass) {
    int first, end, stride;
    if (pass == 0) { if (n_idle == 0 || j < 0) continue; first = j; end = n_free; stride = n_idle; }
    else { first = n_free + (int)blockIdx.x; end = n_items; stride = G; }
    combine_items(c, l, last, 0, halfrows, first, end, stride);
  }
}


#define XB_TMO      128
#define XB_XCNT(j)  (256  + 64 * (j))
#define XB_XSUB(j)  (1280 + 64 * (j))
#define XB_XGEN(j)  (2304 + 64 * (j))
#define XB_TOP      3328
#define XB_TOPGEN   3392
#define XCD_BAR_WORDS 3456
#define XB_SPIN_CAP (1u << 22)
#define LAS __attribute__((address_space(3)))
__device__ __forceinline__ unsigned xb_ld(unsigned* p)              { return __hip_atomic_load(p, __ATOMIC_RELAXED, __HIP_MEMORY_SCOPE_AGENT); }
__device__ __forceinline__ unsigned xb_add(unsigned* p, unsigned v) { return __hip_atomic_fetch_add(p, v, __ATOMIC_RELAXED, __HIP_MEMORY_SCOPE_AGENT); }
__device__ __forceinline__ unsigned xb_xcc_id() { return (unsigned)__builtin_amdgcn_s_getreg((3 << 11) | 20) & 0xFu; }
#define XB_SPIN(cond, bar) do { unsigned _sp = 0; while (cond) { __builtin_amdgcn_s_sleep(1); \
    if ((++_sp & 255u) == 0u) { if (xb_ld(&(bar)[XB_TMO])) break; if (_sp > XB_SPIN_CAP) { atomicAdd(&(bar)[XB_TMO], 1u); break; } } } } while (0)
struct XcdBarrier { unsigned* bar; unsigned x; volatile LAS unsigned* st; };
__device__ __forceinline__ XcdBarrier xcd_barrier_post(unsigned* bar, volatile LAS unsigned* st) {
    XcdBarrier b; b.bar = bar; b.x = xb_xcc_id(); b.st = st;
    if (threadIdx.x == 0) (void)xb_add(&bar[XB_XCNT(b.x)], 1u);
    return b;
}
__device__ __forceinline__ void xcd_barrier_complete(unsigned* bar, unsigned x, unsigned& nloc, unsigned& nx) {
    const unsigned G = gridDim.x * gridDim.y * gridDim.z;
    unsigned sum, cnt, mine, sp = 0u;
    for (;;) {
        sum = 0u; cnt = 0u; mine = 0u;
#pragma unroll
        for (unsigned j = 0; j < 16; ++j) { const unsigned c = xb_ld(&bar[XB_XCNT(j)]); sum += c; cnt += (c > 0u) ? 1u : 0u; mine = (j == x) ? c : mine; }
        if (sum == G) break;
        __builtin_amdgcn_s_sleep(1);
        if ((++sp & 255u) == 0u) { if (xb_ld(&bar[XB_TMO])) break; if (sp > XB_SPIN_CAP) { atomicAdd(&bar[XB_TMO], 1u); break; } }
    }
    nloc = mine > 0u ? mine : 1u; nx = cnt > 0u ? cnt : 1u;
}
__device__ __forceinline__ void xcd_barrier(const XcdBarrier& b) {
    asm volatile("s_waitcnt vmcnt(0)" ::: "memory");
    __syncthreads();
    if (threadIdx.x == 0) {
        unsigned* bar = b.bar;
        __builtin_amdgcn_s_waitcnt(0);
        unsigned nloc = b.st[0], nx = b.st[1];
        if (nloc == 0u) { xcd_barrier_complete(bar, b.x, nloc, nx); b.st[0] = nloc; b.st[1] = nx; }
        const unsigned old = xb_add(&bar[XB_XSUB(b.x)], 1u);
        const unsigned gen = old / nloc;
        if (old + 1u == (gen + 1u) * nloc) {
            __builtin_amdgcn_fence(__ATOMIC_RELEASE, "agent");
            asm volatile("s_waitcnt vmcnt(0)" ::: "memory");
            const unsigned og = xb_add(&bar[XB_TOP], 1u);
            const unsigned tg = og / nx;
            if (og + 1u == (tg + 1u) * nx) xb_add(&bar[XB_TOPGEN], 1u);
            else XB_SPIN(xb_ld(&bar[XB_TOPGEN]) == tg, bar);
            __builtin_amdgcn_fence(__ATOMIC_ACQUIRE, "agent");
            xb_add(&bar[XB_XGEN(b.x)], 1u);
            asm volatile("s_waitcnt vmcnt(0)" ::: "memory");
        } else {
            XB_SPIN(xb_ld(&bar[XB_XGEN(b.x)]) == gen, bar);
            __builtin_amdgcn_fence(__ATOMIC_ACQUIRE, "agent");
            asm volatile("s_waitcnt vmcnt(0)" ::: "memory");
        }
    }
    __syncthreads();
}

#ifdef ONLY
__device__ __forceinline__ void run_step_only(const Ctx& c) {
  const int l_ = 0; const bool last_ = false;
  if (ONLY == 0) step_prep(c); if (ONLY == 1) step_ln_in(c); if (ONLY == 2) step_gemm_in(c, l_); if (ONLY == 3) step_mix_a(c, l_, last_, 0); if (ONLY == 4) step_mix_b(c, l_, last_);
  if (ONLY == 5) step_merge(c, l_, last_); if (ONLY == 6) step_out(c, l_, last_); if (ONLY == 8) { step_router<false>(c, l_, 8704); step_scatter(c, l_, MTOT, 8704); }
  if (ONLY == 9) step_moe_up(c, l_, 0, 8704); if (ONLY == 10) step_moe_down(c, l_, 0, 8704); if (ONLY == 11) step_combine(c, l_, last_, 0, 8704);
}
#endif
#define N_STEPS 23
template <int L>
__device__ __forceinline__ void run_layer_step(const Ctx& c, int k) {
  constexpr bool last = (L == 1);
  constexpr int mrows = last ? TLAT : MTOT, halfrows = mrows / 2;
  switch (k) {
    case 0: step_gemm_in(c, L); break;
    case 1: step_mix_a(c, L, last, 0); step_mix_b(c, L, last); step_mix_a(c, L, last, 1); break;
    case 2: step_merge(c, L, last); break;
    case 3: step_out(c, L, last); break;
    case 4: step_router<last>(c, L, halfrows); break;
    case 5: step_scatter(c, L, mrows, halfrows); break;
    case 6: step_moe_up(c, L, 0, halfrows); break;
    case 7: step_moe_down(c, L, 0, halfrows); break;
    case 8: step_moe_up(c, L, 1, halfrows); moe_up_tail_combine(c, L, last, halfrows); break;
    case 9: step_moe_down(c, L, 1, halfrows); break;
    default: step_combine(c, L, last, 1, halfrows); break;
  }
}

#define LDS_BYTES 163840
#define XB_ST_OFF 158208
#define TS_OFF 158720
__global__ void __launch_bounds__(NTHR, 2) fwd_kernel(Params p) {
  extern __shared__ __attribute__((aligned(16))) char lds[];
  Ctx c; c.p.ws = p.ws; c.p.out = p.out; c.lds = lds;
  if (threadIdx.x == 0) {
    const float** tab = reinterpret_cast<const float**>(lds + PTR_TAB_OFF);
#pragma unroll
    for (int i = 0; i < N_IN; ++i) tab[i] = p.in[i];
  }
  __syncthreads();
  const int lo = p.s_lo, hi = p.s_hi;
  volatile LAS unsigned* xst = (volatile LAS unsigned*)(lds + XB_ST_OFF);
  if (threadIdx.x == 0) { xst[0] = 0u; xst[1] = 0u; xst[2] = 0u; xst[3] = 0u; }
  __syncthreads();
  XcdBarrier xb = xcd_barrier_post(reinterpret_cast<unsigned*>(p.ws + OFF_BAR), xst);
  int n_sync = 0;
#ifdef PROBE_A
  unsigned long long* tsl = reinterpret_cast<unsigned long long*>(lds + TS_OFF);
  if (blockIdx.x == 0 && threadIdx.x == 0) tsl[0] = __builtin_amdgcn_s_memrealtime();
#define STAMP(S) do { if (blockIdx.x == 0 && threadIdx.x == 0) tsl[(S) + 1] = __builtin_amdgcn_s_memrealtime(); } while (0)
#else
#define STAMP(S) do { } while (0)
#endif
#define GRID_SYNC() do { xcd_barrier(xb); ++n_sync; } while (0)
#ifdef PROBE_A
#define STEP(S, CALL) do { if (lo <= (S) && (S) < hi) { CALL; GRID_SYNC(); STAMP(S); } } while (0)
#else
#define STEP(S, CALL) do { if (lo <= (S) && (S) < hi) { CALL; if ((S) + 1 < hi) GRID_SYNC(); } } while (0)
#endif
#ifdef ONLY
  run_step_only(c);
#else
  STEP(0, (step_prep(c), step_ln_in(c)));
#define LSTEP(L, K) STEP(1 + 11 * (L) + (K), run_layer_step<L>(c, K))
  LSTEP(0, 0); LSTEP(0, 1); LSTEP(0, 2); LSTEP(0, 3); LSTEP(0, 4); LSTEP(0, 5); LSTEP(0, 6); LSTEP(0, 7); LSTEP(0, 8); LSTEP(0, 9); LSTEP(0, 10);
  LSTEP(1, 0); LSTEP(1, 1); LSTEP(1, 2); LSTEP(1, 3); LSTEP(1, 4); LSTEP(1, 5); LSTEP(1, 6); LSTEP(1, 7); LSTEP(1, 8); LSTEP(1, 9); LSTEP(1, 10);
#endif

#ifdef PROBE_A
  {
    __syncthreads();
    float* dsh = reinterpret_cast<float*>(lds + TS_OFF + 512);
    if (blockIdx.x == 0 && threadIdx.x == 0) {
      unsigned long long da = 0, db = 0;
      for (int s = 0; s < N_STEPS; ++s) { const int k12 = (s - 2) % 12; const int kind = s < 2 ? s : (k12 < 5 ? 2 + k12 : (k12 == 5 ? 8 : (k12 == 6 ? 12 : (k12 == 11 ? 11 : 10 - (k12 & 1)))));
        const unsigned long long d = tsl[s + 1] - tsl[s]; if (kind == PROBE_A) da += d; if (kind == PROBE_B) db += d; }
      if (PROBE_A == 20) da = tsl[45]; if (PROBE_B == 21) db = tsl[46]; if (PROBE_A == 22) da = tsl[47]; if (PROBE_B == 23) db = tsl[48];
      dsh[0] = 1.f + (float)da * 0.01f / 250.f;
      dsh[1] = sqrtf((float)db * 0.01f * 1e-5f);
    }
    __syncthreads();
    if (blockIdx.x == 0) {
      for (int q = threadIdx.x; q < 1024 * 1024; q += NTHR) p.out[q] += dsh[1];
      __syncthreads();
      if (threadIdx.x == 0) p.out[5 * 1024 * 1024 + 17] += dsh[0];
    }
  }
#endif
}

extern "C" void kernel_launch(void* const* d_in, const int* in_sizes, int n_in, void* d_out, int out_size, void* d_ws, size_t ws_size, hipStream_t stream) {
  static int grid = 0;
  if (grid == 0) {
    if (n_in != N_IN || ws_size < WS_TOTAL) { fprintf(stderr, "kernel_launch: bad shapes n_in %d ws %zu need %zu\n", n_in, ws_size, (size_t)WS_TOTAL); grid = -1; return; }
    hipFuncSetAttribute((const void*)fwd_kernel, hipFuncAttributeMaxDynamicSharedMemorySize, LDS_BYTES);
    int dev = 0, cus = 0, per_cu = 0; hipGetDevice(&dev); hipDeviceGetAttribute(&cus, hipDeviceAttributeMultiprocessorCount, dev);
    hipOccupancyMaxActiveBlocksPerMultiprocessor(&per_cu, (const void*)fwd_kernel, NTHR, LDS_BYTES);
    if (per_cu < 1) { fprintf(stderr, "kernel_launch: occupancy query says %d\n", per_cu); grid = -1; return; }
    grid = cus;
  }
  if (grid < 0) return;
  hipMemsetAsync(d_ws, 0, ZERO_BYTES, stream);
  Params p{};
  for (int i = 0; i < N_IN; ++i) p.in[i] = (const float*)d_in[i];
  p.out = (float*)d_out; p.ws = (char*)d_ws;
#if N_LAUNCH_MODE == 1
  p.s_lo = 0; p.s_hi = N_STEPS;
  void* args[] = {&p};
  hipError_t e = hipLaunchCooperativeKernel((const void*)fwd_kernel, dim3(grid), dim3(NTHR), args, LDS_BYTES, stream);
  if (e != hipSuccess) fprintf(stderr, "cooperative launch failed: %s (grid %d)\n", hipGetErrorString(e), grid);
#else
  for (int s = 0; s < N_STEPS; ++s) { p.s_lo = s; p.s_hi = s + 1; hipLaunchKernelGGL(fwd_kernel, dim3(grid), dim3(NTHR), LDS_BYTES, stream, p); }
#endif
}
```
